# Optimizing an MI355X kernel written in HIP

```python
import math
import jax, jax.numpy as jnp
from jax import lax
import numpy as np

D_MODEL = 1024
BATCH = 32
SEQ = 2048
DEPTH = 1

SSM_WIDTH = D_MODEL // 2
SSM_GROUP_CH = 16
SSM_GROUPS = SSM_WIDTH // SSM_GROUP_CH
SSM_STATE = 64
SGU_WIDTH = D_MODEL // 2
SGU_HEADS = 8
SGU_HEAD_DIM = SGU_WIDTH // SGU_HEADS
SGU_CHUNK = 128
IN_WIDTH = SSM_WIDTH + 2 * SGU_WIDTH
N_GROUPS = 4
EXPERTS_PER_GROUP = 8
N_EXPERTS = N_GROUPS * EXPERTS_PER_GROUP
TOP_K = 2
D_FF_EXPERT = D_MODEL // 2
EXPERT_BLOCK = 128
RMS_EPS = 1e-6
LN_EPS = 1e-5

kernel_name = "hybrid_s5_sgu_hmoe_block"


def rmsnorm(x, g):
    xf = x.astype(jnp.float32)
    y = xf * lax.rsqrt(jnp.mean(xf * xf, axis=-1, keepdims=True) + RMS_EPS)
    return (y * g.astype(jnp.float32)).astype(x.dtype)


def layernorm(x, g, b):
    xf = x.astype(jnp.float32)
    mu = jnp.mean(xf, axis=-1, keepdims=True)
    var = jnp.mean(jnp.square(xf - mu), axis=-1, keepdims=True)
    y = (xf - mu) * lax.rsqrt(var + LN_EPS) * g.astype(jnp.float32) + b.astype(jnp.float32)
    return y.astype(x.dtype)


def modulate(x, shift, scale):
    return x * (1.0 + scale[:, None, :]) + shift[:, None, :]


def s5_branch(u, a_re, a_im, b_re, b_im, c_re, c_im, d_skip, log_step, w_glu, b_glu):
    f32 = jnp.float32
    bq, sq, _ = u.shape
    uf = u.astype(f32).reshape(bq, sq, SSM_GROUPS, SSM_GROUP_CH)
    lam_re = jnp.minimum(a_re.astype(f32), -1e-4)
    lam_im = a_im.astype(f32)
    dt = jnp.exp(log_step.astype(f32))[:, None]
    mag = jnp.exp(lam_re * dt)
    ab_re = mag * jnp.cos(lam_im * dt)
    ab_im = mag * jnp.sin(lam_im * dt)
    den = lam_re * lam_re + lam_im * lam_im
    nr = ab_re - 1.0
    f_re = (nr * lam_re + ab_im * lam_im) / den
    f_im = (ab_im * lam_re - nr * lam_im) / den
    bu_re = jnp.einsum('bsgh,gnh->bsgn', uf, b_re.astype(f32))
    bu_im = jnp.einsum('bsgh,gnh->bsgn', uf, b_im.astype(f32))
    x_re = f_re * bu_re - f_im * bu_im
    x_im = f_re * bu_im + f_im * bu_re
    a_r = jnp.broadcast_to(ab_re[None, None], (1, sq, SSM_GROUPS, SSM_STATE))
    a_i = jnp.broadcast_to(ab_im[None, None], (1, sq, SSM_GROUPS, SSM_STATE))

    def combine(e1, e2):
        ar1, ai1, br1, bi1 = e1
        ar2, ai2, br2, bi2 = e2
        ar = ar2 * ar1 - ai2 * ai1
        ai = ar2 * ai1 + ai2 * ar1
        br = ar2 * br1 - ai2 * bi1 + br2
        bi = ar2 * bi1 + ai2 * br1 + bi2
        return (ar, ai, br, bi)

    _, _, h_re, h_im = lax.associative_scan(combine, (a_r, a_i, x_re, x_im), axis=1)
    y = (jnp.einsum('bsgn,ghn->bsgh', h_re, c_re.astype(f32))
         - jnp.einsum('bsgn,ghn->bsgh', h_im, c_im.astype(f32))
         + d_skip.astype(f32) * uf)
    y = jax.nn.gelu(y.reshape(bq, sq, SSM_WIDTH))
    y = y * jax.nn.sigmoid(y @ w_glu.astype(f32) + b_glu.astype(f32))
    return y.astype(u.dtype)


def sgu_branch(z_u, z_v, ln_g, ln_b, w_s, b_s):
    bq, sq, _ = z_u.shape
    u = jax.nn.gelu(z_u)
    v = layernorm(jax.nn.gelu(z_v), ln_g, ln_b)
    n_chunks = sq // SGU_CHUNK
    vh = v.reshape(bq, n_chunks, SGU_CHUNK, SGU_HEADS, SGU_HEAD_DIM)
    causal = jnp.tril(jnp.ones((SGU_CHUNK, SGU_CHUNK), w_s.dtype))
    ws = w_s * causal[None]
    mixed = jnp.einsum('hts,bcshd->bcthd', ws, vh) + b_s.T[None, None, :, :, None]
    return u * mixed.reshape(bq, sq, SGU_WIDTH)


def hierarchical_moe(xn, w_rg, b_rg, w_re, b_re, w1, w3, w2):
    f32 = jnp.float32
    bq, sq, dm = xn.shape
    n_tok = bq * sq
    xt = xn.reshape(n_tok, dm)
    lg = (xt @ w_rg + b_rg).astype(f32)
    pg = jax.nn.softmax(lg, axis=-1)
    grp = jnp.argmax(lg, axis=-1).astype(jnp.int32)
    pg_sel = jnp.take_along_axis(pg, grp[:, None], axis=1)[:, 0]
    le_all = (jnp.einsum('td,gde->tge', xt, w_re) + b_re[None]).astype(f32)
    le = jnp.take_along_axis(le_all, grp[:, None, None], axis=1)[:, 0]
    top_v, top_i = lax.top_k(le, TOP_K)
    pe = jax.nn.softmax(top_v, axis=-1)
    eid = grp[:, None] * EXPERTS_PER_GROUP + top_i.astype(jnp.int32)
    wgt = pg_sel[:, None] * pe

    n_asg = n_tok * TOP_K
    e_flat = eid.reshape(n_asg)
    w_flat = wgt.reshape(n_asg)
    tok_flat = jnp.repeat(jnp.arange(n_tok, dtype=jnp.int32), TOP_K)
    order = jnp.argsort(e_flat)
    e_s = e_flat[order]
    tok_s = tok_flat[order]
    w_s = w_flat[order]
    counts = jnp.bincount(e_flat, length=N_EXPERTS).astype(jnp.int32)
    padded = (counts + EXPERT_BLOCK - 1) // EXPERT_BLOCK * EXPERT_BLOCK
    starts = jnp.cumsum(counts) - counts
    ends_p = jnp.cumsum(padded)
    pstarts = ends_p - padded
    dest = pstarts[e_s] + (jnp.arange(n_asg, dtype=jnp.int32) - starts[e_s])
    n_buf = n_asg + N_EXPERTS * EXPERT_BLOCK
    n_blocks = n_buf // EXPERT_BLOCK
    buf_tok = jnp.full((n_buf,), n_tok, jnp.int32).at[dest].set(tok_s)
    buf_w = jnp.zeros((n_buf,), f32).at[dest].set(w_s)
    block_start = jnp.arange(n_blocks, dtype=jnp.int32) * EXPERT_BLOCK
    block_e = jnp.clip(jnp.searchsorted(ends_p, block_start, side='right'), 0, N_EXPERTS - 1)
    x_pad = jnp.concatenate([xt, jnp.zeros((1, dm), xt.dtype)], axis=0)
    xb = x_pad[buf_tok].reshape(n_blocks, EXPERT_BLOCK, dm)

    def expert_block(args):
        xblk, e = args
        hid = jax.nn.silu(xblk @ w1[e]) * (xblk @ w3[e])
        return hid @ w2[e]

    yb = lax.map(expert_block, (xb, block_e)).reshape(n_buf, dm)
    y = jnp.zeros((n_tok + 1, dm), yb.dtype).at[buf_tok].add(yb * buf_w[:, None].astype(yb.dtype))
    return y[:n_tok].reshape(bq, sq, dm)


def setup_inputs(seed: int = 0) -> dict:
    key = jax.random.key(seed)
    ks = iter(jax.random.split(key, 40))
    f32 = jnp.float32
    L = DEPTH

    def nrm(shape, scale):
        return jax.random.normal(next(ks), shape, f32) * scale

    d_inv = D_MODEL ** -0.5
    x = nrm((BATCH, SEQ, D_MODEL), 1.0)
    c = nrm((BATCH, D_MODEL), 1.0)
    w_ada = nrm((L, D_MODEL, 6 * D_MODEL), 0.2 * d_inv)
    b_ada = nrm((L, 6 * D_MODEL), 0.01)
    norm1_g = 1.0 + nrm((L, D_MODEL), 0.01)
    w_in = nrm((L, D_MODEL, IN_WIDTH), d_inv)
    w_gate = nrm((L, D_MODEL, 2 * D_MODEL), d_inv)
    b_gate = nrm((L, 2 * D_MODEL), 0.01)
    ssm_a_re = -0.5 + nrm((L, SSM_GROUPS, SSM_STATE), 0.01)
    ssm_a_im = jnp.pi * jnp.arange(SSM_STATE, dtype=f32) + nrm((L, SSM_GROUPS, SSM_STATE), 0.01)
    ssm_b_re = nrm((L, SSM_GROUPS, SSM_STATE, SSM_GROUP_CH), (2 * SSM_GROUP_CH) ** -0.5)
    ssm_b_im = nrm((L, SSM_GROUPS, SSM_STATE, SSM_GROUP_CH), (2 * SSM_GROUP_CH) ** -0.5)
    ssm_c_re = nrm((L, SSM_GROUPS, SSM_GROUP_CH, SSM_STATE), 0.5)
    ssm_c_im = nrm((L, SSM_GROUPS, SSM_GROUP_CH, SSM_STATE), 0.5)
    ssm_d = nrm((L, SSM_GROUPS, SSM_GROUP_CH), 1.0)
    ssm_log_step = jax.random.uniform(next(ks), (L, SSM_GROUPS), f32, math.log(1e-3), math.log(1e-1))
    w_glu = nrm((L, SSM_WIDTH, SSM_WIDTH), SSM_WIDTH ** -0.5)
    b_glu = nrm((L, SSM_WIDTH), 0.01)
    sgu_ln_g = 1.0 + nrm((L, SGU_WIDTH), 0.01)
    sgu_ln_b = nrm((L, SGU_WIDTH), 0.01)
    sgu_w = nrm((L, SGU_HEADS, SGU_CHUNK, SGU_CHUNK), SGU_CHUNK ** -0.5)
    sgu_b = 1.0 + nrm((L, SGU_HEADS, SGU_CHUNK), 0.01)
    w_branch_a = nrm((L, SSM_WIDTH, D_MODEL), SSM_WIDTH ** -0.5)
    w_branch_b = nrm((L, SGU_WIDTH, D_MODEL), SGU_WIDTH ** -0.5)
    w_out = nrm((L, D_MODEL, D_MODEL), d_inv)
    norm2_g = 1.0 + nrm((L, D_MODEL), 0.01)
    w_router_group = nrm((L, D_MODEL, N_GROUPS), d_inv)
    b_router_group = nrm((L, N_GROUPS), 0.01)
    w_router_expert = nrm((L, N_GROUPS, D_MODEL, EXPERTS_PER_GROUP), d_inv)
    b_router_expert = nrm((L, N_GROUPS, EXPERTS_PER_GROUP), 0.01)
    w1 = nrm((L, N_EXPERTS, D_MODEL, D_FF_EXPERT), d_inv)
    w3 = nrm((L, N_EXPERTS, D_MODEL, D_FF_EXPERT), d_inv)
    w2 = nrm((L, N_EXPERTS, D_FF_EXPERT, D_MODEL), D_FF_EXPERT ** -0.5)
    norm_f_g = 1.0 + nrm((D_MODEL,), 0.01)
    return {"x": x, "c": c, "w_ada": w_ada, "b_ada": b_ada, "norm1_g": norm1_g,
            "w_in": w_in, "w_gate": w_gate, "b_gate": b_gate,
            "ssm_a_re": ssm_a_re, "ssm_a_im": ssm_a_im, "ssm_b_re": ssm_b_re, "ssm_b_im": ssm_b_im,
            "ssm_c_re": ssm_c_re, "ssm_c_im": ssm_c_im, "ssm_d": ssm_d, "ssm_log_step": ssm_log_step,
            "w_glu": w_glu, "b_glu": b_glu, "sgu_ln_g": sgu_ln_g, "sgu_ln_b": sgu_ln_b,
            "sgu_w": sgu_w, "sgu_b": sgu_b, "w_branch_a": w_branch_a, "w_branch_b": w_branch_b,
            "w_out": w_out, "norm2_g": norm2_g, "w_router_group": w_router_group,
            "b_router_group": b_router_group, "w_router_expert": w_router_expert,
            "b_router_expert": b_router_expert, "w1": w1, "w3": w3, "w2": w2, "norm_f_g": norm_f_g}


def reference(x, c, w_ada, b_ada, norm1_g, w_in, w_gate, b_gate,
              ssm_a_re, ssm_a_im, ssm_b_re, ssm_b_im, ssm_c_re, ssm_c_im, ssm_d, ssm_log_step,
              w_glu, b_glu, sgu_ln_g, sgu_ln_b, sgu_w, sgu_b, w_branch_a, w_branch_b,
              w_out, norm2_g, w_router_group, b_router_group, w_router_expert,
              b_router_expert, w1, w3, w2, norm_f_g):
    h = x
    c_act = jax.nn.silu(c)
    for l in range(DEPTH):
        mod = c_act @ w_ada[l] + b_ada[l]
        sh1, sc1, gt1, sh2, sc2, gt2 = jnp.split(mod, 6, axis=-1)
        xn = modulate(rmsnorm(h, norm1_g[l]), sh1, sc1)
        proj = xn @ w_in[l]
        z_a = proj[..., :SSM_WIDTH]
        z_u = proj[..., SSM_WIDTH:SSM_WIDTH + SGU_WIDTH]
        z_v = proj[..., SSM_WIDTH + SGU_WIDTH:]
        y_a = s5_branch(z_a, ssm_a_re[l], ssm_a_im[l], ssm_b_re[l], ssm_b_im[l],
                        ssm_c_re[l], ssm_c_im[l], ssm_d[l], ssm_log_step[l], w_glu[l], b_glu[l])
        y_b = sgu_branch(z_u, z_v, sgu_ln_g[l], sgu_ln_b[l], sgu_w[l], sgu_b[l])
        gates = jax.nn.sigmoid(xn @ w_gate[l] + b_gate[l])
        g_a = gates[..., :D_MODEL]
        g_b = gates[..., D_MODEL:]
        merged = g_a * (y_a @ w_branch_a[l]) + g_b * (y_b @ w_branch_b[l])
        h = h + gt1[:, None, :] * (merged @ w_out[l])
        xn2 = modulate(rmsnorm(h, norm2_g[l]), sh2, sc2)
        y_m = hierarchical_moe(xn2, w_router_group[l], b_router_group[l], w_router_expert[l],
                               b_router_expert[l], w1[l], w3[l], w2[l])
        h = h + gt2[:, None, :] * y_m
    return rmsnorm(h, norm_f_g)
```

```cpp
#include <hip/hip_runtime.h>
#include <cstdint>
#include <cstdio>
namespace nv {
constexpr int D = 1024, BATCH = 32, SEQ = 2048, T = BATCH * SEQ;
__device__ __forceinline__ float sigmoidf_(float x) { return 1.0f / (1.0f + __expf(-x)); }
__device__ __forceinline__ float siluf_(float x) { return x * sigmoidf_(x); }
__device__ __forceinline__ float geluf_(float x) { const float u = 0.7978845608028654f * (x + 0.044715f * x * x * x); return 0.5f * x * (1.0f + tanhf(u)); }

__global__ void __launch_bounds__(256) k_mod(const float* c, const float* w_ada, const float* b_ada, float* mod) {
    __shared__ float cs[1024];
    const int b = blockIdx.y, j = blockIdx.x * 256 + threadIdx.x;
    for (int k = threadIdx.x; k < 1024; k += 256) cs[k] = siluf_(c[b * 1024 + k]);
    __syncthreads();
    float acc = b_ada[j];
    for (int k = 0; k < 1024; ++k) acc += cs[k] * w_ada[(size_t)k * 6144 + j];
    mod[b * 6144 + j] = acc;
}
__device__ __forceinline__ float block_sum_256(float v, float* red) {
    for (int o = 32; o > 0; o >>= 1) v += __shfl_xor(v, o);
    const int w = threadIdx.x >> 6;
    __syncthreads();
    if ((threadIdx.x & 63) == 0) red[w] = v;
    __syncthreads();
    return red[0] + red[1] + red[2] + red[3];
}
__global__ void __launch_bounds__(256) k_rmsmod(const float* x, const float* g, const float* mod, int sh_off, int sc_off, float* out) {
    __shared__ float red[4];
    const int t = blockIdx.x, b = t / SEQ, c = threadIdx.x * 4;
    const float4 v = *(const float4*)(x + (size_t)t * D + c);
    const float ss = block_sum_256(v.x * v.x + v.y * v.y + v.z * v.z + v.w * v.w, red);
    const float r = rsqrtf(ss * (1.0f / D) + 1e-6f);
    float o[4] = {v.x, v.y, v.z, v.w};
#pragma unroll
    for (int i = 0; i < 4; ++i) {
        float y = o[i] * r * g[c + i];
        if (sc_off >= 0) y = y * (1.0f + mod[b * 6144 + sc_off + c + i]) + mod[b * 6144 + sh_off + c + i];
        o[i] = y;
    }
    *(float4*)(out + (size_t)t * D + c) = make_float4(o[0], o[1], o[2], o[3]);
}
template <class Epi>
__global__ void __launch_bounds__(256) k_gemm(const float* __restrict__ A, const float* __restrict__ B, int lda, int ldb, int K, int pad_, Epi epi) {
    __shared__ float As[16][68];
    __shared__ float Bs[16][68];
    const int tid = threadIdx.x, tx = tid & 15, ty = tid >> 4;
    const int row0 = blockIdx.y * 64, col0 = blockIdx.x * 64;
    float acc[4][4];
#pragma unroll
    for (int i = 0; i < 4; ++i)
#pragma unroll
        for (int j = 0; j < 4; ++j) acc[i][j] = 0.f;
    for (int k0 = 0; k0 < K; k0 += 16) {
        { const int r = tid >> 2, kk = (tid & 3) * 4;
          const float4 a = *(const float4*)(A + (size_t)(row0 + r) * lda + k0 + kk);
          As[kk + 0][r] = a.x; As[kk + 1][r] = a.y; As[kk + 2][r] = a.z; As[kk + 3][r] = a.w; }
        { const int r = tid >> 4, cc = (tid & 15) * 4;
          const float4 b = *(const float4*)(B + (size_t)(k0 + r) * ldb + col0 + cc);
          *(float4*)&Bs[r][cc] = b; }
        __syncthreads();
#pragma unroll
        for (int kk = 0; kk < 16; ++kk) {
            const float4 a = *(const float4*)&As[kk][ty * 4];
            const float4 b = *(const float4*)&Bs[kk][tx * 4];
            const float av[4] = {a.x, a.y, a.z, a.w}, bv[4] = {b.x, b.y, b.z, b.w};
#pragma unroll
            for (int i = 0; i < 4; ++i)
#pragma unroll
                for (int j = 0; j < 4; ++j) acc[i][j] += av[i] * bv[j];
        }
        __syncthreads();
    }
#pragma unroll
    for (int i = 0; i < 4; ++i)
#pragma unroll
        for (int j = 0; j < 4; ++j) epi(row0 + ty * 4 + i, col0 + tx * 4 + j, acc[i][j]);
}
struct EpiStore { float* C; int ldc; int pad; __device__ void operator()(int r, int c, float v) const { C[(size_t)r * ldc + c] = v; } };
struct EpiGlu { const float* GY; const float* b; float* O; __device__ void operator()(int r, int c, float v) const { O[(size_t)r * 512 + c] = GY[(size_t)r * 512 + c] * sigmoidf_(v + b[c]); } };
struct EpiMulSig { float* M; const float* b; __device__ void operator()(int r, int c, float v) const { M[(size_t)r * 1024 + c] *= sigmoidf_(v + b[c]); } };
struct EpiAddMulSig { float* M; const float* Tm; const float* b; __device__ void operator()(int r, int c, float v) const { M[(size_t)r * 1024 + c] += Tm[(size_t)r * 1024 + c] * sigmoidf_(v + b[c]); } };
struct EpiResid { const float* x; const float* mod; float* O; int gt_off; int pad; __device__ void operator()(int r, int c, float v) const { const int b = r / SEQ; O[(size_t)r * 1024 + c] = x[(size_t)r * 1024 + c] + mod[b * 6144 + gt_off + c] * v; } };

__global__ void __launch_bounds__(64) k_s5(const float* proj, const float* a_re, const float* a_im, const float* b_re, const float* b_im,
                                          const float* c_re, const float* c_im, const float* dsk, const float* log_step, float* GY) {
    const int b = blockIdx.x >> 5, g = blockIdx.x & 31, n = threadIdx.x;
    const double lr = fmin((double)a_re[g * 64 + n], -1e-4), li = (double)a_im[g * 64 + n], dt = exp((double)log_step[g]);
    const double mag = exp(lr * dt), abr_d = mag * cos(li * dt), abi_d = mag * sin(li * dt), den = lr * lr + li * li, nr = abr_d - 1.0;
    const double fr = (nr * lr + abi_d * li) / den, fi = (abi_d * lr - nr * li) / den;
    const float abr = (float)abr_d, abi = (float)abi_d;
    float Br[16], Bi[16], Cr[16], Ci[16];
#pragma unroll
    for (int h = 0; h < 16; ++h) {
        const double br = b_re[(g * 64 + n) * 16 + h], bi = b_im[(g * 64 + n) * 16 + h];
        Br[h] = (float)(fr * br - fi * bi); Bi[h] = (float)(fr * bi + fi * br);
        Cr[h] = c_re[(g * 16 + h) * 64 + n]; Ci[h] = c_im[(g * 16 + h) * 64 + n];
    }
    const float dk = (n < 16) ? dsk[g * 16 + n] : 0.f;
    float hr = 0.f, hi = 0.f;
    for (int t = 0; t < SEQ; ++t) {
        const float* up = proj + (size_t)(b * SEQ + t) * 1536 + g * 16;
        float xr = 0.f, xi = 0.f;
#pragma unroll
        for (int h = 0; h < 16; ++h) { const float u = up[h]; xr += Br[h] * u; xi += Bi[h] * u; }
        const float nhr = abr * hr - abi * hi + xr, nhi = abr * hi + abi * hr + xi;
        hr = nhr; hi = nhi;
        float mine = 0.f;
#pragma unroll
        for (int h = 0; h < 16; ++h) {
            float v = Cr[h] * hr - Ci[h] * hi;
            for (int o = 32; o > 0; o >>= 1) v += __shfl_xor(v, o);
            if (n == h) mine = v;
        }
        if (n < 16) { const float y = mine + dk * up[n]; GY[(size_t)(b * SEQ + t) * 512 + g * 16 + n] = geluf_(y); }
    }
}
__global__ void __launch_bounds__(256) k_sgu_ln(const float* proj, const float* ln_g, const float* ln_b, float* V) {
    __shared__ float red[4];
    const int t = blockIdx.x, c = threadIdx.x * 2;
    const float a0 = geluf_(proj[(size_t)t * 1536 + 1024 + c]), a1 = geluf_(proj[(size_t)t * 1536 + 1024 + c + 1]);
    const float mu = block_sum_256(a0 + a1, red) * (1.0f / 512.0f);
    const float d0 = a0 - mu, d1 = a1 - mu;
    const float var = block_sum_256(d0 * d0 + d1 * d1, red) * (1.0f / 512.0f);
    const float rs = rsqrtf(var + 1e-5f);
    V[(size_t)t * 512 + c] = d0 * rs * ln_g[c] + ln_b[c];
    V[(size_t)t * 512 + c + 1] = d1 * rs * ln_g[c + 1] + ln_b[c + 1];
}
__global__ void __launch_bounds__(256) k_sgu_mix(const float* proj, const float* V, const float* sw, const float* sb, float* YB) {
    const int t = blockIdx.y, ch = blockIdx.x * 256 + threadIdx.x, tt = t & 127, base = t - tt, h = ch >> 6;
    float acc = 0.f;
    for (int ss = 0; ss <= tt; ++ss) acc += sw[(h * 128 + tt) * 128 + ss] * V[(size_t)(base + ss) * 512 + ch];
    YB[(size_t)t * 512 + ch] = geluf_(proj[(size_t)t * 1536 + 512 + ch]) * (acc + sb[h * 128 + tt]);
}
struct Route { int e0, e1; float w0, w1; };
__global__ void __launch_bounds__(64) k_router(const float* XN2, const float* w_rg, const float* b_rg, const float* w_re, const float* b_re, Route* route) {
    __shared__ float xs[1024];
    __shared__ float lg[36];
    const int t = blockIdx.x, o = threadIdx.x;
    for (int k = o; k < 1024; k += 64) xs[k] = XN2[(size_t)t * 1024 + k];
    __syncthreads();
    if (o < 36) {
        float acc = 0.f;
        if (o < 4) { for (int k = 0; k < 1024; ++k) acc += xs[k] * w_rg[k * 4 + o]; acc += b_rg[o]; }
        else { const int g = (o - 4) >> 3, e = (o - 4) & 7; for (int k = 0; k < 1024; ++k) acc += xs[k] * w_re[((size_t)g * 1024 + k) * 8 + e]; acc += b_re[g * 8 + e]; }
        lg[o] = acc;
    }
    __syncthreads();
    if (o == 0) {
        int grp = 0; float mx = lg[0];
        for (int i = 1; i < 4; ++i) if (lg[i] > mx) { mx = lg[i]; grp = i; }
        float se = 0.f; for (int i = 0; i < 4; ++i) se += __expf(lg[i] - mx);
        const float pg = 1.0f / se;
        const float* le = lg + 4 + grp * 8;
        int i0 = 0; float v0 = le[0];
        for (int i = 1; i < 8; ++i) if (le[i] > v0) { v0 = le[i]; i0 = i; }
        int i1 = -1; float v1 = -3.0e38f;
        for (int i = 0; i < 8; ++i) if (i != i0 && le[i] > v1) { v1 = le[i]; i1 = i; }
        const float e1 = __expf(v1 - v0), p0 = 1.0f / (1.0f + e1), p1 = e1 / (1.0f + e1);
        Route r; r.e0 = grp * 8 + i0; r.e1 = grp * 8 + i1; r.w0 = pg * p0; r.w1 = pg * p1;
        route[t] = r;
    }
}
__global__ void __launch_bounds__(512) k_moe_up(const float* XN2, const Route* route, const float* w1, const float* w3, float* HID) {
    __shared__ float xs[1024];
    const int a = blockIdx.x, t = a >> 1, j = threadIdx.x;
    const Route r = route[t]; const int e = (a & 1) ? r.e1 : r.e0;
    for (int k = j; k < 1024; k += 512) xs[k] = XN2[(size_t)t * 1024 + k];
    __syncthreads();
    const float* p1 = w1 + (size_t)e * 1024 * 512 + j; const float* p3 = w3 + (size_t)e * 1024 * 512 + j;
    float s1 = 0.f, s3 = 0.f;
    for (int k = 0; k < 1024; ++k) { s1 += xs[k] * p1[(size_t)k * 512]; s3 += xs[k] * p3[(size_t)k * 512]; }
    HID[(size_t)a * 512 + j] = siluf_(s1) * s3;
}
__global__ void __launch_bounds__(256) k_moe_down_final(const float* HID, const Route* route, const float* w2, const float* H1, const float* mod, const float* gf, float* out) {
    __shared__ float hs[1024];
    __shared__ float red[4];
    const int t = blockIdx.x, b = t / SEQ, c = threadIdx.x * 4;
    const Route r = route[t];
    for (int k = threadIdx.x; k < 1024; k += 256) hs[k] = HID[(size_t)t * 1024 + k] * (k < 512 ? r.w0 : r.w1);
    __syncthreads();
    float y[4] = {0.f, 0.f, 0.f, 0.f};
    for (int half = 0; half < 2; ++half) {
        const float* wp = w2 + (size_t)(half ? r.e1 : r.e0) * 512 * 1024 + c;
        for (int m = 0; m < 512; ++m) { const float4 w = *(const float4*)(wp + (size_t)m * 1024); const float hv = hs[half * 512 + m];
            y[0] += hv * w.x; y[1] += hv * w.y; y[2] += hv * w.z; y[3] += hv * w.w; }
    }
    const float4 h1 = *(const float4*)(H1 + (size_t)t * 1024 + c);
    const float hv[4] = {h1.x, h1.y, h1.z, h1.w};
    float hf[4]; float ss = 0.f;
#pragma unroll
    for (int i = 0; i < 4; ++i) { hf[i] = hv[i] + mod[b * 6144 + 5120 + c + i] * y[i]; ss += hf[i] * hf[i]; }
    const float tot = block_sum_256(ss, red);
    const float rr = rsqrtf(tot * (1.0f / 1024.0f) + 1e-6f);
    *(float4*)(out + (size_t)t * 1024 + c) = make_float4(hf[0] * rr * gf[c], hf[1] * rr * gf[c + 1], hf[2] * rr * gf[c + 2], hf[3] * rr * gf[c + 3]);
}
}
static void naive_forward(void* const* d_in, float* out, unsigned char* ws, hipStream_t st) {
    using namespace nv;
    const float* x = (const float*)d_in[0]; const float* c = (const float*)d_in[1];
    const float* w_ada = (const float*)d_in[2]; const float* b_ada = (const float*)d_in[3]; const float* norm1_g = (const float*)d_in[4];
    const float* w_in = (const float*)d_in[5]; const float* w_gate = (const float*)d_in[6]; const float* b_gate = (const float*)d_in[7];
    const float* a_re = (const float*)d_in[8]; const float* a_im = (const float*)d_in[9]; const float* b_re = (const float*)d_in[10]; const float* b_im = (const float*)d_in[11];
    const float* c_re = (const float*)d_in[12]; const float* c_im = (const float*)d_in[13]; const float* dsk = (const float*)d_in[14]; const float* lstep = (const float*)d_in[15];
    const float* w_glu = (const float*)d_in[16]; const float* b_glu = (const float*)d_in[17]; const float* ln_g = (const float*)d_in[18]; const float* ln_b = (const float*)d_in[19];
    const float* sgu_w = (const float*)d_in[20]; const float* sgu_b = (const float*)d_in[21]; const float* wba = (const float*)d_in[22]; const float* wbb = (const float*)d_in[23];
    const float* w_out = (const float*)d_in[24]; const float* norm2_g = (const float*)d_in[25]; const float* w_rg = (const float*)d_in[26]; const float* b_rg = (const float*)d_in[27];
    const float* w_re = (const float*)d_in[28]; const float* b_re2 = (const float*)d_in[29]; const float* w1 = (const float*)d_in[30]; const float* w3 = (const float*)d_in[31];
    const float* w2 = (const float*)d_in[32]; const float* gf = (const float*)d_in[33];
    const size_t MB = 1u << 20;
    float* MOD = (float*)(ws + 0); float* XN = (float*)(ws + 1 * MB); float* PROJ = (float*)(ws + 257 * MB); float* YA = (float*)(ws + 641 * MB); float* YB = (float*)(ws + 769 * MB);
    Route* ROUTE = (Route*)(ws + 897 * MB);
    float* MERGED = PROJ; float* HID = PROJ; float* XN2 = XN;
    float* V = out; float* GY = out + (size_t)T * 512; float* TMP = out; float* H1 = out;
    k_mod<<<dim3(6144 / 256, 32), 256, 0, st>>>(c, w_ada, b_ada, MOD);
    k_rmsmod<<<T, 256, 0, st>>>(x, norm1_g, MOD, 0, 1024, XN);
    k_gemm<EpiStore><<<dim3(1536 / 64, T / 64), 256, 0, st>>>(XN, w_in, 1024, 1536, 1024, 0, EpiStore{PROJ, 1536, 0});
    k_s5<<<BATCH * 32, 64, 0, st>>>(PROJ, a_re, a_im, b_re, b_im, c_re, c_im, dsk, lstep, GY);
    k_gemm<EpiGlu><<<dim3(512 / 64, T / 64), 256, 0, st>>>(GY, w_glu, 512, 512, 512, 0, EpiGlu{GY, b_glu, YA});
    k_sgu_ln<<<T, 256, 0, st>>>(PROJ, ln_g, ln_b, V);
    k_sgu_mix<<<dim3(2, T), 256, 0, st>>>(PROJ, V, sgu_w, sgu_b, YB);
    k_gemm<EpiStore><<<dim3(1024 / 64, T / 64), 256, 0, st>>>(YA, wba, 512, 1024, 512, 0, EpiStore{MERGED, 1024, 0});
    k_gemm<EpiMulSig><<<dim3(1024 / 64, T / 64), 256, 0, st>>>(XN, w_gate, 1024, 2048, 1024, 0, EpiMulSig{MERGED, b_gate});
    k_gemm<EpiStore><<<dim3(1024 / 64, T / 64), 256, 0, st>>>(YB, wbb, 512, 1024, 512, 0, EpiStore{TMP, 1024, 0});
    k_gemm<EpiAddMulSig><<<dim3(1024 / 64, T / 64), 256, 0, st>>>(XN, w_gate + 1024, 1024, 2048, 1024, 0, EpiAddMulSig{MERGED, TMP, b_gate + 1024});
    k_gemm<EpiResid><<<dim3(1024 / 64, T / 64), 256, 0, st>>>(MERGED, w_out, 1024, 1024, 1024, 0, EpiResid{x, MOD, H1, 2048, 0});
    k_rmsmod<<<T, 256, 0, st>>>(H1, norm2_g, MOD, 3072, 4096, XN2);
    k_router<<<T, 64, 0, st>>>(XN2, w_rg, b_rg, w_re, b_re2, ROUTE);
    k_moe_up<<<2 * T, 512, 0, st>>>(XN2, ROUTE, w1, w3, HID);
    k_moe_down_final<<<T, 256, 0, st>>>(HID, ROUTE, w2, H1, MOD, gf, out);
}
extern "C" void kernel_launch(void* const* d_in, const int* in_sizes, int n_in, void* d_out, int out_size, void* d_ws, size_t ws_size, hipStream_t stream) {
    (void)in_sizes; (void)n_in; (void)out_size; (void)ws_size;
    naive_forward(d_in, (float*)d_out, (unsigned char*)d_ws, stream);
}
```

```cpp
#include <hip/hip_runtime.h>
#include <cstdint>
#include <cstdio>
#define FAST_SPLIT true
namespace mg {
#define MG_LAS __attribute__((address_space(3)))
typedef unsigned short bf16_t;
typedef short bf16x8 __attribute__((ext_vector_type(8)));
typedef float f32x4 __attribute__((ext_vector_type(4)));
typedef float f32x2 __attribute__((ext_vector_type(2)));
typedef unsigned u32x4 __attribute__((ext_vector_type(4)));
typedef unsigned u32x2 __attribute__((ext_vector_type(2)));
constexpr int BM = 256, BK = 64, HALF = 128, HTB = HALF * BK * 2, STAGE_BYTES = 8 * HTB;

__host__ __device__ __forceinline__ int lds_byte(int r, int c) { const int st = (r >> 4) * 2 + (c >> 5), rr = r & 15, cc = c & 31, ob = rr * 64 + cc * 2; return st * 1024 + (ob ^ (((ob >> 9) & 1) << 5)); }
__host__ __device__ __forceinline__ void stage_rc(int b, int& R, int& C) { const int st = b / 1024, sb = b % 1024, swz = sb ^ (((sb >> 9) & 1) << 5); R = (st >> 1) * 16 + swz / 64; C = (st & 1) * 32 + (swz % 64) / 2; }
__host__ __device__ __forceinline__ int perm32(int rho) { const int n = rho >> 4, i = rho & 15; return 8 * (i >> 2) + 4 * n + (i & 3); }

struct Unit { const char* A0; const char* A1; const char* B0; const char* B1; int nt, pm, pn, aux; };

__device__ __forceinline__ unsigned cvt_pk_bf16(float lo, float hi) { unsigned r; asm volatile("v_cvt_pk_bf16_f32 %0, %1, %2" : "=v"(r) : "v"(lo), "v"(hi)); return r; }
__device__ __forceinline__ float bf_lo(unsigned w) { return __uint_as_float(w << 16); }
__device__ __forceinline__ float bf_hi(unsigned w) { return __uint_as_float(w & 0xffff0000u); }
__device__ __forceinline__ float fsigmoid(float x) { return __builtin_amdgcn_rcpf(1.0f + __builtin_amdgcn_exp2f(-1.4426950408889634f * x)); }
__device__ __forceinline__ float fsilu(float x) { return x * fsigmoid(x); }
__device__ __forceinline__ float fgelu(float x) { const float u = x * (1.5957691216057308f + 0.07135481627260025f * x * x); return x * fsigmoid(u); }

template <class Epi, class Sched, bool GATHER, bool ALIGN_EPI>
__device__ __forceinline__ void gemm_phase(MG_LAS unsigned char* lds, const Sched& S, const Epi& E, const size_t kstepA, const size_t kstepB) {
    const int tid = threadIdx.x, wid = __builtin_amdgcn_readfirstlane(tid >> 6), lane = tid & 63, wr = wid >> 2, wc = wid & 3, fr = lane & 15, fq = lane >> 4;
    constexpr int NH = GATHER ? 2 : 1, H1 = GATHER ? 1 : 0;
    unsigned vA[NH][2], vB[2];
    const unsigned ldsw = (unsigned)wid * 1024u;
    const int aoff = lds_byte(wr * 64 + fr, fq * 8), boff = lds_byte(wc * 32 + fr, fq * 8);
#define MG_SA(b, h) (((b) * 2 + (h)) * HTB)
#define MG_SB(b, h) ((4 + (b) * 2 + (h)) * HTB)
#define MG_STAGE(bufoff, gbase, voff) do { _Pragma("unroll") for (int _i = 0; _i < 2; ++_i) \
        __builtin_amdgcn_global_load_lds((const unsigned*)((const char*)(gbase) + (voff)[_i]), (MG_LAS unsigned*)(lds + (bufoff) + ldsw + _i * 8192), 16, 0, 0); } while (0)
#define MG_LDA(dst, b, h) do { _Pragma("unroll") for (int m = 0; m < 4; ++m) _Pragma("unroll") for (int k = 0; k < 2; ++k) dst[m][k] = *(const MG_LAS bf16x8*)(lds + MG_SA(b, h) + aoff + m * 2048 + k * 1024); } while (0)
#define MG_LDB(dst, b, h) do { _Pragma("unroll") for (int n = 0; n < 2; ++n) _Pragma("unroll") for (int k = 0; k < 2; ++k) dst[n][k] = *(const MG_LAS bf16x8*)(lds + MG_SB(b, h) + boff + n * 2048 + k * 1024); } while (0)
#define MG_MMA(ai, bj, At, Bt) do { __builtin_amdgcn_s_setprio(1); _Pragma("unroll") for (int m = 0; m < 4; ++m) _Pragma("unroll") for (int n = 0; n < 2; ++n) _Pragma("unroll") for (int k = 0; k < 2; ++k) \
        acc[ai][bj][m][n] = __builtin_amdgcn_mfma_f32_16x16x32_bf16(Bt[n][k], At[m][k], acc[ai][bj][m][n], 0, 0, 0); __builtin_amdgcn_s_setprio(0); } while (0)
#define MG_WAIT_V(n) asm volatile("s_waitcnt vmcnt(" #n ")" ::: "memory")
#define MG_WAIT_L(n) asm volatile("s_waitcnt lgkmcnt(" #n ")" ::: "memory")
#define MG_BAR __builtin_amdgcn_s_barrier()
#define MG_SCHED __builtin_amdgcn_sched_barrier(0)
    Unit cur, nxt; int ui = 0;
    if (!S.next(0, cur)) return;
    f32x4 acc[2][2][4][2];
#pragma unroll
    for (int a = 0; a < 2; ++a)
#pragma unroll
        for (int b = 0; b < 2; ++b)
#pragma unroll
            for (int m = 0; m < 4; ++m)
#pragma unroll
                for (int n = 0; n < 2; ++n) acc[a][b][m][n] = (f32x4){0.f, 0.f, 0.f, 0.f};
    bf16x8 At[4][2], B0[2][2], B1[2][2];
    S.voff(cur, tid, vA, vB);
    MG_STAGE(MG_SB(0, 0), cur.B0, vB); MG_STAGE(MG_SB(0, 1), cur.B1, vB); MG_STAGE(MG_SA(0, 0), cur.A0, vA[0]); MG_STAGE(MG_SA(0, 1), cur.A1, vA[H1]);
    if (wr == 1) MG_BAR;
    MG_WAIT_V(2); MG_BAR;
    MG_STAGE(MG_SB(1, 0), cur.B0 + kstepB, vB); MG_STAGE(MG_SA(1, 0), cur.A0 + kstepA, vA[0]); MG_STAGE(MG_SB(1, 1), cur.B1 + kstepB, vB);
    MG_WAIT_V(6); MG_BAR;
    for (;;) {
        const bool has_next = S.next(ui + 1, nxt);
        if (!has_next) nxt = cur;
        const int nt = cur.nt;
        for (int t = 0; t < nt; t += 2) {
            const bool last = (t == nt - 2);
            const char* a1h = cur.A1 + (size_t)(t + 1) * kstepA;
            const char* a20 = last ? nxt.A0 : cur.A0 + (size_t)(t + 2) * kstepA; const char* a21 = last ? nxt.A1 : cur.A1 + (size_t)(t + 2) * kstepA;
            const char* b20 = last ? nxt.B0 : cur.B0 + (size_t)(t + 2) * kstepB; const char* b21 = last ? nxt.B1 : cur.B1 + (size_t)(t + 2) * kstepB;
            MG_LDB(B0, 0, 0); MG_LDB(B1, 0, 1); MG_SCHED; MG_LDA(At, 0, 0); MG_STAGE(MG_SA(1, 1), a1h, vA[H1]);
            if (last && has_next) S.voff(nxt, tid, vA, vB);
            MG_WAIT_V(8); MG_WAIT_L(0); MG_BAR; MG_MMA(0, 0, At, B0); MG_MMA(0, 1, At, B1); MG_BAR; MG_SCHED;
            MG_LDA(At, 0, 1); MG_STAGE(MG_SB(0, 0), b20, vB); MG_STAGE(MG_SB(0, 1), b21, vB); MG_STAGE(MG_SA(0, 0), a20, vA[0]);
            MG_WAIT_V(8); MG_WAIT_L(0); MG_BAR; MG_MMA(1, 0, At, B0); MG_MMA(1, 1, At, B1); MG_BAR; MG_SCHED;
            MG_LDB(B0, 1, 0); MG_LDB(B1, 1, 1); MG_SCHED; MG_LDA(At, 1, 0); MG_STAGE(MG_SA(0, 1), a21, vA[H1]);
            MG_WAIT_V(8); MG_WAIT_L(0); MG_BAR; MG_MMA(0, 0, At, B0); MG_MMA(0, 1, At, B1); MG_BAR; MG_SCHED;
            MG_LDA(At, 1, 1); MG_STAGE(MG_SB(1, 0), b20 + kstepB, vB); MG_STAGE(MG_SB(1, 1), b21 + kstepB, vB); MG_STAGE(MG_SA(1, 0), a20 + kstepA, vA[0]);
            MG_WAIT_V(8); MG_WAIT_L(0); MG_BAR; MG_MMA(1, 0, At, B0); MG_MMA(1, 1, At, B1); MG_BAR; MG_SCHED;
        }
        if constexpr (ALIGN_EPI) { if (wr == 0) MG_BAR; }
        { int fr_ = fr, fq_ = fq; asm volatile("" : "+v"(fr_), "+v"(fq_));
          E(acc, cur, wr, wc, fr_, fq_); }
        if (!has_next) break;
#pragma unroll
        for (int a = 0; a < 2; ++a)
#pragma unroll
            for (int b = 0; b < 2; ++b)
#pragma unroll
                for (int m = 0; m < 4; ++m)
#pragma unroll
                    for (int n = 0; n < 2; ++n) acc[a][b][m][n] = (f32x4){0.f, 0.f, 0.f, 0.f};
        cur = nxt; ++ui;
        if constexpr (ALIGN_EPI) { if (wr == 1) MG_BAR; }
    }
    MG_WAIT_V(0);
    if constexpr (!ALIGN_EPI) { if (wr == 0) MG_BAR; }
    MG_BAR;
#undef MG_SA
#undef MG_SB
#undef MG_STAGE
#undef MG_LDA
#undef MG_LDB
#undef MG_MMA
#undef MG_WAIT_V
#undef MG_WAIT_L
#undef MG_BAR
#undef MG_SCHED
}
template <bool PERM>
__device__ __forceinline__ void std_voff(int tid, int lda, int ldb, unsigned (&va)[1][2], unsigned (&vb)[2]) {
#pragma unroll
    for (int i = 0; i < 2; ++i) { int R, C; stage_rc(tid * 16 + i * 8192, R, C); const int Rb = PERM ? ((R & ~31) + perm32(R & 31)) : R;
        va[0][i] = (unsigned)(R * lda + C) * 2u; vb[i] = (unsigned)(Rb * ldb + C) * 2u; }
}
__device__ __forceinline__ bool static_tile(int i, int G, int c, int nM, int nN, int& pm, int& pn) {
    const int nwg = nM * nN; const long L = (long)i * G + c; if (L >= nwg) return false;
    int wgid = (int)L; { const int q = nwg / 8, r = nwg % 8, xcd = wgid % 8, off = wgid / 8; wgid = (xcd < r ? xcd * (q + 1) : r * (q + 1) + (xcd - r) * q) + off; }
    const int nig = 8 * nN, gid = wgid / nig, fm = gid * 8, gsz = (nM - fm) < 8 ? (nM - fm) : 8;
    pm = fm + ((wgid % nig) % gsz); pn = (wgid % nig) / gsz; return true;
}
}
namespace fx {
using mg::bf16_t; using mg::bf16x8; using mg::f32x4; using mg::f32x2; using mg::u32x4; using mg::u32x2; using mg::Unit;
#define GAS __attribute__((address_space(1)))
#define LAS __attribute__((address_space(3)))
typedef GAS unsigned gu32;
#define RLX_AGENT __ATOMIC_RELAXED, __HIP_MEMORY_SCOPE_AGENT
#define LDS_WAIT() asm volatile("s_waitcnt lgkmcnt(0)" ::: "memory")
#define VM_WAIT() asm volatile("s_waitcnt vmcnt(0)" ::: "memory")
constexpr int NWAVES = 8, NTHREADS = 512;
constexpr int T = 65536, D = 1024, SEQ = 2048, NB = 32;
constexpr int ECAP = 131072;
constexpr size_t MiB = 1u << 20;
constexpr size_t WS_CTL = 0, CTL_ZERO_BYTES = 1 * MiB;
constexpr size_t WS_MOD = 1 * MiB;
constexpr size_t WS_SGUW = 2 * MiB;
constexpr size_t WS_AL = 2 * MiB + 512 * 1024;
constexpr size_t WS_TZ = 4 * MiB;
constexpr size_t WS_WS = 6 * MiB;
constexpr size_t WS_WO = 14 * MiB;
constexpr size_t WS_W1T = 30 * MiB;
constexpr size_t WS_WGLUT = 37 * MiB;
constexpr size_t WS_WBAT = 38 * MiB, WS_WBBT = 39 * MiB;
constexpr size_t WS_WOUTT = 40 * MiB;
constexpr size_t WS_WUPT = 42 * MiB;
constexpr size_t WS_WDNT = 106 * MiB;
constexpr size_t WS_ROWTOK = 139 * MiB;
constexpr size_t WS_ROWW = 155 * MiB;
constexpr size_t WS_XN = 172 * MiB;
constexpr size_t WS_GATES = 300 * MiB;
constexpr size_t WS_ZA = 556 * MiB;
constexpr size_t WS_YG = WS_ZA;
constexpr size_t WS_U = 620 * MiB, WS_GV = 684 * MiB;
constexpr size_t WS_YI = 748 * MiB;
constexpr size_t WS_SST = 812 * MiB;
constexpr size_t WS_HP = 828 * MiB;
constexpr size_t WS_YA = 844 * MiB, WS_YB = 908 * MiB;
constexpr size_t WS_P1 = 620 * MiB;
constexpr size_t WS_MERGED = 748 * MiB;
constexpr size_t WS_HID = 300 * MiB;
constexpr size_t WS_SLOT = 556 * MiB;
constexpr size_t WS_END = 972 * MiB;
constexpr int CW_TMO = 0, CW_BAR = 4096, CW_CURSOR = 65536;
constexpr int RING_BYTES = 131072;
constexpr int LDS_BYTES = 163840;
constexpr int MISC_OFF = LDS_BYTES - 256;
constexpr int XT_OFF = RING_BYTES;

__device__ __forceinline__ unsigned f2bf(float f) { unsigned u = __builtin_bit_cast(unsigned, f); return (u + 0x7fffu + ((u >> 16) & 1u)) >> 16; }
__device__ __forceinline__ unsigned pk2(float lo, float hi) { return f2bf(lo) | (f2bf(hi) << 16); }
__device__ __forceinline__ float wave_sum(float v) {
#pragma unroll
    for (int o = 1; o < 64; o <<= 1) v += __shfl_xor(v, o);
    return v;
}
#define XB_TMO      128
#define XB_XCNT(j)  (256  + 64 * (j))
#define XB_XSUB(j)  (1280 + 64 * (j))
#define XB_XGEN(j)  (2304 + 64 * (j))
#define XB_TOP      3328
#define XB_TOPGEN   3392
#define XCD_BAR_WORDS 3456
#define XB_SPIN_CAP (1u << 18)
__device__ __forceinline__ unsigned xb_ld(unsigned* p)              { return __hip_atomic_load(p, __ATOMIC_RELAXED, __HIP_MEMORY_SCOPE_AGENT); }
__device__ __forceinline__ unsigned xb_add(unsigned* p, unsigned v) { return __hip_atomic_fetch_add(p, v, __ATOMIC_RELAXED, __HIP_MEMORY_SCOPE_AGENT); }
__device__ __forceinline__ unsigned xb_xcc_id() { return (unsigned)__builtin_amdgcn_s_getreg((3 << 11) | 20) & 0xFu; }
#define XB_SPIN(cond, bar) do { unsigned _sp = 0; while (cond) { __builtin_amdgcn_s_sleep(1); \
    if ((++_sp & 255u) == 0u) { if (xb_ld(&(bar)[XB_TMO])) break; if (_sp > XB_SPIN_CAP) { atomicAdd(&(bar)[XB_TMO], 1u); break; } } } } while (0)
struct XcdBarrier { unsigned* bar; unsigned x; volatile LAS unsigned* st; };
__device__ __forceinline__ XcdBarrier xcd_barrier_post(unsigned* bar, volatile LAS unsigned* st) {
    XcdBarrier b; b.bar = bar; b.x = xb_xcc_id(); b.st = st;
    if (threadIdx.x == 0) (void)xb_add(&bar[XB_XCNT(b.x)], 1u);
    return b;
}
__device__ __forceinline__ void xcd_barrier_complete(unsigned* bar, unsigned x, unsigned& nloc, unsigned& nx) {
    const unsigned G = gridDim.x * gridDim.y * gridDim.z;
    unsigned sum, cnt, mine, sp = 0u;
    for (;;) {
        sum = 0u; cnt = 0u; mine = 0u;
#pragma unroll
        for (unsigned j = 0; j < 16; ++j) { const unsigned c = xb_ld(&bar[XB_XCNT(j)]); sum += c; cnt += (c > 0u) ? 1u : 0u; mine = (j == x) ? c : mine; }
        if (sum == G) break;
        __builtin_amdgcn_s_sleep(1);
        if ((++sp & 255u) == 0u) { if (xb_ld(&bar[XB_TMO])) break; if (sp > XB_SPIN_CAP) { atomicAdd(&bar[XB_TMO], 1u); break; } }
    }
    nloc = mine > 0u ? mine : 1u; nx = cnt > 0u ? cnt : 1u;
}
__device__ __forceinline__ void xcd_barrier(const XcdBarrier& b) {
    asm volatile("s_waitcnt vmcnt(0)" ::: "memory");
    __syncthreads();
    if (threadIdx.x == 0) {
        unsigned* bar = b.bar;
        __builtin_amdgcn_s_waitcnt(0);
        unsigned nloc = b.st[0], nx = b.st[1];
        if (nloc == 0u) { xcd_barrier_complete(bar, b.x, nloc, nx); b.st[0] = nloc; b.st[1] = nx; }
        const unsigned old = xb_add(&bar[XB_XSUB(b.x)], 1u);
        const unsigned gen = old / nloc;
        if (old + 1u == (gen + 1u) * nloc) {
            __builtin_amdgcn_fence(__ATOMIC_RELEASE, "agent");
            asm volatile("s_waitcnt vmcnt(0)" ::: "memory");
            const unsigned og = xb_add(&bar[XB_TOP], 1u);
            const unsigned tg = og / nx;
            if (og + 1u == (tg + 1u) * nx) xb_add(&bar[XB_TOPGEN], 1u);
            else XB_SPIN(xb_ld(&bar[XB_TOPGEN]) == tg, bar);
            __builtin_amdgcn_fence(__ATOMIC_ACQUIRE, "agent");
            xb_add(&bar[XB_XGEN(b.x)], 1u);
            asm volatile("s_waitcnt vmcnt(0)" ::: "memory");
        } else {
            XB_SPIN(xb_ld(&bar[XB_XGEN(b.x)]) == gen, bar);
            __builtin_amdgcn_fence(__ATOMIC_ACQUIRE, "agent");
            asm volatile("s_waitcnt vmcnt(0)" ::: "memory");
        }
    }
    __syncthreads();
}

struct Params { const float* in[34]; float* out; unsigned char* ws; int ph_lo, ph_hi; };
enum { I_X = 0, I_C, I_WADA, I_BADA, I_N1G, I_WIN, I_WGATE, I_BGATE, I_ARE, I_AIM, I_BRE, I_BIM, I_CRE, I_CIM, I_DSK, I_LSTEP, I_WGLU, I_BGLU, I_LNG, I_LNB,
       I_SGUW, I_SGUB, I_WBA, I_WBB, I_WOUT, I_N2G, I_WRG, I_BRG, I_WRE, I_BRE2, I_W1, I_W3, I_W2, I_NFG };
}
namespace fx {
using mg::cvt_pk_bf16; using mg::fsigmoid; using mg::fsilu; using mg::fgelu; using mg::bf_lo; using mg::bf_hi;
struct Ctx { LAS unsigned char* lds; int tid, lane, wave, vcu, G; };

__device__ __forceinline__ u32x4 pack8(const f32x4& a, const f32x4& b) { u32x4 w; w.x = cvt_pk_bf16(a[0], a[1]); w.y = cvt_pk_bf16(a[2], a[3]); w.z = cvt_pk_bf16(b[0], b[1]); w.w = cvt_pk_bf16(b[2], b[3]); return w; }
__device__ __forceinline__ void unpack8(const u32x4& w, f32x4& a, f32x4& b) { a = (f32x4){bf_lo(w.x), bf_hi(w.x), bf_lo(w.y), bf_hi(w.y)}; b = (f32x4){bf_lo(w.z), bf_hi(w.z), bf_lo(w.w), bf_hi(w.w)}; }

__device__ __forceinline__ void transpose_item(const float* W, int K, int N, bf16_t* WT, int dest_row0, int k0, int n0, LAS float* scr, int lane) {
#pragma unroll 8
    for (int i = 0; i < 32; ++i) { const int kk = 2 * i + (lane >> 5); scr[kk * 33 + (lane & 31)] = W[(size_t)(k0 + kk) * N + n0 + (lane & 31)]; }
    LDS_WAIT(); asm volatile("" ::: "memory");
    const int c = lane & 7;
#pragma unroll
    for (int j = 0; j < 4; ++j) { const int n = (lane >> 3) + 8 * j; const LAS float* s = scr + (8 * c) * 33 + n;
        u32x4 o; o.x = pk2(s[0 * 33], s[1 * 33]); o.y = pk2(s[2 * 33], s[3 * 33]); o.z = pk2(s[4 * 33], s[5 * 33]); o.w = pk2(s[6 * 33], s[7 * 33]);
        *(GAS u32x4*)(WT + (size_t)(dest_row0 + n) * K + k0 + 8 * c) = o; }
    LDS_WAIT(); asm volatile("" ::: "memory");
}
__device__ __forceinline__ void p0_s5_tables(const Params& p, const Ctx& c, int g) {
    typedef float f2 __attribute__((ext_vector_type(2)));
    LAS f2* P = (LAS f2*)c.lds;
    LAS f2* BT = P + 64 * 66;
    LAS f2* CC = BT + 1024;
    const float* a_re = p.in[I_ARE]; const float* a_im = p.in[I_AIM]; const float* lstep = p.in[I_LSTEP];
    const int tid = c.tid;
    { const int n = tid & 63, tq = tid >> 6;
      const double lr = fmin((double)a_re[g * 64 + n], -1e-4), li = (double)a_im[g * 64 + n], dt = exp((double)lstep[g]);
      for (int tau = tq; tau <= 64; tau += 8) { const double m = exp(lr * dt * tau), ang = li * dt * tau; P[n * 66 + tau] = (f2){(float)(m * cos(ang)), (float)(m * sin(ang))}; } }
    for (int idx = tid; idx < 1024; idx += 512) {
        { const int n = idx >> 4, h = idx & 15;
          const double lr = fmin((double)a_re[g * 64 + n], -1e-4), li = (double)a_im[g * 64 + n], dt = exp((double)lstep[g]);
          const double mag = exp(lr * dt), abr = mag * cos(li * dt), abi = mag * sin(li * dt), den = lr * lr + li * li, nr = abr - 1.0;
          const double fr = (nr * lr + abi * li) / den, fi = (abi * lr - nr * li) / den;
          const double br = p.in[I_BRE][(g * 64 + n) * 16 + h], bi = p.in[I_BIM][(g * 64 + n) * 16 + h];
          BT[n * 16 + h] = (f2){(float)(fr * br - fi * bi), (float)(fr * bi + fi * br)}; }
        { const int h = idx >> 6, n = idx & 63; CC[h * 64 + n] = (f2){p.in[I_CRE][(g * 16 + h) * 64 + n], p.in[I_CIM][(g * 16 + h) * 64 + n]}; }
    }
    __syncthreads();
    if (tid < 64) ((f2*)(p.ws + WS_AL))[g * 64 + tid] = P[tid * 66 + 64];
    bf16_t* TZ = (bf16_t*)(p.ws + WS_TZ); bf16_t* WSg = (bf16_t*)(p.ws + WS_WS); bf16_t* WOg = (bf16_t*)(p.ws + WS_WO);
    { const int pair = tid & 255, h = pair >> 4, hp = pair & 15, th = tid >> 8;
      float acc[32];
#pragma unroll
      for (int i = 0; i < 32; ++i) acc[i] = 0.f;
      for (int n = 0; n < 64; ++n) {
          const f2 cc = CC[h * 64 + n], bb = BT[n * 16 + hp]; const float cbr = cc.x * bb.x - cc.y * bb.y, cbi = cc.x * bb.y + cc.y * bb.x;
#pragma unroll
          for (int i = 0; i < 32; ++i) { const f2 pw = P[n * 66 + 32 * th + i]; acc[i] += cbr * pw.x - cbi * pw.y; }
      }
      bf16_t* tz = TZ + ((size_t)(g * 16 + h) * 128) * 16 + hp;
      const float dk = p.in[I_DSK][g * 16 + h];
#pragma unroll
      for (int i = 0; i < 32; ++i) { const int tau = 32 * th + i; float v = acc[i]; if (tau == 0 && h == hp) v += dk; tz[(63 + tau) * 16] = (bf16_t)f2bf(v);
          const int jz = 32 * th + i; if (jz < 63) tz[jz * 16] = 0; }
      if (th == 1) tz[127 * 16] = 0;
    }
    for (int r = 0; r < 256; ++r) { const int idx = tid + 512 * r, row = idx >> 10, k = idx & 1023, n = row & 63, im = row >> 6, sp = k >> 4, hp = k & 15;
        const f2 pw = P[n * 66 + sp], bb = BT[n * 16 + hp]; const float v = im ? (pw.x * bb.y + pw.y * bb.x) : (pw.x * bb.x - pw.y * bb.y);
        WSg[((size_t)g * 128 + row) * 1024 + k] = (bf16_t)f2bf(v); }
    for (int r = 0; r < 512; ++r) { const int idx = tid + 512 * r, row = idx >> 8, k = idx & 255, t = row >> 4, h = row & 15; float v = 0.f;
        if (k < 128) { const int n = k & 63; const f2 cc = CC[h * 64 + n], pw = P[n * 66 + t + 1]; v = (k < 64) ? (cc.x * pw.x - cc.y * pw.y) : -(cc.x * pw.y + cc.y * pw.x); }
        WOg[((size_t)g * 1024 + row) * 256 + k] = (bf16_t)f2bf(v); }
    __syncthreads();
}
__device__ __forceinline__ void p0_mod(const Params& p, const Ctx& c) {
    if (c.vcu * 8 >= 768) return;
    LAS float* cs = (LAS float*)c.lds;
    for (int idx = c.tid; idx < 32768; idx += 512) { const int k = idx >> 5, b = idx & 31; cs[idx] = fsilu(p.in[I_C][b * 1024 + k]); }
    __syncthreads();
    const float* w_ada = p.in[I_WADA];
    for (int it = c.vcu * 8 + c.wave; it < 768; it += c.G * 8) {
        const int b = c.lane & 31, half = c.lane >> 5, j0 = it * 8 + 4 * half;
        f32x4 acc = *(const f32x4*)(p.in[I_BADA] + j0);
#pragma unroll 8
        for (int k = 0; k < 1024; ++k) { const f32x4 w = *(const f32x4*)(w_ada + (size_t)k * 6144 + j0); acc += w * cs[k * 32 + b]; }
        *(f32x4*)((float*)(p.ws + WS_MOD) + b * 6144 + j0) = acc;
    }
    __syncthreads();
}
__device__ __forceinline__ void p0_prologue(const Params& p, const Ctx& c) {
    p0_mod(p, c);
    if (c.vcu >= c.G - 32) p0_s5_tables(p, c, c.G - 1 - c.vcu);
    { bf16_t* sw = (bf16_t*)(p.ws + WS_SGUW);
      for (int idx = c.vcu * NTHREADS + c.tid; idx < 8 * 128 * 128; idx += c.G * NTHREADS) { const int tt = (idx >> 7) & 127, ss = idx & 127; sw[idx] = (ss <= tt) ? (bf16_t)f2bf(p.in[I_SGUW][idx]) : (bf16_t)0; } }
    LAS float* scr = (LAS float*)(c.lds + c.wave * 16384);
    const int gw = c.vcu * NWAVES + c.wave, NGW = c.G * NWAVES;
    constexpr int I0 = 768, I1 = I0 + 1024, I2 = I1 + 128, I3 = I2 + 256, I4 = I3 + 256, I5 = I4 + 512, I6 = I5 + 8192, I7 = I6 + 8192, I8 = I7 + 8192;
    for (int it = gw; it < I8; it += NGW) {
        if (it < I0) { const int nb = 1536 / 32, r = it; transpose_item(p.in[I_WIN], 1024, 1536, (bf16_t*)(p.ws + WS_W1T), 32 * (r % nb), 64 * (r / nb), 32 * (r % nb), scr, c.lane); }
        else if (it < I1) { const int nb = 2048 / 32, r = it - I0; transpose_item(p.in[I_WGATE], 1024, 2048, (bf16_t*)(p.ws + WS_W1T), 1536 + 32 * (r % nb), 64 * (r / nb), 32 * (r % nb), scr, c.lane); }
        else if (it < I2) { const int nb = 512 / 32, r = it - I1; transpose_item(p.in[I_WGLU], 512, 512, (bf16_t*)(p.ws + WS_WGLUT), 32 * (r % nb), 64 * (r / nb), 32 * (r % nb), scr, c.lane); }
        else if (it < I3) { const int nb = 1024 / 32, r = it - I2; transpose_item(p.in[I_WBA], 512, 1024, (bf16_t*)(p.ws + WS_WBAT), 32 * (r % nb), 64 * (r / nb), 32 * (r % nb), scr, c.lane); }
        else if (it < I4) { const int nb = 1024 / 32, r = it - I3; transpose_item(p.in[I_WBB], 512, 1024, (bf16_t*)(p.ws + WS_WBBT), 32 * (r % nb), 64 * (r / nb), 32 * (r % nb), scr, c.lane); }
        else if (it < I5) { const int nb = 1024 / 32, r = it - I4; transpose_item(p.in[I_WOUT], 1024, 1024, (bf16_t*)(p.ws + WS_WOUTT), 32 * (r % nb), 64 * (r / nb), 32 * (r % nb), scr, c.lane); }
        else if (it < I7) { const bool is3 = it >= I6; const int r0 = it - (is3 ? I6 : I5), e = r0 >> 8, r = r0 & 255, nb = 512 / 32, n0 = 32 * (r % nb);
            transpose_item(p.in[is3 ? I_W3 : I_W1] + (size_t)e * 1024 * 512, 1024, 512, (bf16_t*)(p.ws + WS_WUPT) + (size_t)e * 1024 * 1024, (n0 >> 7) * 256 + (is3 ? 128 : 0) + (n0 & 127), 64 * (r / nb), n0, scr, c.lane); }
        else { const int r0 = it - I7, e = r0 >> 8, r = r0 & 255, nb = 1024 / 32;
            transpose_item(p.in[I_W2] + (size_t)e * 512 * 1024, 512, 1024, (bf16_t*)(p.ws + WS_WDNT) + (size_t)e * 1024 * 512, 32 * (r % nb), 64 * (r / nb), 32 * (r % nb), scr, c.lane); }
    }
}

__device__ __forceinline__ void p1_xn(const Params& p, const Ctx& c) {
    const float* mod = (const float*)(p.ws + WS_MOD); bf16_t* XN = (bf16_t*)(p.ws + WS_XN);
    for (int rb = c.vcu; rb < 256; rb += c.G) {
        const int b = rb >> 3;
        f32x4 A[4], Bc[4];
#pragma unroll
        for (int j = 0; j < 4; ++j) { const int k = 4 * c.lane + 256 * j; const f32x4 g = *(const f32x4*)(p.in[I_N1G] + k), sc = *(const f32x4*)(mod + b * 6144 + 1024 + k); A[j] = g * (sc + 1.0f); Bc[j] = *(const f32x4*)(mod + b * 6144 + k); }
        for (int i = 0; i < 32; ++i) {
            const size_t row = (size_t)rb * 256 + c.wave * 32 + i;
            const GAS f32x4* xr = (const GAS f32x4*)(p.in[I_X] + row * D) + c.lane;
            f32x4 v[4]; float s = 0.f;
#pragma unroll
            for (int j = 0; j < 4; ++j) { v[j] = xr[64 * j]; s += (v[j].x * v[j].x + v[j].y * v[j].y) + (v[j].z * v[j].z + v[j].w * v[j].w); }
            const float r = 1.0f / sqrtf(wave_sum(s) * (1.0f / D) + 1e-6f);
            GAS unsigned long long* o8 = (GAS unsigned long long*)(XN + row * D) + c.lane;
#pragma unroll
            for (int j = 0; j < 4; ++j) { const f32x4 y = v[j] * r * A[j] + Bc[j]; o8[64 * j] = (unsigned long long)pk2(y.x, y.y) | ((unsigned long long)pk2(y.z, y.w) << 32); }
        }
    }
}

template <bool PERM_> struct SchedStd {
    const char* A; const char* B; int lda, ldb, nM, nN, nt, G, c;
    __device__ __forceinline__ bool next(int i, Unit& u) const { int pm, pn; if (!mg::static_tile(i, G, c, nM, nN, pm, pn)) return false; u.pm = pm; u.pn = pn; u.nt = nt; u.aux = 0;
        u.A0 = A + (size_t)pm * 512 * lda; u.A1 = u.A0 + (size_t)256 * lda; u.B0 = B + (size_t)pn * 512 * ldb; u.B1 = u.B0 + (size_t)256 * ldb; return true; }
    __device__ __forceinline__ void voff(const Unit&, int tid, unsigned (&va)[1][2], unsigned (&vb)[2]) const { mg::std_voff<PERM_>(tid, lda, ldb, va, vb); }
};
#define EPI_ARGS const f32x4 (&acc)[2][2][4][2], const Unit& u, int wr, int wc, int fr, int fq
struct Epi1 { static constexpr bool PERM = true; bf16_t* ZA; bf16_t* U; bf16_t* GV; bf16_t* GATES; const float* b_gate;
    __device__ __forceinline__ void operator()(EPI_ARGS) const {
        const int pn = u.pn;
#pragma unroll
        for (int bj = 0; bj < 2; ++bj) {
            const int col0 = pn * 256 + bj * 128 + wc * 32 + 8 * fq;
            f32x4 b0 = (f32x4){0.f, 0.f, 0.f, 0.f}, b1 = b0;
            if (pn >= 6) { b0 = *(const f32x4*)(b_gate + col0 - 1536); b1 = *(const f32x4*)(b_gate + col0 - 1536 + 4); }
#pragma unroll
            for (int ai = 0; ai < 2; ++ai)
#pragma unroll
                for (int m = 0; m < 4; ++m) {
                    const int t = u.pm * 256 + ai * 128 + wr * 64 + m * 16 + fr;
                    f32x4 v0 = acc[ai][bj][m][0], v1 = acc[ai][bj][m][1];
                    if (pn < 2) { const int g = col0 >> 4, half = (col0 >> 3) & 1, bb = t >> 11, pp = t & 2047, cc = pp >> 6, sp = 63 - (pp & 63);
                        *(u32x4*)(ZA + ((size_t)(g * 1024 + bb * 32 + cc) * 1024 + sp * 16 + half * 8)) = pack8(v0, v1); }
                    else if (pn < 6) {
#pragma unroll
                        for (int j = 0; j < 4; ++j) { v0[j] = fgelu(v0[j]); v1[j] = fgelu(v1[j]); }
                        bf16_t* dst = (pn < 4) ? (U + (size_t)t * 512 + (col0 - 512)) : (GV + (size_t)t * 512 + (col0 - 1024));
                        *(u32x4*)dst = pack8(v0, v1); }
                    else {
#pragma unroll
                        for (int j = 0; j < 4; ++j) { v0[j] = fsigmoid(v0[j] + b0[j]); v1[j] = fsigmoid(v1[j] + b1[j]); }
                        *(u32x4*)(GATES + (size_t)t * 2048 + (col0 - 1536)) = pack8(v0, v1); }
                }
        }
    }
};
struct SchedS5a { const char* ZA; const char* TZ; const char* WS; int G, c;
    __device__ __forceinline__ void fill(int v, int k, Unit& u) const {
        const int pair = v >> 1, g = pair >> 2, rt = pair & 3;
        const int j = (v & 1) ? (k == 0 ? 1 : (k == 1 ? 0 : 4)) : (k == 0 ? 3 : 2);
        const int kt0 = (j < 4) ? 12 - 4 * j : 0;
        u.A0 = ZA + ((size_t)(g * 1024 + rt * 256) * 1024 + kt0 * 64) * 2; u.A1 = u.A0 + 128 * 2048;
        if (j < 4) { u.B0 = TZ + ((size_t)g * 32768 + 16 * j * 16 + kt0 * 64) * 2; u.B1 = u.B0 + 256; }
        else { u.B0 = WS + (size_t)g * 131072 * 2; u.B1 = u.B0; }
        u.nt = 16 - kt0; u.pm = g * 4 + rt; u.pn = j; u.aux = 0;
    }
    __device__ __forceinline__ bool next(int i, Unit& u) const { int k = i; for (int v = c; v < 256; v += G) { const int n = (v & 1) ? 3 : 2; if (k < n) { fill(v, k, u); return true; } k -= n; } return false; }
    __device__ __forceinline__ void voff(const Unit& u, int tid, unsigned (&va)[1][2], unsigned (&vb)[2]) const {
#pragma unroll
        for (int i = 0; i < 2; ++i) { int R, C; mg::stage_rc(tid * 16 + i * 8192, R, C); const int Rb = (R & ~31) + mg::perm32(R & 31);
            va[0][i] = (unsigned)(R * 1024 + C) * 2u; vb[i] = (u.pn < 4) ? (unsigned)((Rb & 15) * 2048 + (Rb >> 4) * 16 + C) * 2u : (unsigned)(Rb * 1024 + C) * 2u; }
    }
};
struct EpiS5a { static constexpr bool PERM = true; bf16_t* YI; float* SST;
    __device__ __forceinline__ void operator()(EPI_ARGS) const {
        const int j = u.pn;
#pragma unroll
        for (int ai = 0; ai < 2; ++ai)
#pragma unroll
            for (int m = 0; m < 4; ++m) { const size_t row = (size_t)u.pm * 256 + ai * 128 + wr * 64 + m * 16 + fr;
                if (j < 4) {
#pragma unroll
                    for (int bj = 0; bj < 2; ++bj) *(u32x4*)(YI + row * 1024 + j * 256 + bj * 128 + wc * 32 + 8 * fq) = pack8(acc[ai][bj][m][0], acc[ai][bj][m][1]);
                } else { float* d = SST + row * 128 + wc * 32 + 8 * fq; *(f32x4*)d = acc[ai][0][m][0]; *(f32x4*)(d + 4) = acc[ai][0][m][1]; }
            }
    }
};
struct SchedS5b { const char* HP; const char* WO; int G, c;
    __device__ __forceinline__ bool next(int i, Unit& u) const { const long L = (long)i * G + c; if (L >= 512) return false; const int g = (int)L >> 4, rt = ((int)L >> 2) & 3, j = (int)L & 3;
        u.A0 = HP + (size_t)(g * 1024 + rt * 256) * 512; u.A1 = u.A0 + 128 * 512; u.B0 = WO + (size_t)(g * 1024 + j * 256) * 512; u.B1 = u.B0 + 128 * 512; u.nt = 4; u.pm = g * 4 + rt; u.pn = j; u.aux = 0; return true; }
    __device__ __forceinline__ void voff(const Unit&, int tid, unsigned (&va)[1][2], unsigned (&vb)[2]) const { mg::std_voff<true>(tid, 256, 256, va, vb); }
};
struct EpiS5b { static constexpr bool PERM = true; const bf16_t* YI; bf16_t* YG;
    __device__ __forceinline__ void operator()(EPI_ARGS) const {
#pragma unroll
        for (int ai = 0; ai < 2; ++ai)
#pragma unroll
            for (int m = 0; m < 4; ++m) { const size_t row = (size_t)u.pm * 256 + ai * 128 + wr * 64 + m * 16 + fr;
#pragma unroll
                for (int bj = 0; bj < 2; ++bj) { const size_t off = row * 1024 + u.pn * 256 + bj * 128 + wc * 32 + 8 * fq;
                    f32x4 y0, y1; unpack8(*(const u32x4*)(YI + off), y0, y1); y0 += acc[ai][bj][m][0]; y1 += acc[ai][bj][m][1];
#pragma unroll
                    for (int q = 0; q < 4; ++q) { y0[q] = fgelu(y0[q]); y1[q] = fgelu(y1[q]); }
                    *(u32x4*)(YG + off) = pack8(y0, y1); }
            }
    }
};
struct SchedGlu { const char* YG; const char* B; int G, c;
    __device__ __forceinline__ bool next(int i, Unit& u) const { int pm, pn; if (!mg::static_tile(i, G, c, 256, 2, pm, pn)) return false; u.pm = pm; u.pn = pn; u.nt = 8; u.aux = 0;
        u.A0 = YG + (size_t)pm * 256 * 32; u.A1 = u.A0 + 128 * 32; u.B0 = B + (size_t)pn * 512 * 512; u.B1 = u.B0 + (size_t)256 * 512; return true; }
    __device__ __forceinline__ void voff(const Unit&, int tid, unsigned (&va)[1][2], unsigned (&vb)[2]) const {
#pragma unroll
        for (int i = 0; i < 2; ++i) { int R, C; mg::stage_rc(tid * 16 + i * 8192, R, C); const int Rb = (R & ~31) + mg::perm32(R & 31);
            va[0][i] = (unsigned)((C >> 4) * 1048576 + R * 16 + (C & 15)) * 2u; vb[i] = (unsigned)(Rb * 512 + C) * 2u; }
    }
};
struct EpiGlu { static constexpr bool PERM = true; const bf16_t* YG; bf16_t* YA; const float* b_glu;
    __device__ __forceinline__ void operator()(EPI_ARGS) const {
#pragma unroll
        for (int bj = 0; bj < 2; ++bj) { const int col0 = u.pn * 256 + bj * 128 + wc * 32 + 8 * fq;
            const f32x4 b0 = *(const f32x4*)(b_glu + col0), b1 = *(const f32x4*)(b_glu + col0 + 4);
#pragma unroll
            for (int ai = 0; ai < 2; ++ai)
#pragma unroll
                for (int m = 0; m < 4; ++m) { const size_t t = (size_t)u.pm * 256 + ai * 128 + wr * 64 + m * 16 + fr;
                    f32x4 y0, y1; unpack8(*(const u32x4*)(YG + ((size_t)(col0 >> 4) * 65536 + t) * 16 + (col0 & 15)), y0, y1);
                    f32x4 v0 = acc[ai][bj][m][0] + b0, v1 = acc[ai][bj][m][1] + b1;
#pragma unroll
                    for (int q = 0; q < 4; ++q) { v0[q] = y0[q] * fsigmoid(v0[q]); v1[q] = y1[q] * fsigmoid(v1[q]); }
                    *(u32x4*)(YA + t * 512 + col0) = pack8(v0, v1); }
        }
    }
};
template <int SECOND> struct EpiMerge { static constexpr bool PERM = true; const bf16_t* GATES; bf16_t* P1; bf16_t* MERGED;
    __device__ __forceinline__ void operator()(EPI_ARGS) const {
#pragma unroll
        for (int ai = 0; ai < 2; ++ai)
#pragma unroll
            for (int m = 0; m < 4; ++m) { const size_t t = (size_t)u.pm * 256 + ai * 128 + wr * 64 + m * 16 + fr;
#pragma unroll
                for (int bj = 0; bj < 2; ++bj) { const int col0 = u.pn * 256 + bj * 128 + wc * 32 + 8 * fq;
                    f32x4 g0, g1; unpack8(*(const u32x4*)(GATES + t * 2048 + SECOND * 1024 + col0), g0, g1);
                    f32x4 v0 = acc[ai][bj][m][0] * g0, v1 = acc[ai][bj][m][1] * g1;
                    if (SECOND) { f32x4 q0, q1; unpack8(*(const u32x4*)(P1 + t * 1024 + col0), q0, q1); v0 += q0; v1 += q1; *(u32x4*)(MERGED + t * 1024 + col0) = pack8(v0, v1); }
                    else *(u32x4*)(P1 + t * 1024 + col0) = pack8(v0, v1); }
            }
    }
};
struct EpiOut { static constexpr bool PERM = false; const float* x; const float* mod; float* H1;
    __device__ __forceinline__ void operator()(EPI_ARGS) const {
        const int bb = (u.pm * 256) >> 11;
#pragma unroll
        for (int bj = 0; bj < 2; ++bj)
#pragma unroll
            for (int n = 0; n < 2; ++n) { const int col = u.pn * 256 + bj * 128 + wc * 32 + 16 * n + 4 * fq;
                const f32x4 gt = *(const f32x4*)(mod + bb * 6144 + 2048 + col);
#pragma unroll
                for (int ai = 0; ai < 2; ++ai)
#pragma unroll
                    for (int m = 0; m < 4; ++m) { const size_t off = ((size_t)u.pm * 256 + ai * 128 + wr * 64 + m * 16 + fr) * 1024 + col;
                        *(f32x4*)(H1 + off) = *(const f32x4*)(x + off) + gt * acc[ai][bj][m][n]; }
            }
    }
};
struct MoeTab { const LAS int* cnt; const LAS int* tstart; };
__device__ __forceinline__ void moe_find(const MoeTab& mt, int rt, int& e, int& lt) { int ee = 0; for (int q = 1; q < 32; ++q) if (mt.tstart[q] <= rt) ee = q; e = ee; lt = rt - mt.tstart[ee]; }
struct SchedUp { const char* XN2; const char* WUPT; const int* rowtok; MoeTab mt; int G, c;
    __device__ __forceinline__ bool next(int i, Unit& u) const { const long L = (long)i * G + c; if (L >= 4l * mt.tstart[32]) return false; const int rt = (int)(L >> 2), pn = (int)L & 3; int e, lt; moe_find(mt, rt, e, lt);
        u.A0 = XN2; u.A1 = XN2; u.B0 = WUPT + ((size_t)(e * 1024 + pn * 256) * 1024) * 2; u.B1 = u.B0 + 128 * 2048; u.nt = 16; u.pm = rt; u.pn = pn; u.aux = e | (lt << 8); return true; }
    __device__ __forceinline__ void voff(const Unit& u, int tid, unsigned (&va)[2][2], unsigned (&vb)[2]) const {
        asm volatile("" : "+v"(tid));
        const int e = u.aux & 255, lt = u.aux >> 8, cn = mt.cnt[e];
#pragma unroll
        for (int i = 0; i < 2; ++i) { int R, C; mg::stage_rc(tid * 16 + i * 8192, R, C); const int Rb = (R & ~31) + mg::perm32(R & 31); vb[i] = (unsigned)(Rb * 1024 + C) * 2u;
#pragma unroll
            for (int h = 0; h < 2; ++h) { const int ri = lt * 256 + h * 128 + R; const int tok = (ri < cn) ? (rowtok[(size_t)e * ECAP + ri] >> 1) : 0; va[h][i] = (unsigned)tok * 2048u + (unsigned)C * 2u; } }
    }
};
struct EpiUp { static constexpr bool PERM = true; bf16_t* HID; const float* roww; MoeTab mt;
    __device__ __forceinline__ void operator()(EPI_ARGS) const {
        const int e = u.aux & 255, lt = u.aux >> 8, cn = mt.cnt[e];
#pragma unroll
        for (int ai = 0; ai < 2; ++ai)
#pragma unroll
            for (int m = 0; m < 4; ++m) { const int r = ai * 128 + wr * 64 + m * 16 + fr, ri = lt * 256 + r; const float w = (ri < cn) ? roww[(size_t)e * ECAP + ri] : 0.f;
                f32x4 h0, h1;
#pragma unroll
                for (int q = 0; q < 4; ++q) { h0[q] = fsilu(acc[ai][0][m][0][q]) * acc[ai][1][m][0][q] * w; h1[q] = fsilu(acc[ai][0][m][1][q]) * acc[ai][1][m][1][q] * w; }
                *(u32x4*)(HID + ((size_t)u.pm * 256 + r) * 512 + u.pn * 128 + wc * 32 + 8 * fq) = pack8(h0, h1); }
    }
};
struct SchedDn { const char* HID; const char* WDNT; MoeTab mt; int G, c;
    __device__ __forceinline__ bool next(int i, Unit& u) const { const long L = (long)i * G + c; if (L >= 4l * mt.tstart[32]) return false; const int rt = (int)(L >> 2), pn = (int)L & 3; int e, lt; moe_find(mt, rt, e, lt);
        u.A0 = HID + (size_t)rt * 256 * 1024; u.A1 = u.A0 + 128 * 1024; u.B0 = WDNT + ((size_t)(e * 1024 + pn * 256) * 512) * 2; u.B1 = u.B0 + 128 * 1024; u.nt = 8; u.pm = rt; u.pn = pn; u.aux = e | (lt << 8); return true; }
    __device__ __forceinline__ void voff(const Unit&, int tid, unsigned (&va)[1][2], unsigned (&vb)[2]) const { mg::std_voff<true>(tid, 512, 512, va, vb); }
};
struct EpiDn { static constexpr bool PERM = true; bf16_t* SLOT; const int* rowtok; MoeTab mt;
    __device__ __forceinline__ void operator()(EPI_ARGS) const {
        const int e = u.aux & 255, lt = u.aux >> 8, cn = mt.cnt[e];
#pragma unroll
        for (int ai = 0; ai < 2; ++ai)
#pragma unroll
            for (int m = 0; m < 4; ++m) { const int r = ai * 128 + wr * 64 + m * 16 + fr, ri = lt * 256 + r;
                if (ri < cn) { const size_t slot = (size_t)rowtok[(size_t)e * ECAP + ri];
#pragma unroll
                    for (int bj = 0; bj < 2; ++bj) *(u32x4*)(SLOT + slot * 1024 + u.pn * 256 + bj * 128 + wc * 32 + 8 * fq) = pack8(acc[ai][bj][m][0], acc[ai][bj][m][1]); }
            }
    }
};
__device__ __forceinline__ MoeTab moe_table(const Params& p, const Ctx& c) {
    LAS int* cnt = (LAS int*)(c.lds + XT_OFF); LAS int* ts = (LAS int*)(c.lds + XT_OFF + 256);
    if (c.tid < 32) cnt[c.tid] = (int)__hip_atomic_load((unsigned*)(p.ws + WS_CTL) + CW_CURSOR + 64 * c.tid, RLX_AGENT);
    __syncthreads();
    if (c.tid == 0) { int s = 0; for (int e = 0; e < 32; ++e) { ts[e] = s; s += (cnt[e] + 255) >> 8; } ts[32] = s; }
    __syncthreads();
    MoeTab mt; mt.cnt = cnt; mt.tstart = ts; return mt;
}

__device__ __forceinline__ void p4_scan(const Params& p, const Ctx& c) {
    typedef float f2 __attribute__((ext_vector_type(2)));
    const float* SST = (const float*)(p.ws + WS_SST); bf16_t* HP = (bf16_t*)(p.ws + WS_HP);
    for (int gid = c.vcu * NTHREADS + c.tid; gid < 65536; gid += c.G * NTHREADS) {
        const int g = gid >> 11, b = (gid >> 6) & 31, n = gid & 63;
        const f2 al = ((const f2*)(p.ws + WS_AL))[g * 64 + n];
        float hr = 0.f, hi = 0.f;
        for (int cc = 0; cc < 32; ++cc) { const size_t row = (size_t)g * 1024 + b * 32 + cc;
            HP[row * 256 + n] = (bf16_t)f2bf(hr); HP[row * 256 + 64 + n] = (bf16_t)f2bf(hi); HP[row * 256 + 128 + n] = 0; HP[row * 256 + 192 + n] = 0;
            const float sr = SST[row * 128 + n], si = SST[row * 128 + 64 + n];
            const float nr = al.x * hr - al.y * hi + sr, ni = al.x * hi + al.y * hr + si; hr = nr; hi = ni; }
    }
}

__device__ __forceinline__ void p7_sgu(const Params& p, const Ctx& c) {
    typedef float f32x16 __attribute__((ext_vector_type(16)));
    constexpr int VS = 136;
    LAS bf16_t* VT = (LAS bf16_t*)c.lds;
    const bf16_t* GV = (const bf16_t*)(p.ws + WS_GV); const bf16_t* U = (const bf16_t*)(p.ws + WS_U); bf16_t* YB = (bf16_t*)(p.ws + WS_YB);
    const bf16_t* SW = (const bf16_t*)(p.ws + WS_SGUW);
    const int lane = c.lane, w = c.wave;
    f32x4 lg0 = *(const f32x4*)(p.in[I_LNG] + 8 * lane), lg1 = *(const f32x4*)(p.in[I_LNG] + 8 * lane + 4), lb0 = *(const f32x4*)(p.in[I_LNB] + 8 * lane), lb1 = *(const f32x4*)(p.in[I_LNB] + 8 * lane + 4);
    for (int un = c.vcu; un < 512; un += c.G) {
        const size_t t0 = (size_t)un * 128;
        unsigned pk[8][8];
#pragma unroll
        for (int rr = 0; rr < 16; ++rr) {
            f32x4 a, b; unpack8(*(const u32x4*)(GV + (t0 + 16 * w + rr) * 512 + 8 * lane), a, b);
            const float mu = wave_sum((a[0] + a[1]) + (a[2] + a[3]) + (b[0] + b[1]) + (b[2] + b[3])) * (1.0f / 512.0f);
            a -= mu; b -= mu;
            const float var = wave_sum((a[0] * a[0] + a[1] * a[1]) + (a[2] * a[2] + a[3] * a[3]) + (b[0] * b[0] + b[1] * b[1]) + (b[2] * b[2] + b[3] * b[3])) * (1.0f / 512.0f);
            const float rs = 1.0f / sqrtf(var + 1e-5f);
            a = a * rs * lg0 + lb0; b = b * rs * lg1 + lb1;
#pragma unroll
            for (int j = 0; j < 4; ++j) {
                if (rr & 1) { pk[j][rr >> 1] |= f2bf(a[j]) << 16; pk[4 + j][rr >> 1] |= f2bf(b[j]) << 16; }
                else { pk[j][rr >> 1] = f2bf(a[j]); pk[4 + j][rr >> 1] = f2bf(b[j]); }
            }
        }
#pragma unroll
        for (int j = 0; j < 8; ++j) { LAS bf16_t* d = VT + (8 * lane + j) * VS + 16 * w;
            *(LAS u32x4*)d = (u32x4){pk[j][0], pk[j][1], pk[j][2], pk[j][3]}; *(LAS u32x4*)(d + 8) = (u32x4){pk[j][4], pk[j][5], pk[j][6], pk[j][7]}; }
        __syncthreads();
        const int tb = w & 3, db = w >> 2, l31 = lane & 31, hi = lane >> 5;
        for (int h = 0; h < 8; ++h) {
            f32x16 acc;
#pragma unroll
            for (int q = 0; q < 16; ++q) acc[q] = 0.f;
            const LAS bf16_t* arow = VT + (h * 64 + db * 32 + l31) * VS + 8 * hi;
            const bf16_t* brow = SW + ((size_t)(h * 128 + tb * 32 + l31)) * 128 + 8 * hi;
            for (int ks = 0; ks < 2 * tb + 2; ++ks) {
                const bf16x8 af = *(const LAS bf16x8*)(arow + 16 * ks), bfr = *(const bf16x8*)(brow + 16 * ks);
                acc = __builtin_amdgcn_mfma_f32_32x32x16_bf16(af, bfr, acc, 0, 0, 0);
            }
            const int tt = tb * 32 + l31; const float bs = p.in[I_SGUB][h * 128 + tt];
            const size_t rowoff = (t0 + tt) * 512 + h * 64 + db * 32 + 4 * hi;
#pragma unroll
            for (int q = 0; q < 4; ++q) {
                const u32x2 uu = *(const u32x2*)(U + rowoff + 8 * q);
                const float y0 = bf_lo(uu.x) * (acc[4 * q] + bs), y1 = bf_hi(uu.x) * (acc[4 * q + 1] + bs), y2 = bf_lo(uu.y) * (acc[4 * q + 2] + bs), y3 = bf_hi(uu.y) * (acc[4 * q + 3] + bs);
                *(u32x2*)(YB + rowoff + 8 * q) = (u32x2){cvt_pk_bf16(y0, y1), cvt_pk_bf16(y2, y3)};
            }
        }
        __syncthreads();
    }
}

__device__ __forceinline__ void p10_norm_router(const Params& p, const Ctx& c) {
    LAS f32x4* WR = (LAS f32x4*)c.lds;
    LAS int* RT = (LAS int*)(c.lds + 147456);
    LAS int* hist = (LAS int*)(c.lds + 147456 + 4096);
    const float* mod = (const float*)(p.ws + WS_MOD); const float* H1 = p.out; bf16_t* XN2 = (bf16_t*)(p.ws + WS_XN);
    int* rowtok = (int*)(p.ws + WS_ROWTOK); float* roww = (float*)(p.ws + WS_ROWW); unsigned* cursor = (unsigned*)(p.ws + WS_CTL) + CW_CURSOR;
    for (int idx = c.tid; idx < 16 * 9 * 64; idx += NTHREADS) { const int l = idx & 63, q = (idx >> 6) % 9, ji = idx / 576, k = 4 * l + (ji & 3) + 256 * (ji >> 2);
        WR[idx] = (q == 0) ? *(const f32x4*)(p.in[I_WRG] + k * 4) : *(const f32x4*)(p.in[I_WRE] + ((size_t)((q - 1) >> 1) * 1024 + k) * 8 + ((q - 1) & 1) * 4); }
    if (c.tid < 64) hist[c.tid] = 0;
    __syncthreads();
    for (int rb = c.vcu; rb < 256; rb += c.G) {
        const int b = rb >> 3;
        f32x4 A[4], Bc[4];
#pragma unroll
        for (int j = 0; j < 4; ++j) { const int k = 4 * c.lane + 256 * j; const f32x4 g = *(const f32x4*)(p.in[I_N2G] + k), sc = *(const f32x4*)(mod + b * 6144 + 4096 + k); A[j] = g * (sc + 1.0f); Bc[j] = *(const f32x4*)(mod + b * 6144 + 3072 + k); }
        for (int i = 0; i < 32; ++i) {
            const int rl = c.wave * 32 + i; const size_t row = (size_t)rb * 256 + rl;
            const GAS f32x4* xr = (const GAS f32x4*)(H1 + row * D) + c.lane;
            f32x4 v[4]; float s = 0.f;
#pragma unroll
            for (int j = 0; j < 4; ++j) { v[j] = xr[64 * j]; s += (v[j].x * v[j].x + v[j].y * v[j].y) + (v[j].z * v[j].z + v[j].w * v[j].w); }
            const float r = 1.0f / sqrtf(wave_sum(s) * (1.0f / D) + 1e-6f);
            GAS unsigned long long* o8 = (GAS unsigned long long*)(XN2 + row * D) + c.lane;
            f32x4 lg = (f32x4){0.f, 0.f, 0.f, 0.f};
#pragma unroll
            for (int j = 0; j < 4; ++j) { v[j] = v[j] * r * A[j] + Bc[j]; o8[64 * j] = (unsigned long long)pk2(v[j].x, v[j].y) | ((unsigned long long)pk2(v[j].z, v[j].w) << 32);
#pragma unroll
                for (int ii = 0; ii < 4; ++ii) lg += WR[((j * 4 + ii) * 9 + 0) * 64 + c.lane] * v[j][ii]; }
            float l4[4];
#pragma unroll
            for (int q = 0; q < 4; ++q) l4[q] = wave_sum(lg[q]) + p.in[I_BRG][q];
            int grp = 0; float mx = l4[0];
#pragma unroll
            for (int q = 1; q < 4; ++q) if (l4[q] > mx) { mx = l4[q]; grp = q; }
            float se = 0.f;
#pragma unroll
            for (int q = 0; q < 4; ++q) se += __expf(l4[q] - mx);
            const float pg = 1.0f / se;
            grp = __builtin_amdgcn_readfirstlane(grp);
            f32x4 e0 = (f32x4){0.f, 0.f, 0.f, 0.f}, e1 = e0;
#pragma unroll
            for (int j = 0; j < 4; ++j)
#pragma unroll
                for (int ii = 0; ii < 4; ++ii) { const LAS f32x4* wp = WR + ((j * 4 + ii) * 9 + 1 + 2 * grp) * 64 + c.lane; e0 += wp[0] * v[j][ii]; e1 += wp[64] * v[j][ii]; }
            float le[8];
#pragma unroll
            for (int q = 0; q < 4; ++q) { le[q] = wave_sum(e0[q]) + p.in[I_BRE2][grp * 8 + q]; le[4 + q] = wave_sum(e1[q]) + p.in[I_BRE2][grp * 8 + 4 + q]; }
            int i0 = 0; float v0 = le[0];
#pragma unroll
            for (int q = 1; q < 8; ++q) if (le[q] > v0) { v0 = le[q]; i0 = q; }
            int i1 = -1; float v1 = -3.0e38f;
#pragma unroll
            for (int q = 0; q < 8; ++q) if (q != i0 && le[q] > v1) { v1 = le[q]; i1 = q; }
            const float ex = __expf(v1 - v0), p0 = 1.0f / (1.0f + ex), p1 = ex / (1.0f + ex);
            if (c.lane == 0) { RT[rl * 4 + 0] = grp * 8 + i0; RT[rl * 4 + 1] = grp * 8 + i1; RT[rl * 4 + 2] = (int)__float_as_uint(pg * p0); RT[rl * 4 + 3] = (int)__float_as_uint(pg * p1); }
        }
        __syncthreads();
        int e0 = 0, e1 = 0, r0 = 0, r1 = 0;
        if (c.tid < 256) { e0 = RT[c.tid * 4]; e1 = RT[c.tid * 4 + 1]; r0 = __hip_atomic_fetch_add(&hist[e0], 1, __ATOMIC_RELAXED, __HIP_MEMORY_SCOPE_WORKGROUP); r1 = __hip_atomic_fetch_add(&hist[e1], 1, __ATOMIC_RELAXED, __HIP_MEMORY_SCOPE_WORKGROUP); }
        __syncthreads();
        if (c.tid < 32) hist[32 + c.tid] = (int)__hip_atomic_fetch_add(cursor + 64 * c.tid, (unsigned)hist[c.tid], RLX_AGENT);
        __syncthreads();
        if (c.tid < 256) { const int tok = rb * 256 + c.tid; const int p0 = hist[32 + e0] + r0, p1 = hist[32 + e1] + r1;
            rowtok[(size_t)e0 * ECAP + p0] = tok * 2; roww[(size_t)e0 * ECAP + p0] = __uint_as_float((unsigned)RT[c.tid * 4 + 2]);
            rowtok[(size_t)e1 * ECAP + p1] = tok * 2 + 1; roww[(size_t)e1 * ECAP + p1] = __uint_as_float((unsigned)RT[c.tid * 4 + 3]); }
        __syncthreads();
        if (c.tid < 32) hist[c.tid] = 0;
        __syncthreads();
    }
}

__device__ __forceinline__ void p14_final(const Params& p, const Ctx& c) {
    const float* mod = (const float*)(p.ws + WS_MOD); const bf16_t* SLOT = (const bf16_t*)(p.ws + WS_SLOT); float* out = p.out;
    for (int rb = c.vcu; rb < 256; rb += c.G) {
        const int b = rb >> 3;
        f32x4 gt[4], gf[4];
#pragma unroll
        for (int j = 0; j < 4; ++j) { const int k = 4 * c.lane + 256 * j; gt[j] = *(const f32x4*)(mod + b * 6144 + 5120 + k); gf[j] = *(const f32x4*)(p.in[I_NFG] + k); }
        for (int i = 0; i < 32; ++i) {
            const size_t row = (size_t)rb * 256 + c.wave * 32 + i;
            GAS f32x4* xr = (GAS f32x4*)(out + row * D) + c.lane;
            const GAS u32x2* s0 = (const GAS u32x2*)(SLOT + (row * 2) * D) + c.lane; const GAS u32x2* s1 = (const GAS u32x2*)(SLOT + (row * 2 + 1) * D) + c.lane;
            f32x4 v[4]; float s = 0.f;
#pragma unroll
            for (int j = 0; j < 4; ++j) { const u32x2 a = s0[64 * j], bq = s1[64 * j];
                const f32x4 y = (f32x4){bf_lo(a.x) + bf_lo(bq.x), bf_hi(a.x) + bf_hi(bq.x), bf_lo(a.y) + bf_lo(bq.y), bf_hi(a.y) + bf_hi(bq.y)};
                v[j] = xr[64 * j] + gt[j] * y; s += (v[j].x * v[j].x + v[j].y * v[j].y) + (v[j].z * v[j].z + v[j].w * v[j].w); }
            const float r = 1.0f / sqrtf(wave_sum(s) * (1.0f / D) + 1e-6f);
#pragma unroll
            for (int j = 0; j < 4; ++j) xr[64 * j] = v[j] * r * gf[j];
        }
    }
}
}
namespace fx {
constexpr int N_PHASES = 15;
struct KArgs { Params p; int region, pad; };
__global__ void __launch_bounds__(NTHREADS, 2) fwd(KArgs ka) {
    extern __shared__ __attribute__((aligned(16))) unsigned char lds_[];
    const Params& p = ka.p;
    Ctx c; c.lds = (LAS unsigned char*)lds_; c.tid = threadIdx.x; c.lane = c.tid & 63; c.wave = __builtin_amdgcn_readfirstlane(c.tid >> 6);
    c.G = gridDim.x; { const int bx = blockIdx.x; c.vcu = (c.G % 8 == 0) ? (bx % 8) * (c.G / 8) + bx / 8 : bx; }
    volatile LAS unsigned* MISC = (volatile LAS unsigned*)(c.lds + MISC_OFF);
    if (c.tid < 64) MISC[c.tid] = 0u;
    __syncthreads();
    unsigned* ctl = (unsigned*)(p.ws + WS_CTL);
    const int lo = p.ph_lo, hi = p.ph_hi;
    XcdBarrier bar; bar.bar = ctl + CW_BAR + ka.region * XCD_BAR_WORDS; bar.x = 0; bar.st = nullptr;
    if (hi - lo > 1) bar = xcd_barrier_post(ctl + CW_BAR + ka.region * XCD_BAR_WORDS, MISC + 8);
#ifndef PHASE_MASK
#define PHASE_MASK 0x7fff
#endif
#define IN(k) ((((PHASE_MASK) >> (k)) & 1) && lo <= (k) && (k) < hi)
#define SEAM(k) do { if (IN(k) && IN((k) + 1)) xcd_barrier(bar); } while (0)
    LAS unsigned char* ring = c.lds;
    const int G = c.G, bx = (int)blockIdx.x;
    const char* ws = (const char*)p.ws;
    if (IN(0)) { p0_prologue(p, c); } SEAM(0);
    if (IN(1)) { p1_xn(p, c); } SEAM(1);
    if (IN(2)) { SchedStd<true> S{ws + WS_XN, ws + WS_W1T, 1024, 1024, 256, 14, 16, G, bx};
        Epi1 E{(bf16_t*)(p.ws + WS_ZA), (bf16_t*)(p.ws + WS_U), (bf16_t*)(p.ws + WS_GV), (bf16_t*)(p.ws + WS_GATES), p.in[I_BGATE]};
        mg::gemm_phase<Epi1, SchedStd<true>, false, true>(ring, S, E, 128, 128); } SEAM(2);
    if (IN(3)) { SchedS5a S{ws + WS_ZA, ws + WS_TZ, ws + WS_WS, G, c.vcu}; EpiS5a E{(bf16_t*)(p.ws + WS_YI), (float*)(p.ws + WS_SST)};
        mg::gemm_phase<EpiS5a, SchedS5a, false, true>(ring, S, E, 128, 128); } SEAM(3);
    if (IN(4)) { p4_scan(p, c); } SEAM(4);
    if (IN(5)) { SchedS5b S{ws + WS_HP, ws + WS_WO, G, bx}; EpiS5b E{(const bf16_t*)(p.ws + WS_YI), (bf16_t*)(p.ws + WS_YG)};
        mg::gemm_phase<EpiS5b, SchedS5b, false, true>(ring, S, E, 128, 128); } SEAM(5);
    if (IN(6)) { SchedGlu S{ws + WS_YG, ws + WS_WGLUT, G, bx}; EpiGlu E{(const bf16_t*)(p.ws + WS_YG), (bf16_t*)(p.ws + WS_YA), p.in[I_BGLU]};
        mg::gemm_phase<EpiGlu, SchedGlu, false, true>(ring, S, E, (size_t)8388608, 128); } SEAM(6);
    if (IN(7)) { p7_sgu(p, c); } SEAM(7);
    if (IN(8)) { SchedStd<true> S{ws + WS_YA, ws + WS_WBAT, 512, 512, 256, 4, 8, G, bx}; EpiMerge<0> E{(const bf16_t*)(p.ws + WS_GATES), (bf16_t*)(p.ws + WS_P1), (bf16_t*)(p.ws + WS_MERGED)};
        mg::gemm_phase<EpiMerge<0>, SchedStd<true>, false, true>(ring, S, E, 128, 128); } SEAM(8);
    if (IN(9)) { SchedStd<true> S{ws + WS_YB, ws + WS_WBBT, 512, 512, 256, 4, 8, G, bx}; EpiMerge<1> E{(const bf16_t*)(p.ws + WS_GATES), (bf16_t*)(p.ws + WS_P1), (bf16_t*)(p.ws + WS_MERGED)};
        mg::gemm_phase<EpiMerge<1>, SchedStd<true>, false, true>(ring, S, E, 128, 128); } SEAM(9);
    if (IN(10)) { SchedStd<false> S{ws + WS_MERGED, ws + WS_WOUTT, 1024, 1024, 256, 4, 16, G, bx}; EpiOut E{p.in[I_X], (const float*)(p.ws + WS_MOD), p.out};
        mg::gemm_phase<EpiOut, SchedStd<false>, false, true>(ring, S, E, 128, 128); } SEAM(10);
    if (IN(11)) { p10_norm_router(p, c); } SEAM(11);
    if (IN(12)) { const MoeTab mt = moe_table(p, c); SchedUp S{ws + WS_XN, ws + WS_WUPT, (const int*)(p.ws + WS_ROWTOK), mt, G, bx}; EpiUp E{(bf16_t*)(p.ws + WS_HID), (const float*)(p.ws + WS_ROWW), mt};
        mg::gemm_phase<EpiUp, SchedUp, true, true>(ring, S, E, 128, 128); } SEAM(12);
    if (IN(13)) { const MoeTab mt = moe_table(p, c); SchedDn S{ws + WS_HID, ws + WS_WDNT, mt, G, bx}; EpiDn E{(bf16_t*)(p.ws + WS_SLOT), (const int*)(p.ws + WS_ROWTOK), mt};
        mg::gemm_phase<EpiDn, SchedDn, false, true>(ring, S, E, 128, 128); } SEAM(13);
    if (IN(14)) { p14_final(p, c); }
#undef IN
#undef SEAM
}
static int g_grid = 0;
static bool fast_setup() {
    if (g_grid != 0) return g_grid > 0;
    int dev = 0, cus = 0, per_cu = 0;
    if (hipGetDevice(&dev) != hipSuccess || hipDeviceGetAttribute(&cus, hipDeviceAttributeMultiprocessorCount, dev) != hipSuccess) { g_grid = -1; return false; }
    if (hipFuncSetAttribute((const void*)fwd, hipFuncAttributeMaxDynamicSharedMemorySize, LDS_BYTES) != hipSuccess) { fprintf(stderr, "hipFuncSetAttribute failed\n"); g_grid = -1; return false; }
    if (hipOccupancyMaxActiveBlocksPerMultiprocessor(&per_cu, (const void*)fwd, NTHREADS, LDS_BYTES) != hipSuccess || per_cu < 1) fprintf(stderr, "occupancy query: %d\n", per_cu);
    (void)hipGetLastError();
    g_grid = cus;
    return true;
}
static void fast_forward(void* const* d_in, float* out, unsigned char* ws, hipStream_t st, int lo, int hi, bool split, int region) {
    if (!fast_setup()) return;
    KArgs a{};
    for (int i = 0; i < 34; ++i) a.p.in[i] = (const float*)d_in[i];
    a.p.out = out; a.p.ws = ws; a.region = region; a.pad = 0;
    if (split) { for (int k = lo; k < hi; ++k) { a.p.ph_lo = k; a.p.ph_hi = k + 1; hipLaunchKernelGGL(fwd, dim3(g_grid), dim3(NTHREADS), LDS_BYTES, st, a); } }
    else { a.p.ph_lo = lo; a.p.ph_hi = hi; hipLaunchKernelGGL(fwd, dim3(g_grid), dim3(NTHREADS), LDS_BYTES, st, a); }
}
}
extern "C" void kernel_launch(void* const* d_in, const int* in_sizes, int n_in, void* d_out, int out_size, void* d_ws, size_t ws_size, hipStream_t stream) {
    (void)in_sizes; (void)n_in; (void)out_size; (void)ws_size;
    (void)hipMemsetAsync((char*)d_ws + fx::WS_CTL, 0, fx::CTL_ZERO_BYTES, stream);
    fx::fast_forward(d_in, (float*)d_out, (unsigned char*)d_ws, stream, 0, fx::N_PHASES, FAST_SPLIT, 0);
}
```

```cpp
#include <hip/hip_runtime.h>
#include <cstdint>
#include <cstdio>
#define FAST_SPLIT false
namespace mg {
#define MG_LAS __attribute__((address_space(3)))
typedef unsigned short bf16_t;
typedef short bf16x8 __attribute__((ext_vector_type(8)));
typedef float f32x4 __attribute__((ext_vector_type(4)));
typedef float f32x2 __attribute__((ext_vector_type(2)));
typedef unsigned u32x4 __attribute__((ext_vector_type(4)));
typedef unsigned u32x2 __attribute__((ext_vector_type(2)));
constexpr int BM = 256, BK = 64, HALF = 128, HTB = HALF * BK * 2, STAGE_BYTES = 8 * HTB;

__host__ __device__ __forceinline__ int lds_byte(int r, int c) { const int st = (r >> 4) * 2 + (c >> 5), rr = r & 15, cc = c & 31, ob = rr * 64 + cc * 2; return st * 1024 + (ob ^ (((ob >> 9) & 1) << 5)); }
__host__ __device__ __forceinline__ void stage_rc(int b, int& R, int& C) { const int st = b / 1024, sb = b % 1024, swz = sb ^ (((sb >> 9) & 1) << 5); R = (st >> 1) * 16 + swz / 64; C = (st & 1) * 32 + (swz % 64) / 2; }
__host__ __device__ __forceinline__ int perm32(int rho) { const int n = rho >> 4, i = rho & 15; return 8 * (i >> 2) + 4 * n + (i & 3); }

struct Unit { const char* A0; const char* A1; const char* B0; const char* B1; int nt, pm, pn, aux; };

__device__ __forceinline__ unsigned cvt_pk_bf16(float lo, float hi) { unsigned r; asm volatile("v_cvt_pk_bf16_f32 %0, %1, %2" : "=v"(r) : "v"(lo), "v"(hi)); return r; }
__device__ __forceinline__ float bf_lo(unsigned w) { return __uint_as_float(w << 16); }
__device__ __forceinline__ float bf_hi(unsigned w) { return __uint_as_float(w & 0xffff0000u); }
__device__ __forceinline__ float fsigmoid(float x) { return __builtin_amdgcn_rcpf(1.0f + __builtin_amdgcn_exp2f(-1.4426950408889634f * x)); }
__device__ __forceinline__ float fsilu(float x) { return x * fsigmoid(x); }
__device__ __forceinline__ float fgelu(float x) { const float u = x * (1.5957691216057308f + 0.07135481627260025f * x * x); return x * fsigmoid(u); }

template <class Epi, class Sched, bool GATHER, bool ALIGN_EPI>
__device__ __forceinline__ void gemm_phase(MG_LAS unsigned char* lds, const Sched& S, const Epi& E, const size_t kstepA, const size_t kstepB) {
    const int tid = threadIdx.x, wid = __builtin_amdgcn_readfirstlane(tid >> 6), lane = tid & 63, wr = wid >> 2, wc = wid & 3, fr = lane & 15, fq = lane >> 4;
    constexpr int NH = GATHER ? 2 : 1, H1 = GATHER ? 1 : 0;
    unsigned vA[NH][2], vB[2];
    const unsigned ldsw = (unsigned)wid * 1024u;
    const int aoff = lds_byte(wr * 64 + fr, fq * 8), boff = lds_byte(wc * 32 + fr, fq * 8);
#define MG_SA(b, h) (((b) * 2 + (h)) * HTB)
#define MG_SB(b, h) ((4 + (b) * 2 + (h)) * HTB)
#define MG_STAGE(bufoff, gbase, voff) do { _Pragma("unroll") for (int _i = 0; _i < 2; ++_i) \
        __builtin_amdgcn_global_load_lds((const unsigned*)((const char*)(gbase) + (voff)[_i]), (MG_LAS unsigned*)(lds + (bufoff) + ldsw + _i * 8192), 16, 0, 0); } while (0)
#define MG_LDA(dst, b, h) do { _Pragma("unroll") for (int m = 0; m < 4; ++m) _Pragma("unroll") for (int k = 0; k < 2; ++k) dst[m][k] = *(const MG_LAS bf16x8*)(lds + MG_SA(b, h) + aoff + m * 2048 + k * 1024); } while (0)
#define MG_LDB(dst, b, h) do { _Pragma("unroll") for (int n = 0; n < 2; ++n) _Pragma("unroll") for (int k = 0; k < 2; ++k) dst[n][k] = *(const MG_LAS bf16x8*)(lds + MG_SB(b, h) + boff + n * 2048 + k * 1024); } while (0)
#define MG_MMA(ai, bj, At, Bt) do { __builtin_amdgcn_s_setprio(1); _Pragma("unroll") for (int m = 0; m < 4; ++m) _Pragma("unroll") for (int n = 0; n < 2; ++n) _Pragma("unroll") for (int k = 0; k < 2; ++k) \
        acc[ai][bj][m][n] = __builtin_amdgcn_mfma_f32_16x16x32_bf16(Bt[n][k], At[m][k], acc[ai][bj][m][n], 0, 0, 0); __builtin_amdgcn_s_setprio(0); } while (0)
#define MG_WAIT_V(n) asm volatile("s_waitcnt vmcnt(" #n ")" ::: "memory")
#define MG_WAIT_L(n) asm volatile("s_waitcnt lgkmcnt(" #n ")" ::: "memory")
#define MG_BAR __builtin_amdgcn_s_barrier()
#define MG_SCHED __builtin_amdgcn_sched_barrier(0)
    Unit cur, nxt; int ui = 0;
    if (!S.next(0, cur)) return;
    f32x4 acc[2][2][4][2];
#pragma unroll
    for (int a = 0; a < 2; ++a)
#pragma unroll
        for (int b = 0; b < 2; ++b)
#pragma unroll
            for (int m = 0; m < 4; ++m)
#pragma unroll
                for (int n = 0; n < 2; ++n) acc[a][b][m][n] = (f32x4){0.f, 0.f, 0.f, 0.f};
    bf16x8 At[4][2], B0[2][2], B1[2][2];
    S.voff(cur, tid, vA, vB);
    MG_STAGE(MG_SB(0, 0), cur.B0, vB); MG_STAGE(MG_SB(0, 1), cur.B1, vB); MG_STAGE(MG_SA(0, 0), cur.A0, vA[0]); MG_STAGE(MG_SA(0, 1), cur.A1, vA[H1]);
    if (wr == 1) MG_BAR;
    MG_WAIT_V(2); MG_BAR;
    MG_STAGE(MG_SB(1, 0), cur.B0 + kstepB, vB); MG_STAGE(MG_SA(1, 0), cur.A0 + kstepA, vA[0]); MG_STAGE(MG_SB(1, 1), cur.B1 + kstepB, vB);
    MG_WAIT_V(6); MG_BAR;
    for (;;) {
        const bool has_next = S.next(ui + 1, nxt);
        if (!has_next) nxt = cur;
        const int nt = cur.nt;
        for (int t = 0; t < nt; t += 2) {
            const bool last = (t == nt - 2);
            const char* a1h = cur.A1 + (size_t)(t + 1) * kstepA;
            const char* a20 = last ? nxt.A0 : cur.A0 + (size_t)(t + 2) * kstepA; const char* a21 = last ? nxt.A1 : cur.A1 + (size_t)(t + 2) * kstepA;
            const char* b20 = last ? nxt.B0 : cur.B0 + (size_t)(t + 2) * kstepB; const char* b21 = last ? nxt.B1 : cur.B1 + (size_t)(t + 2) * kstepB;
            MG_LDB(B0, 0, 0); MG_LDB(B1, 0, 1); MG_SCHED; MG_LDA(At, 0, 0); MG_STAGE(MG_SA(1, 1), a1h, vA[H1]);
            if (last && has_next) S.voff(nxt, tid, vA, vB);
            MG_WAIT_V(8); MG_WAIT_L(0); MG_BAR; MG_MMA(0, 0, At, B0); MG_MMA(0, 1, At, B1); MG_BAR; MG_SCHED;
            MG_LDA(At, 0, 1); MG_STAGE(MG_SB(0, 0), b20, vB); MG_STAGE(MG_SB(0, 1), b21, vB); MG_STAGE(MG_SA(0, 0), a20, vA[0]);
            MG_WAIT_V(8); MG_WAIT_L(0); MG_BAR; MG_MMA(1, 0, At, B0); MG_MMA(1, 1, At, B1); MG_BAR; MG_SCHED;
            MG_LDB(B0, 1, 0); MG_LDB(B1, 1, 1); MG_SCHED; MG_LDA(At, 1, 0); MG_STAGE(MG_SA(0, 1), a21, vA[H1]);
            MG_WAIT_V(8); MG_WAIT_L(0); MG_BAR; MG_MMA(0, 0, At, B0); MG_MMA(0, 1, At, B1); MG_BAR; MG_SCHED;
            MG_LDA(At, 1, 1); MG_STAGE(MG_SB(1, 0), b20 + kstepB, vB); MG_STAGE(MG_SB(1, 1), b21 + kstepB, vB); MG_STAGE(MG_SA(1, 0), a20 + kstepA, vA[0]);
            MG_WAIT_V(8); MG_WAIT_L(0); MG_BAR; MG_MMA(1, 0, At, B0); MG_MMA(1, 1, At, B1); MG_BAR; MG_SCHED;
        }
        if constexpr (ALIGN_EPI) { if (wr == 0) MG_BAR; }
        { int fr_ = fr, fq_ = fq; asm volatile("" : "+v"(fr_), "+v"(fq_));
          E(acc, cur, wr, wc, fr_, fq_); }
        if (!has_next) break;
#pragma unroll
        for (int a = 0; a < 2; ++a)
#pragma unroll
            for (int b = 0; b < 2; ++b)
#pragma unroll
                for (int m = 0; m < 4; ++m)
#pragma unroll
                    for (int n = 0; n < 2; ++n) acc[a][b][m][n] = (f32x4){0.f, 0.f, 0.f, 0.f};
        cur = nxt; ++ui;
        if constexpr (ALIGN_EPI) { if (wr == 1) MG_BAR; }
    }
    MG_WAIT_V(0);
    if constexpr (!ALIGN_EPI) { if (wr == 0) MG_BAR; }
    MG_BAR;
#undef MG_SA
#undef MG_SB
#undef MG_STAGE
#undef MG_LDA
#undef MG_LDB
#undef MG_MMA
#undef MG_WAIT_V
#undef MG_WAIT_L
#undef MG_BAR
#undef MG_SCHED
}
template <bool PERM>
__device__ __forceinline__ void std_voff(int tid, int lda, int ldb, unsigned (&va)[1][2], unsigned (&vb)[2]) {
#pragma unroll
    for (int i = 0; i < 2; ++i) { int R, C; stage_rc(tid * 16 + i * 8192, R, C); const int Rb = PERM ? ((R & ~31) + perm32(R & 31)) : R;
        va[0][i] = (unsigned)(R * lda + C) * 2u; vb[i] = (unsigned)(Rb * ldb + C) * 2u; }
}
__device__ __forceinline__ bool static_tile(int i, int G, int c, int nM, int nN, int& pm, int& pn) {
    const int nwg = nM * nN; const long L = (long)i * G + c; if (L >= nwg) return false;
    int wgid = (int)L; { const int q = nwg / 8, r = nwg % 8, xcd = wgid % 8, off = wgid / 8; wgid = (xcd < r ? xcd * (q + 1) : r * (q + 1) + (xcd - r) * q) + off; }
    const int nig = 8 * nN, gid = wgid / nig, fm = gid * 8, gsz = (nM - fm) < 8 ? (nM - fm) : 8;
    pm = fm + ((wgid % nig) % gsz); pn = (wgid % nig) / gsz; return true;
}
}
namespace fx {
using mg::bf16_t; using mg::bf16x8; using mg::f32x4; using mg::f32x2; using mg::u32x4; using mg::u32x2; using mg::Unit;
#define GAS __attribute__((address_space(1)))
#define LAS __attribute__((address_space(3)))
typedef GAS unsigned gu32;
#define RLX_AGENT __ATOMIC_RELAXED, __HIP_MEMORY_SCOPE_AGENT
#define LDS_WAIT() asm volatile("s_waitcnt lgkmcnt(0)" ::: "memory")
#define VM_WAIT() asm volatile("s_waitcnt vmcnt(0)" ::: "memory")
constexpr int NWAVES = 8, NTHREADS = 512;
constexpr int T = 65536, D = 1024, SEQ = 2048, NB = 32;
constexpr int ECAP = 131072;
constexpr size_t MiB = 1u << 20;
constexpr size_t WS_CTL = 0, CTL_ZERO_BYTES = 1 * MiB;
constexpr size_t WS_MOD = 1 * MiB;
constexpr size_t WS_SGUW = 2 * MiB;
constexpr size_t WS_AL = 2 * MiB + 512 * 1024;
constexpr size_t WS_TZ = 4 * MiB;
constexpr size_t WS_WS = 6 * MiB;
constexpr size_t WS_WO = 14 * MiB;
constexpr size_t WS_W1T = 30 * MiB;
constexpr size_t WS_WGLUT = 37 * MiB;
constexpr size_t WS_WBAT = 38 * MiB, WS_WBBT = 39 * MiB;
constexpr size_t WS_WOUTT = 40 * MiB;
constexpr size_t WS_WUPT = 42 * MiB;
constexpr size_t WS_WDNT = 106 * MiB;
constexpr size_t WS_ROWTOK = 139 * MiB;
constexpr size_t WS_ROWW = 155 * MiB;
constexpr size_t WS_XN = 172 * MiB;
constexpr size_t WS_GATES = 300 * MiB;
constexpr size_t WS_ZA = 556 * MiB;
constexpr size_t WS_YG = WS_ZA;
constexpr size_t WS_U = 620 * MiB, WS_GV = 684 * MiB;
constexpr size_t WS_YI = 748 * MiB;
constexpr size_t WS_SST = 812 * MiB;
constexpr size_t WS_HP = 828 * MiB;
constexpr size_t WS_YA = 844 * MiB, WS_YB = 908 * MiB;
constexpr size_t WS_P1 = 620 * MiB;
constexpr size_t WS_MERGED = 748 * MiB;
constexpr size_t WS_HID = 300 * MiB;
constexpr size_t WS_SLOT = 556 * MiB;
constexpr size_t WS_END = 972 * MiB;
constexpr int CW_TMO = 0, CW_BAR = 4096, CW_CURSOR = 65536;
constexpr int RING_BYTES = 131072;
constexpr int LDS_BYTES = 163840;
constexpr int MISC_OFF = LDS_BYTES - 256;
constexpr int XT_OFF = RING_BYTES;

__device__ __forceinline__ unsigned f2bf(float f) { unsigned u = __builtin_bit_cast(unsigned, f); return (u + 0x7fffu + ((u >> 16) & 1u)) >> 16; }
__device__ __forceinline__ unsigned pk2(float lo, float hi) { return f2bf(lo) | (f2bf(hi) << 16); }
__device__ __forceinline__ float wave_sum(float v) {
#pragma unroll
    for (int o = 1; o < 64; o <<= 1) v += __shfl_xor(v, o);
    return v;
}
#define XB_TMO      128
#define XB_XCNT(j)  (256  + 64 * (j))
#define XB_XSUB(j)  (1280 + 64 * (j))
#define XB_XGEN(j)  (2304 + 64 * (j))
#define XB_TOP      3328
#define XB_TOPGEN   3392
#define XCD_BAR_WORDS 3456
#define XB_SPIN_CAP (1u << 18)
__device__ __forceinline__ unsigned xb_ld(unsigned* p)              { return __hip_atomic_load(p, __ATOMIC_RELAXED, __HIP_MEMORY_SCOPE_AGENT); }
__device__ __forceinline__ unsigned xb_add(unsigned* p, unsigned v) { return __hip_atomic_fetch_add(p, v, __ATOMIC_RELAXED, __HIP_MEMORY_SCOPE_AGENT); }
__device__ __forceinline__ unsigned xb_xcc_id() { return (unsigned)__builtin_amdgcn_s_getreg((3 << 11) | 20) & 0xFu; }
#define XB_SPIN(cond, bar) do { unsigned _sp = 0; while (cond) { __builtin_amdgcn_s_sleep(1); \
    if ((++_sp & 255u) == 0u) { if (xb_ld(&(bar)[XB_TMO])) break; if (_sp > XB_SPIN_CAP) { atomicAdd(&(bar)[XB_TMO], 1u); break; } } } } while (0)
struct XcdBarrier { unsigned* bar; unsigned x; volatile LAS unsigned* st; };
__device__ __forceinline__ XcdBarrier xcd_barrier_post(unsigned* bar, volatile LAS unsigned* st) {
    XcdBarrier b; b.bar = bar; b.x = xb_xcc_id(); b.st = st;
    if (threadIdx.x == 0) (void)xb_add(&bar[XB_XCNT(b.x)], 1u);
    return b;
}
__device__ __forceinline__ void xcd_barrier_complete(unsigned* bar, unsigned x, unsigned& nloc, unsigned& nx) {
    const unsigned G = gridDim.x * gridDim.y * gridDim.z;
    unsigned sum, cnt, mine, sp = 0u;
    for (;;) {
        sum = 0u; cnt = 0u; mine = 0u;
#pragma unroll
        for (unsigned j = 0; j < 16; ++j) { const unsigned c = xb_ld(&bar[XB_XCNT(j)]); sum += c; cnt += (c > 0u) ? 1u : 0u; mine = (j == x) ? c : mine; }
        if (sum == G) break;
        __builtin_amdgcn_s_sleep(1);
        if ((++sp & 255u) == 0u) { if (xb_ld(&bar[XB_TMO])) break; if (sp > XB_SPIN_CAP) { atomicAdd(&bar[XB_TMO], 1u); break; } }
    }
    nloc = mine > 0u ? mine : 1u; nx = cnt > 0u ? cnt : 1u;
}
__device__ __forceinline__ void xcd_barrier(const XcdBarrier& b) {
    asm volatile("s_waitcnt vmcnt(0)" ::: "memory");
    __syncthreads();
    if (threadIdx.x == 0) {
        unsigned* bar = b.bar;
        __builtin_amdgcn_s_waitcnt(0);
        unsigned nloc = b.st[0], nx = b.st[1];
        if (nloc == 0u) { xcd_barrier_complete(bar, b.x, nloc, nx); b.st[0] = nloc; b.st[1] = nx; }
        const unsigned old = xb_add(&bar[XB_XSUB(b.x)], 1u);
        const unsigned gen = old / nloc;
        if (old + 1u == (gen + 1u) * nloc) {
            __builtin_amdgcn_fence(__ATOMIC_RELEASE, "agent");
            asm volatile("s_waitcnt vmcnt(0)" ::: "memory");
            const unsigned og = xb_add(&bar[XB_TOP], 1u);
            const unsigned tg = og / nx;
            if (og + 1u == (tg + 1u) * nx) xb_add(&bar[XB_TOPGEN], 1u);
            else XB_SPIN(xb_ld(&bar[XB_TOPGEN]) == tg, bar);
            __builtin_amdgcn_fence(__ATOMIC_ACQUIRE, "agent");
            xb_add(&bar[XB_XGEN(b.x)], 1u);
            asm volatile("s_waitcnt vmcnt(0)" ::: "memory");
        } else {
            XB_SPIN(xb_ld(&bar[XB_XGEN(b.x)]) == gen, bar);
            __builtin_amdgcn_fence(__ATOMIC_ACQUIRE, "agent");
            asm volatile("s_waitcnt vmcnt(0)" ::: "memory");
        }
    }
    __syncthreads();
}

struct Params { const float* in[34]; float* out; unsigned char* ws; int ph_lo, ph_hi; };
enum { I_X = 0, I_C, I_WADA, I_BADA, I_N1G, I_WIN, I_WGATE, I_BGATE, I_ARE, I_AIM, I_BRE, I_BIM, I_CRE, I_CIM, I_DSK, I_LSTEP, I_WGLU, I_BGLU, I_LNG, I_LNB,
       I_SGUW, I_SGUB, I_WBA, I_WBB, I_WOUT, I_N2G, I_WRG, I_BRG, I_WRE, I_BRE2, I_W1, I_W3, I_W2, I_NFG };
}
namespace fx {
using mg::cvt_pk_bf16; using mg::fsigmoid; using mg::fsilu; using mg::fgelu; using mg::bf_lo; using mg::bf_hi;
struct Ctx { LAS unsigned char* lds; int tid, lane, wave, vcu, G; };

__device__ __forceinline__ u32x4 pack8(const f32x4& a, const f32x4& b) { u32x4 w; w.x = cvt_pk_bf16(a[0], a[1]); w.y = cvt_pk_bf16(a[2], a[3]); w.z = cvt_pk_bf16(b[0], b[1]); w.w = cvt_pk_bf16(b[2], b[3]); return w; }
__device__ __forceinline__ void unpack8(const u32x4& w, f32x4& a, f32x4& b) { a = (f32x4){bf_lo(w.x), bf_hi(w.x), bf_lo(w.y), bf_hi(w.y)}; b = (f32x4){bf_lo(w.z), bf_hi(w.z), bf_lo(w.w), bf_hi(w.w)}; }

__device__ __forceinline__ void transpose_item(const float* W, int K, int N, bf16_t* WT, int dest_row0, int k0, int n0, LAS float* scr, int lane) {
#pragma unroll 8
    for (int i = 0; i < 32; ++i) { const int kk = 2 * i + (lane >> 5); scr[kk * 33 + (lane & 31)] = W[(size_t)(k0 + kk) * N + n0 + (lane & 31)]; }
    LDS_WAIT(); asm volatile("" ::: "memory");
    const int c = lane & 7;
#pragma unroll
    for (int j = 0; j < 4; ++j) { const int n = (lane >> 3) + 8 * j; const LAS float* s = scr + (8 * c) * 33 + n;
        u32x4 o; o.x = pk2(s[0 * 33], s[1 * 33]); o.y = pk2(s[2 * 33], s[3 * 33]); o.z = pk2(s[4 * 33], s[5 * 33]); o.w = pk2(s[6 * 33], s[7 * 33]);
        *(GAS u32x4*)(WT + (size_t)(dest_row0 + n) * K + k0 + 8 * c) = o; }
    LDS_WAIT(); asm volatile("" ::: "memory");
}
__device__ __forceinline__ void p0_s5_tables(const Params& p, const Ctx& c, int g) {
    typedef float f2 __attribute__((ext_vector_type(2)));
    LAS f2* P = (LAS f2*)c.lds;
    LAS f2* BT = P + 64 * 66;
    LAS f2* CC = BT + 1024;
    const float* a_re = p.in[I_ARE]; const float* a_im = p.in[I_AIM]; const float* lstep = p.in[I_LSTEP];
    const int tid = c.tid;
    { const int n = tid & 63, tq = tid >> 6;
      const double lr = fmin((double)a_re[g * 64 + n], -1e-4), li = (double)a_im[g * 64 + n], dt = exp((double)lstep[g]);
      for (int tau = tq; tau <= 64; tau += 8) { const double m = exp(lr * dt * tau), ang = li * dt * tau; P[n * 66 + tau] = (f2){(float)(m * cos(ang)), (float)(m * sin(ang))}; } }
    for (int idx = tid; idx < 1024; idx += 512) {
        { const int n = idx >> 4, h = idx & 15;
          const double lr = fmin((double)a_re[g * 64 + n], -1e-4), li = (double)a_im[g * 64 + n], dt = exp((double)lstep[g]);
          const double mag = exp(lr * dt), abr = mag * cos(li * dt), abi = mag * sin(li * dt), den = lr * lr + li * li, nr = abr - 1.0;
          const double fr = (nr * lr + abi * li) / den, fi = (abi * lr - nr * li) / den;
          const double br = p.in[I_BRE][(g * 64 + n) * 16 + h], bi = p.in[I_BIM][(g * 64 + n) * 16 + h];
          BT[n * 16 + h] = (f2){(float)(fr * br - fi * bi), (float)(fr * bi + fi * br)}; }
        { const int h = idx >> 6, n = idx & 63; CC[h * 64 + n] = (f2){p.in[I_CRE][(g * 16 + h) * 64 + n], p.in[I_CIM][(g * 16 + h) * 64 + n]}; }
    }
    __syncthreads();
    if (tid < 64) ((f2*)(p.ws + WS_AL))[g * 64 + tid] = P[tid * 66 + 64];
    bf16_t* TZ = (bf16_t*)(p.ws + WS_TZ); bf16_t* WSg = (bf16_t*)(p.ws + WS_WS); bf16_t* WOg = (bf16_t*)(p.ws + WS_WO);
    { const int pair = tid & 255, h = pair >> 4, hp = pair & 15, th = tid >> 8;
      float acc[32];
#pragma unroll
      for (int i = 0; i < 32; ++i) acc[i] = 0.f;
      for (int n = 0; n < 64; ++n) {
          const f2 cc = CC[h * 64 + n], bb = BT[n * 16 + hp]; const float cbr = cc.x * bb.x - cc.y * bb.y, cbi = cc.x * bb.y + cc.y * bb.x;
#pragma unroll
          for (int i = 0; i < 32; ++i) { const f2 pw = P[n * 66 + 32 * th + i]; acc[i] += cbr * pw.x - cbi * pw.y; }
      }
      bf16_t* tz = TZ + ((size_t)(g * 16 + h) * 128) * 16 + hp;
      const float dk = p.in[I_DSK][g * 16 + h];
#pragma unroll
      for (int i = 0; i < 32; ++i) { const int tau = 32 * th + i; float v = acc[i]; if (tau == 0 && h == hp) v += dk; tz[(63 + tau) * 16] = (bf16_t)f2bf(v);
          const int jz = 32 * th + i; if (jz < 63) tz[jz * 16] = 0; }
      if (th == 1) tz[127 * 16] = 0;
    }
    for (int r = 0; r < 256; ++r) { const int idx = tid + 512 * r, row = idx >> 10, k = idx & 1023, n = row & 63, im = row >> 6, sp = k >> 4, hp = k & 15;
        const f2 pw = P[n * 66 + sp], bb = BT[n * 16 + hp]; const float v = im ? (pw.x * bb.y + pw.y * bb.x) : (pw.x * bb.x - pw.y * bb.y);
        WSg[((size_t)g * 128 + row) * 1024 + k] = (bf16_t)f2bf(v); }
    for (int r = 0; r < 512; ++r) { const int idx = tid + 512 * r, row = idx >> 8, k = idx & 255, t = row >> 4, h = row & 15; float v = 0.f;
        if (k < 128) { const int n = k & 63; const f2 cc = CC[h * 64 + n], pw = P[n * 66 + t + 1]; v = (k < 64) ? (cc.x * pw.x - cc.y * pw.y) : -(cc.x * pw.y + cc.y * pw.x); }
        WOg[((size_t)g * 1024 + row) * 256 + k] = (bf16_t)f2bf(v); }
    __syncthreads();
}
__device__ __forceinline__ void p0_mod(const Params& p, const Ctx& c) {
    if (c.vcu * 8 >= 768) return;
    LAS float* cs = (LAS float*)c.lds;
    for (int idx = c.tid; idx < 32768; idx += 512) { const int k = idx >> 5, b = idx & 31; cs[idx] = fsilu(p.in[I_C][b * 1024 + k]); }
    __syncthreads();
    const float* w_ada = p.in[I_WADA];
    for (int it = c.vcu * 8 + c.wave; it < 768; it += c.G * 8) {
        const int b = c.lane & 31, half = c.lane >> 5, j0 = it * 8 + 4 * half;
        f32x4 acc = *(const f32x4*)(p.in[I_BADA] + j0);
#pragma unroll 8
        for (int k = 0; k < 1024; ++k) { const f32x4 w = *(const f32x4*)(w_ada + (size_t)k * 6144 + j0); acc += w * cs[k * 32 + b]; }
        *(f32x4*)((float*)(p.ws + WS_MOD) + b * 6144 + j0) = acc;
    }
    __syncthreads();
}
__device__ __forceinline__ void p0_prologue(const Params& p, const Ctx& c) {
    p0_mod(p, c);
    if (c.vcu >= c.G - 32) p0_s5_tables(p, c, c.G - 1 - c.vcu);
    { bf16_t* sw = (bf16_t*)(p.ws + WS_SGUW);
      for (int idx = c.vcu * NTHREADS + c.tid; idx < 8 * 128 * 128; idx += c.G * NTHREADS) { const int tt = (idx >> 7) & 127, ss = idx & 127; sw[idx] = (ss <= tt) ? (bf16_t)f2bf(p.in[I_SGUW][idx]) : (bf16_t)0; } }
    LAS float* scr = (LAS float*)(c.lds + c.wave * 16384);
    const int gw = c.vcu * NWAVES + c.wave, NGW = c.G * NWAVES;
    constexpr int I0 = 768, I1 = I0 + 1024, I2 = I1 + 128, I3 = I2 + 256, I4 = I3 + 256, I5 = I4 + 512, I6 = I5 + 8192, I7 = I6 + 8192, I8 = I7 + 8192;
    for (int it = gw; it < I8; it += NGW) {
        if (it < I0) { const int nb = 1536 / 32, r = it; transpose_item(p.in[I_WIN], 1024, 1536, (bf16_t*)(p.ws + WS_W1T), 32 * (r % nb), 64 * (r / nb), 32 * (r % nb), scr, c.lane); }
        else if (it < I1) { const int nb = 2048 / 32, r = it - I0; transpose_item(p.in[I_WGATE], 1024, 2048, (bf16_t*)(p.ws + WS_W1T), 1536 + 32 * (r % nb), 64 * (r / nb), 32 * (r % nb), scr, c.lane); }
        else if (it < I2) { const int nb = 512 / 32, r = it - I1; transpose_item(p.in[I_WGLU], 512, 512, (bf16_t*)(p.ws + WS_WGLUT), 32 * (r % nb), 64 * (r / nb), 32 * (r % nb), scr, c.lane); }
        else if (it < I3) { const int nb = 1024 / 32, r = it - I2; transpose_item(p.in[I_WBA], 512, 1024, (bf16_t*)(p.ws + WS_WBAT), 32 * (r % nb), 64 * (r / nb), 32 * (r % nb), scr, c.lane); }
        else if (it < I4) { const int nb = 1024 / 32, r = it - I3; transpose_item(p.in[I_WBB], 512, 1024, (bf16_t*)(p.ws + WS_WBBT), 32 * (r % nb), 64 * (r / nb), 32 * (r % nb), scr, c.lane); }
        else if (it < I5) { const int nb = 1024 / 32, r = it - I4; transpose_item(p.in[I_WOUT], 1024, 1024, (bf16_t*)(p.ws + WS_WOUTT), 32 * (r % nb), 64 * (r / nb), 32 * (r % nb), scr, c.lane); }
        else if (it < I7) { const bool is3 = it >= I6; const int r0 = it - (is3 ? I6 : I5), e = r0 >> 8, r = r0 & 255, nb = 512 / 32, n0 = 32 * (r % nb);
            transpose_item(p.in[is3 ? I_W3 : I_W1] + (size_t)e * 1024 * 512, 1024, 512, (bf16_t*)(p.ws + WS_WUPT) + (size_t)e * 1024 * 1024, (n0 >> 7) * 256 + (is3 ? 128 : 0) + (n0 & 127), 64 * (r / nb), n0, scr, c.lane); }
        else { const int r0 = it - I7, e = r0 >> 8, r = r0 & 255, nb = 1024 / 32;
            transpose_item(p.in[I_W2] + (size_t)e * 512 * 1024, 512, 1024, (bf16_t*)(p.ws + WS_WDNT) + (size_t)e * 1024 * 512, 32 * (r % nb), 64 * (r / nb), 32 * (r % nb), scr, c.lane); }
    }
}

__device__ __forceinline__ void p1_xn(const Params& p, const Ctx& c) {
    const float* mod = (const float*)(p.ws + WS_MOD); bf16_t* XN = (bf16_t*)(p.ws + WS_XN);
    for (int rb = c.vcu; rb < 256; rb += c.G) {
        const int b = rb >> 3;
        f32x4 A[4], Bc[4];
#pragma unroll
        for (int j = 0; j < 4; ++j) { const int k = 4 * c.lane + 256 * j; const f32x4 g = *(const f32x4*)(p.in[I_N1G] + k), sc = *(const f32x4*)(mod + b * 6144 + 1024 + k); A[j] = g * (sc + 1.0f); Bc[j] = *(const f32x4*)(mod + b * 6144 + k); }
        for (int i = 0; i < 32; ++i) {
            const size_t row = (size_t)rb * 256 + c.wave * 32 + i;
            const GAS f32x4* xr = (const GAS f32x4*)(p.in[I_X] + row * D) + c.lane;
            f32x4 v[4]; float s = 0.f;
#pragma unroll
            for (int j = 0; j < 4; ++j) { v[j] = xr[64 * j]; s += (v[j].x * v[j].x + v[j].y * v[j].y) + (v[j].z * v[j].z + v[j].w * v[j].w); }
            const float r = 1.0f / sqrtf(wave_sum(s) * (1.0f / D) + 1e-6f);
            GAS unsigned long long* o8 = (GAS unsigned long long*)(XN + row * D) + c.lane;
#pragma unroll
            for (int j = 0; j < 4; ++j) { const f32x4 y = v[j] * r * A[j] + Bc[j]; o8[64 * j] = (unsigned long long)pk2(y.x, y.y) | ((unsigned long long)pk2(y.z, y.w) << 32); }
        }
    }
}

template <bool PERM_> struct SchedStd {
    const char* A; const char* B; int lda, ldb, nM, nN, nt, G, c;
    __device__ __forceinline__ bool next(int i, Unit& u) const { int pm, pn; if (!mg::static_tile(i, G, c, nM, nN, pm, pn)) return false; u.pm = pm; u.pn = pn; u.nt = nt; u.aux = 0;
        u.A0 = A + (size_t)pm * 512 * lda; u.A1 = u.A0 + (size_t)256 * lda; u.B0 = B + (size_t)pn * 512 * ldb; u.B1 = u.B0 + (size_t)256 * ldb; return true; }
    __device__ __forceinline__ void voff(const Unit&, int tid, unsigned (&va)[1][2], unsigned (&vb)[2]) const { mg::std_voff<PERM_>(tid, lda, ldb, va, vb); }
};
#define EPI_ARGS const f32x4 (&acc)[2][2][4][2], const Unit& u, int wr, int wc, int fr, int fq
struct Epi1 { static constexpr bool PERM = true; bf16_t* ZA; bf16_t* U; bf16_t* GV; bf16_t* GATES; const float* b_gate;
    __device__ __forceinline__ void operator()(EPI_ARGS) const {
        const int pn = u.pn;
#pragma unroll
        for (int bj = 0; bj < 2; ++bj) {
            const int col0 = pn * 256 + bj * 128 + wc * 32 + 8 * fq;
            f32x4 b0 = (f32x4){0.f, 0.f, 0.f, 0.f}, b1 = b0;
            if (pn >= 6) { b0 = *(const f32x4*)(b_gate + col0 - 1536); b1 = *(const f32x4*)(b_gate + col0 - 1536 + 4); }
#pragma unroll
            for (int ai = 0; ai < 2; ++ai)
#pragma unroll
                for (int m = 0; m < 4; ++m) {
                    const int t = u.pm * 256 + ai * 128 + wr * 64 + m * 16 + fr;
                    f32x4 v0 = acc[ai][bj][m][0], v1 = acc[ai][bj][m][1];
                    if (pn < 2) { const int g = col0 >> 4, half = (col0 >> 3) & 1, bb = t >> 11, pp = t & 2047, cc = pp >> 6, sp = 63 - (pp & 63);
                        *(u32x4*)(ZA + ((size_t)(g * 1024 + bb * 32 + cc) * 1024 + sp * 16 + half * 8)) = pack8(v0, v1); }
                    else if (pn < 6) {
#pragma unroll
                        for (int j = 0; j < 4; ++j) { v0[j] = fgelu(v0[j]); v1[j] = fgelu(v1[j]); }
                        bf16_t* dst = (pn < 4) ? (U + (size_t)t * 512 + (col0 - 512)) : (GV + (size_t)t * 512 + (col0 - 1024));
                        *(u32x4*)dst = pack8(v0, v1); }
                    else {
#pragma unroll
                        for (int j = 0; j < 4; ++j) { v0[j] = fsigmoid(v0[j] + b0[j]); v1[j] = fsigmoid(v1[j] + b1[j]); }
                        *(u32x4*)(GATES + (size_t)t * 2048 + (col0 - 1536)) = pack8(v0, v1); }
                }
        }
    }
};
struct SchedS5a { const char* ZA; const char* TZ; const char* WS; int G, c;
    __device__ __forceinline__ void fill(int v, int k, Unit& u) const {
        const int pair = v >> 1, g = pair >> 2, rt = pair & 3;
        const int j = (v & 1) ? (k == 0 ? 1 : (k == 1 ? 0 : 4)) : (k == 0 ? 3 : 2);
        const int kt0 = (j < 4) ? 12 - 4 * j : 0;
        u.A0 = ZA + ((size_t)(g * 1024 + rt * 256) * 1024 + kt0 * 64) * 2; u.A1 = u.A0 + 128 * 2048;
        if (j < 4) { u.B0 = TZ + ((size_t)g * 32768 + 16 * j * 16 + kt0 * 64) * 2; u.B1 = u.B0 + 256; }
        else { u.B0 = WS + (size_t)g * 131072 * 2; u.B1 = u.B0; }
        u.nt = 16 - kt0; u.pm = g * 4 + rt; u.pn = j; u.aux = 0;
    }
    __device__ __forceinline__ bool next(int i, Unit& u) const { int k = i; for (int v = c; v < 256; v += G) { const int n = (v & 1) ? 3 : 2; if (k < n) { fill(v, k, u); return true; } k -= n; } return false; }
    __device__ __forceinline__ void voff(const Unit& u, int tid, unsigned (&va)[1][2], unsigned (&vb)[2]) const {
#pragma unroll
        for (int i = 0; i < 2; ++i) { int R, C; mg::stage_rc(tid * 16 + i * 8192, R, C); const int Rb = (R & ~31) + mg::perm32(R & 31);
            va[0][i] = (unsigned)(R * 1024 + C) * 2u; vb[i] = (u.pn < 4) ? (unsigned)((Rb & 15) * 2048 + (Rb >> 4) * 16 + C) * 2u : (unsigned)(Rb * 1024 + C) * 2u; }
    }
};
struct EpiS5a { static constexpr bool PERM = true; bf16_t* YI; float* SST;
    __device__ __forceinline__ void operator()(EPI_ARGS) const {
        const int j = u.pn;
#pragma unroll
        for (int ai = 0; ai < 2; ++ai)
#pragma unroll
            for (int m = 0; m < 4; ++m) { const size_t row = (size_t)u.pm * 256 + ai * 128 + wr * 64 + m * 16 + fr;
                if (j < 4) {
#pragma unroll
                    for (int bj = 0; bj < 2; ++bj) *(u32x4*)(YI + row * 1024 + j * 256 + bj * 128 + wc * 32 + 8 * fq) = pack8(acc[ai][bj][m][0], acc[ai][bj][m][1]);
                } else { float* d = SST + row * 128 + wc * 32 + 8 * fq; *(f32x4*)d = acc[ai][0][m][0]; *(f32x4*)(d + 4) = acc[ai][0][m][1]; }
            }
    }
};
struct SchedS5b { const char* HP; const char* WO; int G, c;
    __device__ __forceinline__ bool next(int i, Unit& u) const { const long L = (long)i * G + c; if (L >= 512) return false; const int g = (int)L >> 4, rt = ((int)L >> 2) & 3, j = (int)L & 3;
        u.A0 = HP + (size_t)(g * 1024 + rt * 256) * 512; u.A1 = u.A0 + 128 * 512; u.B0 = WO + (size_t)(g * 1024 + j * 256) * 512; u.B1 = u.B0 + 128 * 512; u.nt = 4; u.pm = g * 4 + rt; u.pn = j; u.aux = 0; return true; }
    __device__ __forceinline__ void voff(const Unit&, int tid, unsigned (&va)[1][2], unsigned (&vb)[2]) const { mg::std_voff<true>(tid, 256, 256, va, vb); }
};
struct EpiS5b { static constexpr bool PERM = true; const bf16_t* YI; bf16_t* YG;
    __device__ __forceinline__ void operator()(EPI_ARGS) const {
#pragma unroll
        for (int ai = 0; ai < 2; ++ai)
#pragma unroll
            for (int m = 0; m < 4; ++m) { const size_t row = (size_t)u.pm * 256 + ai * 128 + wr * 64 + m * 16 + fr;
#pragma unroll
                for (int bj = 0; bj < 2; ++bj) { const size_t off = row * 1024 + u.pn * 256 + bj * 128 + wc * 32 + 8 * fq;
                    f32x4 y0, y1; unpack8(*(const u32x4*)(YI + off), y0, y1); y0 += acc[ai][bj][m][0]; y1 += acc[ai][bj][m][1];
#pragma unroll
                    for (int q = 0; q < 4; ++q) { y0[q] = fgelu(y0[q]); y1[q] = fgelu(y1[q]); }
                    *(u32x4*)(YG + off) = pack8(y0, y1); }
            }
    }
};
struct SchedGlu { const char* YG; const char* B; int G, c;
    __device__ __forceinline__ bool next(int i, Unit& u) const { int pm, pn; if (!mg::static_tile(i, G, c, 256, 2, pm, pn)) return false; u.pm = pm; u.pn = pn; u.nt = 8; u.aux = 0;
        u.A0 = YG + (size_t)pm * 256 * 32; u.A1 = u.A0 + 128 * 32; u.B0 = B + (size_t)pn * 512 * 512; u.B1 = u.B0 + (size_t)256 * 512; return true; }
    __device__ __forceinline__ void voff(const Unit&, int tid, unsigned (&va)[1][2], unsigned (&vb)[2]) const {
#pragma unroll
        for (int i = 0; i < 2; ++i) { int R, C; mg::stage_rc(tid * 16 + i * 8192, R, C); const int Rb = (R & ~31) + mg::perm32(R & 31);
            va[0][i] = (unsigned)((C >> 4) * 1048576 + R * 16 + (C & 15)) * 2u; vb[i] = (unsigned)(Rb * 512 + C) * 2u; }
    }
};
struct EpiGlu { static constexpr bool PERM = true; const bf16_t* YG; bf16_t* YA; const float* b_glu;
    __device__ __forceinline__ void operator()(EPI_ARGS) const {
#pragma unroll
        for (int bj = 0; bj < 2; ++bj) { const int col0 = u.pn * 256 + bj * 128 + wc * 32 + 8 * fq;
            const f32x4 b0 = *(const f32x4*)(b_glu + col0), b1 = *(const f32x4*)(b_glu + col0 + 4);
#pragma unroll
            for (int ai = 0; ai < 2; ++ai)
#pragma unroll
                for (int m = 0; m < 4; ++m) { const size_t t = (size_t)u.pm * 256 + ai * 128 + wr * 64 + m * 16 + fr;
                    f32x4 y0, y1; unpack8(*(const u32x4*)(YG + ((size_t)(col0 >> 4) * 65536 + t) * 16 + (col0 & 15)), y0, y1);
                    f32x4 v0 = acc[ai][bj][m][0] + b0, v1 = acc[ai][bj][m][1] + b1;
#pragma unroll
                    for (int q = 0; q < 4; ++q) { v0[q] = y0[q] * fsigmoid(v0[q]); v1[q] = y1[q] * fsigmoid(v1[q]); }
                    *(u32x4*)(YA + t * 512 + col0) = pack8(v0, v1); }
        }
    }
};
template <int SECOND> struct EpiMerge { static constexpr bool PERM = true; const bf16_t* GATES; bf16_t* P1; bf16_t* MERGED;
    __device__ __forceinline__ void operator()(EPI_ARGS) const {
#pragma unroll
        for (int ai = 0; ai < 2; ++ai)
#pragma unroll
            for (int m = 0; m < 4; ++m) { const size_t t = (size_t)u.pm * 256 + ai * 128 + wr * 64 + m * 16 + fr;
#pragma unroll
                for (int bj = 0; bj < 2; ++bj) { const int col0 = u.pn * 256 + bj * 128 + wc * 32 + 8 * fq;
                    f32x4 g0, g1; unpack8(*(const u32x4*)(GATES + t * 2048 + SECOND * 1024 + col0), g0, g1);
                    f32x4 v0 = acc[ai][bj][m][0] * g0, v1 = acc[ai][bj][m][1] * g1;
                    if (SECOND) { f32x4 q0, q1; unpack8(*(const u32x4*)(P1 + t * 1024 + col0), q0, q1); v0 += q0; v1 += q1; *(u32x4*)(MERGED + t * 1024 + col0) = pack8(v0, v1); }
                    else *(u32x4*)(P1 + t * 1024 + col0) = pack8(v0, v1); }
            }
    }
};
struct EpiOut { static constexpr bool PERM = false; const float* x; const float* mod; float* H1;
    __device__ __forceinline__ void operator()(EPI_ARGS) const {
        const int bb = (u.pm * 256) >> 11;
#pragma unroll
        for (int bj = 0; bj < 2; ++bj)
#pragma unroll
            for (int n = 0; n < 2; ++n) { const int col = u.pn * 256 + bj * 128 + wc * 32 + 16 * n + 4 * fq;
                const f32x4 gt = *(const f32x4*)(mod + bb * 6144 + 2048 + col);
#pragma unroll
                for (int ai = 0; ai < 2; ++ai)
#pragma unroll
                    for (int m = 0; m < 4; ++m) { const size_t off = ((size_t)u.pm * 256 + ai * 128 + wr * 64 + m * 16 + fr) * 1024 + col;
                        *(f32x4*)(H1 + off) = *(const f32x4*)(x + off) + gt * acc[ai][bj][m][n]; }
            }
    }
};
struct MoeTab { const LAS int* cnt; const LAS int* tstart; };
__device__ __forceinline__ void moe_find(const MoeTab& mt, int rt, int& e, int& lt) { int ee = 0; for (int q = 1; q < 32; ++q) if (mt.tstart[q] <= rt) ee = q; e = ee; lt = rt - mt.tstart[ee]; }
struct SchedUp { const char* XN2; const char* WUPT; const int* rowtok; MoeTab mt; int G, c;
    __device__ __forceinline__ bool next(int i, Unit& u) const { const long L = (long)i * G + c; if (L >= 4l * mt.tstart[32]) return false; const int rt = (int)(L >> 2), pn = (int)L & 3; int e, lt; moe_find(mt, rt, e, lt);
        u.A0 = XN2; u.A1 = XN2; u.B0 = WUPT + ((size_t)(e * 1024 + pn * 256) * 1024) * 2; u.B1 = u.B0 + 128 * 2048; u.nt = 16; u.pm = rt; u.pn = pn; u.aux = e | (lt << 8); return true; }
    __device__ __forceinline__ void voff(const Unit& u, int tid, unsigned (&va)[2][2], unsigned (&vb)[2]) const {
        asm volatile("" : "+v"(tid));
        const int e = u.aux & 255, lt = u.aux >> 8, cn = mt.cnt[e];
#pragma unroll
        for (int i = 0; i < 2; ++i) { int R, C; mg::stage_rc(tid * 16 + i * 8192, R, C); const int Rb = (R & ~31) + mg::perm32(R & 31); vb[i] = (unsigned)(Rb * 1024 + C) * 2u;
#pragma unroll
            for (int h = 0; h < 2; ++h) { const int ri = lt * 256 + h * 128 + R; const int tok = (ri < cn) ? (rowtok[(size_t)e * ECAP + ri] >> 1) : 0; va[h][i] = (unsigned)tok * 2048u + (unsigned)C * 2u; } }
    }
};
struct EpiUp { static constexpr bool PERM = true; bf16_t* HID; const float* roww; MoeTab mt;
    __device__ __forceinline__ void operator()(EPI_ARGS) const {
        const int e = u.aux & 255, lt = u.aux >> 8, cn = mt.cnt[e];
#pragma unroll
        for (int ai = 0; ai < 2; ++ai)
#pragma unroll
            for (int m = 0; m < 4; ++m) { const int r = ai * 128 + wr * 64 + m * 16 + fr, ri = lt * 256 + r; const float w = (ri < cn) ? roww[(size_t)e * ECAP + ri] : 0.f;
                f32x4 h0, h1;
#pragma unroll
                for (int q = 0; q < 4; ++q) { h0[q] = fsilu(acc[ai][0][m][0][q]) * acc[ai][1][m][0][q] * w; h1[q] = fsilu(acc[ai][0][m][1][q]) * acc[ai][1][m][1][q] * w; }
                *(u32x4*)(HID + ((size_t)u.pm * 256 + r) * 512 + u.pn * 128 + wc * 32 + 8 * fq) = pack8(h0, h1); }
    }
};
struct SchedDn { const char* HID; const char* WDNT; MoeTab mt; int G, c;
    __device__ __forceinline__ bool next(int i, Unit& u) const { const long L = (long)i * G + c; if (L >= 4l * mt.tstart[32]) return false; const int rt = (int)(L >> 2), pn = (int)L & 3; int e, lt; moe_find(mt, rt, e, lt);
        u.A0 = HID + (size_t)rt * 256 * 1024; u.A1 = u.A0 + 128 * 1024; u.B0 = WDNT + ((size_t)(e * 1024 + pn * 256) * 512) * 2; u.B1 = u.B0 + 128 * 1024; u.nt = 8; u.pm = rt; u.pn = pn; u.aux = e | (lt << 8); return true; }
    __device__ __forceinline__ void voff(const Unit&, int tid, unsigned (&va)[1][2], unsigned (&vb)[2]) const { mg::std_voff<true>(tid, 512, 512, va, vb); }
};
struct EpiDn { static constexpr bool PERM = true; bf16_t* SLOT; const int* rowtok; MoeTab mt;
    __device__ __forceinline__ void operator()(EPI_ARGS) const {
        const int e = u.aux & 255, lt = u.aux >> 8, cn = mt.cnt[e];
#pragma unroll
        for (int ai = 0; ai < 2; ++ai)
#pragma unroll
            for (int m = 0; m < 4; ++m) { const int r = ai * 128 + wr * 64 + m * 16 + fr, ri = lt * 256 + r;
                if (ri < cn) { const size_t slot = (size_t)rowtok[(size_t)e * ECAP + ri];
#pragma unroll
                    for (int bj = 0; bj < 2; ++bj) *(u32x4*)(SLOT + slot * 1024 + u.pn * 256 + bj * 128 + wc * 32 + 8 * fq) = pack8(acc[ai][bj][m][0], acc[ai][bj][m][1]); }
            }
    }
};
__device__ __forceinline__ MoeTab moe_table(const Params& p, const Ctx& c) {
    LAS int* cnt = (LAS int*)(c.lds + XT_OFF); LAS int* ts = (LAS int*)(c.lds + XT_OFF + 256);
    if (c.tid < 32) cnt[c.tid] = (int)__hip_atomic_load((unsigned*)(p.ws + WS_CTL) + CW_CURSOR + 64 * c.tid, RLX_AGENT);
    __syncthreads();
    if (c.tid == 0) { int s = 0; for (int e = 0; e < 32; ++e) { ts[e] = s; s += (cnt[e] + 255) >> 8; } ts[32] = s; }
    __syncthreads();
    MoeTab mt; mt.cnt = cnt; mt.tstart = ts; return mt;
}

__device__ __forceinline__ void p4_scan(const Params& p, const Ctx& c) {
    typedef float f2 __attribute__((ext_vector_type(2)));
    const float* SST = (const float*)(p.ws + WS_SST); bf16_t* HP = (bf16_t*)(p.ws + WS_HP);
    for (int gid = c.vcu * NTHREADS + c.tid; gid < 65536; gid += c.G * NTHREADS) {
        const int g = gid >> 11, b = (gid >> 6) & 31, n = gid & 63;
        const f2 al = ((const f2*)(p.ws + WS_AL))[g * 64 + n];
        float hr = 0.f, hi = 0.f;
        for (int cc = 0; cc < 32; ++cc) { const size_t row = (size_t)g * 1024 + b * 32 + cc;
            HP[row * 256 + n] = (bf16_t)f2bf(hr); HP[row * 256 + 64 + n] = (bf16_t)f2bf(hi); HP[row * 256 + 128 + n] = 0; HP[row * 256 + 192 + n] = 0;
            const float sr = SST[row * 128 + n], si = SST[row * 128 + 64 + n];
            const float nr = al.x * hr - al.y * hi + sr, ni = al.x * hi + al.y * hr + si; hr = nr; hi = ni; }
    }
}

__device__ __forceinline__ void p7_sgu(const Params& p, const Ctx& c) {
    typedef float f32x16 __attribute__((ext_vector_type(16)));
    constexpr int VS = 136;
    LAS bf16_t* VT = (LAS bf16_t*)c.lds;
    const bf16_t* GV = (const bf16_t*)(p.ws + WS_GV); const bf16_t* U = (const bf16_t*)(p.ws + WS_U); bf16_t* YB = (bf16_t*)(p.ws + WS_YB);
    const bf16_t* SW = (const bf16_t*)(p.ws + WS_SGUW);
    const int lane = c.lane, w = c.wave;
    f32x4 lg0 = *(const f32x4*)(p.in[I_LNG] + 8 * lane), lg1 = *(const f32x4*)(p.in[I_LNG] + 8 * lane + 4), lb0 = *(const f32x4*)(p.in[I_LNB] + 8 * lane), lb1 = *(const f32x4*)(p.in[I_LNB] + 8 * lane + 4);
    for (int un = c.vcu; un < 512; un += c.G) {
        const size_t t0 = (size_t)un * 128;
        unsigned pk[8][8];
#pragma unroll
        for (int rr = 0; rr < 16; ++rr) {
            f32x4 a, b; unpack8(*(const u32x4*)(GV + (t0 + 16 * w + rr) * 512 + 8 * lane), a, b);
            const float mu = wave_sum((a[0] + a[1]) + (a[2] + a[3]) + (b[0] + b[1]) + (b[2] + b[3])) * (1.0f / 512.0f);
            a -= mu; b -= mu;
            const float var = wave_sum((a[0] * a[0] + a[1] * a[1]) + (a[2] * a[2] + a[3] * a[3]) + (b[0] * b[0] + b[1] * b[1]) + (b[2] * b[2] + b[3] * b[3])) * (1.0f / 512.0f);
            const float rs = 1.0f / sqrtf(var + 1e-5f);
            a = a * rs * lg0 + lb0; b = b * rs * lg1 + lb1;
#pragma unroll
            for (int j = 0; j < 4; ++j) {
                if (rr & 1) { pk[j][rr >> 1] |= f2bf(a[j]) << 16; pk[4 + j][rr >> 1] |= f2bf(b[j]) << 16; }
                else { pk[j][rr >> 1] = f2bf(a[j]); pk[4 + j][rr >> 1] = f2bf(b[j]); }
            }
        }
#pragma unroll
        for (int j = 0; j < 8; ++j) { LAS bf16_t* d = VT + (8 * lane + j) * VS + 16 * w;
            *(LAS u32x4*)d = (u32x4){pk[j][0], pk[j][1], pk[j][2], pk[j][3]}; *(LAS u32x4*)(d + 8) = (u32x4){pk[j][4], pk[j][5], pk[j][6], pk[j][7]}; }
        __syncthreads();
        const int tb = w & 3, db = w >> 2, l31 = lane & 31, hi = lane >> 5;
        for (int h = 0; h < 8; ++h) {
            f32x16 acc;
#pragma unroll
            for (int q = 0; q < 16; ++q) acc[q] = 0.f;
            const LAS bf16_t* arow = VT + (h * 64 + db * 32 + l31) * VS + 8 * hi;
            const bf16_t* brow = SW + ((size_t)(h * 128 + tb * 32 + l31)) * 128 + 8 * hi;
            for (int ks = 0; ks < 2 * tb + 2; ++ks) {
                const bf16x8 af = *(const LAS bf16x8*)(arow + 16 * ks), bfr = *(const bf16x8*)(brow + 16 * ks);
                acc = __builtin_amdgcn_mfma_f32_32x32x16_bf16(af, bfr, acc, 0, 0, 0);
            }
            const int tt = tb * 32 + l31; const float bs = p.in[I_SGUB][h * 128 + tt];
            const size_t rowoff = (t0 + tt) * 512 + h * 64 + db * 32 + 4 * hi;
#pragma unroll
            for (int q = 0; q < 4; ++q) {
                const u32x2 uu = *(const u32x2*)(U + rowoff + 8 * q);
                const float y0 = bf_lo(uu.x) * (acc[4 * q] + bs), y1 = bf_hi(uu.x) * (acc[4 * q + 1] + bs), y2 = bf_lo(uu.y) * (acc[4 * q + 2] + bs), y3 = bf_hi(uu.y) * (acc[4 * q + 3] + bs);
                *(u32x2*)(YB + rowoff + 8 * q) = (u32x2){cvt_pk_bf16(y0, y1), cvt_pk_bf16(y2, y3)};
            }
        }
        __syncthreads();
    }
}

__device__ __forceinline__ void p10_norm_router(const Params& p, const Ctx& c) {
    LAS f32x4* WR = (LAS f32x4*)c.lds;
    LAS int* RT = (LAS int*)(c.lds + 147456);
    LAS int* hist = (LAS int*)(c.lds + 147456 + 4096);
    const float* mod = (const float*)(p.ws + WS_MOD); const float* H1 = p.out; bf16_t* XN2 = (bf16_t*)(p.ws + WS_XN);
    int* rowtok = (int*)(p.ws + WS_ROWTOK); float* roww = (float*)(p.ws + WS_ROWW); unsigned* cursor = (unsigned*)(p.ws + WS_CTL) + CW_CURSOR;
    for (int idx = c.tid; idx < 16 * 9 * 64; idx += NTHREADS) { const int l = idx & 63, q = (idx >> 6) % 9, ji = idx / 576, k = 4 * l + (ji & 3) + 256 * (ji >> 2);
        WR[idx] = (q == 0) ? *(const f32x4*)(p.in[I_WRG] + k * 4) : *(const f32x4*)(p.in[I_WRE] + ((size_t)((q - 1) >> 1) * 1024 + k) * 8 + ((q - 1) & 1) * 4); }
    if (c.tid < 64) hist[c.tid] = 0;
    __syncthreads();
    for (int rb = c.vcu; rb < 256; rb += c.G) {
        const int b = rb >> 3;
        f32x4 A[4], Bc[4];
#pragma unroll
        for (int j = 0; j < 4; ++j) { const int k = 4 * c.lane + 256 * j; const f32x4 g = *(const f32x4*)(p.in[I_N2G] + k), sc = *(const f32x4*)(mod + b * 6144 + 4096 + k); A[j] = g * (sc + 1.0f); Bc[j] = *(const f32x4*)(mod + b * 6144 + 3072 + k); }
        for (int i = 0; i < 32; ++i) {
            const int rl = c.wave * 32 + i; const size_t row = (size_t)rb * 256 + rl;
            const GAS f32x4* xr = (const GAS f32x4*)(H1 + row * D) + c.lane;
            f32x4 v[4]; float s = 0.f;
#pragma unroll
            for (int j = 0; j < 4; ++j) { v[j] = xr[64 * j]; s += (v[j].x * v[j].x + v[j].y * v[j].y) + (v[j].z * v[j].z + v[j].w * v[j].w); }
            const float r = 1.0f / sqrtf(wave_sum(s) * (1.0f / D) + 1e-6f);
            GAS unsigned long long* o8 = (GAS unsigned long long*)(XN2 + row * D) + c.lane;
            f32x4 lg = (f32x4){0.f, 0.f, 0.f, 0.f};
#pragma unroll
            for (int j = 0; j < 4; ++j) { v[j] = v[j] * r * A[j] + Bc[j]; o8[64 * j] = (unsigned long long)pk2(v[j].x, v[j].y) | ((unsigned long long)pk2(v[j].z, v[j].w) << 32);
#pragma unroll
                for (int ii = 0; ii < 4; ++ii) lg += WR[((j * 4 + ii) * 9 + 0) * 64 + c.lane] * v[j][ii]; }
            float l4[4];
#pragma unroll
            for (int q = 0; q < 4; ++q) l4[q] = wave_sum(lg[q]) + p.in[I_BRG][q];
            int grp = 0; float mx = l4[0];
#pragma unroll
            for (int q = 1; q < 4; ++q) if (l4[q] > mx) { mx = l4[q]; grp = q; }
            float se = 0.f;
#pragma unroll
            for (int q = 0; q < 4; ++q) se += __expf(l4[q] - mx);
            const float pg = 1.0f / se;
            grp = __builtin_amdgcn_readfirstlane(grp);
            f32x4 e0 = (f32x4){0.f, 0.f, 0.f, 0.f}, e1 = e0;
#pragma unroll
            for (int j = 0; j < 4; ++j)
#pragma unroll
                for (int ii = 0; ii < 4; ++ii) { const LAS f32x4* wp = WR + ((j * 4 + ii) * 9 + 1 + 2 * grp) * 64 + c.lane; e0 += wp[0] * v[j][ii]; e1 += wp[64] * v[j][ii]; }
            float le[8];
#pragma unroll
            for (int q = 0; q < 4; ++q) { le[q] = wave_sum(e0[q]) + p.in[I_BRE2][grp * 8 + q]; le[4 + q] = wave_sum(e1[q]) + p.in[I_BRE2][grp * 8 + 4 + q]; }
            int i0 = 0; float v0 = le[0];
#pragma unroll
            for (int q = 1; q < 8; ++q) if (le[q] > v0) { v0 = le[q]; i0 = q; }
            int i1 = -1; float v1 = -3.0e38f;
#pragma unroll
            for (int q = 0; q < 8; ++q) if (q != i0 && le[q] > v1) { v1 = le[q]; i1 = q; }
            const float ex = __expf(v1 - v0), p0 = 1.0f / (1.0f + ex), p1 = ex / (1.0f + ex);
            if (c.lane == 0) { RT[rl * 4 + 0] = grp * 8 + i0; RT[rl * 4 + 1] = grp * 8 + i1; RT[rl * 4 + 2] = (int)__float_as_uint(pg * p0); RT[rl * 4 + 3] = (int)__float_as_uint(pg * p1); }
        }
        __syncthreads();
        int e0 = 0, e1 = 0, r0 = 0, r1 = 0;
        if (c.tid < 256) { e0 = RT[c.tid * 4]; e1 = RT[c.tid * 4 + 1]; r0 = __hip_atomic_fetch_add(&hist[e0], 1, __ATOMIC_RELAXED, __HIP_MEMORY_SCOPE_WORKGROUP); r1 = __hip_atomic_fetch_add(&hist[e1], 1, __ATOMIC_RELAXED, __HIP_MEMORY_SCOPE_WORKGROUP); }
        __syncthreads();
        if (c.tid < 32) hist[32 + c.tid] = (int)__hip_atomic_fetch_add(cursor + 64 * c.tid, (unsigned)hist[c.tid], RLX_AGENT);
        __syncthreads();
        if (c.tid < 256) { const int tok = rb * 256 + c.tid; const int p0 = hist[32 + e0] + r0, p1 = hist[32 + e1] + r1;
            rowtok[(size_t)e0 * ECAP + p0] = tok * 2; roww[(size_t)e0 * ECAP + p0] = __uint_as_float((unsigned)RT[c.tid * 4 + 2]);
            rowtok[(size_t)e1 * ECAP + p1] = tok * 2 + 1; roww[(size_t)e1 * ECAP + p1] = __uint_as_float((unsigned)RT[c.tid * 4 + 3]); }
        __syncthreads();
        if (c.tid < 32) hist[c.tid] = 0;
        __syncthreads();
    }
}

__device__ __forceinline__ void p14_final(const Params& p, const Ctx& c) {
    const float* mod = (const float*)(p.ws + WS_MOD); const bf16_t* SLOT = (const bf16_t*)(p.ws + WS_SLOT); float* out = p.out;
    for (int rb = c.vcu; rb < 256; rb += c.G) {
        const int b = rb >> 3;
        f32x4 gt[4], gf[4];
#pragma unroll
        for (int j = 0; j < 4; ++j) { const int k = 4 * c.lane + 256 * j; gt[j] = *(const f32x4*)(mod + b * 6144 + 5120 + k); gf[j] = *(const f32x4*)(p.in[I_NFG] + k); }
        for (int i = 0; i < 32; ++i) {
            const size_t row = (size_t)rb * 256 + c.wave * 32 + i;
            GAS f32x4* xr = (GAS f32x4*)(out + row * D) + c.lane;
            const GAS u32x2* s0 = (const GAS u32x2*)(SLOT + (row * 2) * D) + c.lane; const GAS u32x2* s1 = (const GAS u32x2*)(SLOT + (row * 2 + 1) * D) + c.lane;
            f32x4 v[4]; float s = 0.f;
#pragma unroll
            for (int j = 0; j < 4; ++j) { const u32x2 a = s0[64 * j], bq = s1[64 * j];
                const f32x4 y = (f32x4){bf_lo(a.x) + bf_lo(bq.x), bf_hi(a.x) + bf_hi(bq.x), bf_lo(a.y) + bf_lo(bq.y), bf_hi(a.y) + bf_hi(bq.y)};
                v[j] = xr[64 * j] + gt[j] * y; s += (v[j].x * v[j].x + v[j].y * v[j].y) + (v[j].z * v[j].z + v[j].w * v[j].w); }
            const float r = 1.0f / sqrtf(wave_sum(s) * (1.0f / D) + 1e-6f);
#pragma unroll
            for (int j = 0; j < 4; ++j) xr[64 * j] = v[j] * r * gf[j];
        }
    }
}
}
namespace fx {
constexpr int N_PHASES = 15;
struct KArgs { Params p; int region, pad; };
__global__ void __launch_bounds__(NTHREADS, 2) fwd(KArgs ka) {
    extern __shared__ __attribute__((aligned(16))) unsigned char lds_[];
    const Params& p = ka.p;
    Ctx c; c.lds = (LAS unsigned char*)lds_; c.tid = threadIdx.x; c.lane = c.tid & 63; c.wave = __builtin_amdgcn_readfirstlane(c.tid >> 6);
    c.G = gridDim.x; { const int bx = blockIdx.x; c.vcu = (c.G % 8 == 0) ? (bx % 8) * (c.G / 8) + bx / 8 : bx; }
    volatile LAS unsigned* MISC = (volatile LAS unsigned*)(c.lds + MISC_OFF);
    if (c.tid < 64) MISC[c.tid] = 0u;
    __syncthreads();
    unsigned* ctl = (unsigned*)(p.ws + WS_CTL);
    const int lo = p.ph_lo, hi = p.ph_hi;
    XcdBarrier bar; bar.bar = ctl + CW_BAR + ka.region * XCD_BAR_WORDS; bar.x = 0; bar.st = nullptr;
    if (hi - lo > 1) bar = xcd_barrier_post(ctl + CW_BAR + ka.region * XCD_BAR_WORDS, MISC + 8);
#ifndef PHASE_MASK
#define PHASE_MASK 0x7fff
#endif
#define IN(k) ((((PHASE_MASK) >> (k)) & 1) && lo <= (k) && (k) < hi)
#define SEAM(k) do { if (IN(k) && IN((k) + 1)) xcd_barrier(bar); } while (0)
    LAS unsigned char* ring = c.lds;
    const int G = c.G, bx = (int)blockIdx.x;
    const char* ws = (const char*)p.ws;
    if (IN(0)) { p0_prologue(p, c); } SEAM(0);
    if (IN(1)) { p1_xn(p, c); } SEAM(1);
    if (IN(2)) { SchedStd<true> S{ws + WS_XN, ws + WS_W1T, 1024, 1024, 256, 14, 16, G, bx};
        Epi1 E{(bf16_t*)(p.ws + WS_ZA), (bf16_t*)(p.ws + WS_U), (bf16_t*)(p.ws + WS_GV), (bf16_t*)(p.ws + WS_GATES), p.in[I_BGATE]};
        mg::gemm_phase<Epi1, SchedStd<true>, false, true>(ring, S, E, 128, 128); } SEAM(2);
    if (IN(3)) { SchedS5a S{ws + WS_ZA, ws + WS_TZ, ws + WS_WS, G, c.vcu}; EpiS5a E{(bf16_t*)(p.ws + WS_YI), (float*)(p.ws + WS_SST)};
        mg::gemm_phase<EpiS5a, SchedS5a, false, true>(ring, S, E, 128, 128); } SEAM(3);
    if (IN(4)) { p4_scan(p, c); } SEAM(4);
    if (IN(5)) { SchedS5b S{ws + WS_HP, ws + WS_WO, G, bx}; EpiS5b E{(const bf16_t*)(p.ws + WS_YI), (bf16_t*)(p.ws + WS_YG)};
        mg::gemm_phase<EpiS5b, SchedS5b, false, true>(ring, S, E, 128, 128); } SEAM(5);
    if (IN(6)) { SchedGlu S{ws + WS_YG, ws + WS_WGLUT, G, bx}; EpiGlu E{(const bf16_t*)(p.ws + WS_YG), (bf16_t*)(p.ws + WS_YA), p.in[I_BGLU]};
        mg::gemm_phase<EpiGlu, SchedGlu, false, true>(ring, S, E, (size_t)8388608, 128); } SEAM(6);
    if (IN(7)) { p7_sgu(p, c); } SEAM(7);
    if (IN(8)) { SchedStd<true> S{ws + WS_YA, ws + WS_WBAT, 512, 512, 256, 4, 8, G, bx}; EpiMerge<0> E{(const bf16_t*)(p.ws + WS_GATES), (bf16_t*)(p.ws + WS_P1), (bf16_t*)(p.ws + WS_MERGED)};
        mg::gemm_phase<EpiMerge<0>, SchedStd<true>, false, true>(ring, S, E, 128, 128); } SEAM(8);
    if (IN(9)) { SchedStd<true> S{ws + WS_YB, ws + WS_WBBT, 512, 512, 256, 4, 8, G, bx}; EpiMerge<1> E{(const bf16_t*)(p.ws + WS_GATES), (bf16_t*)(p.ws + WS_P1), (bf16_t*)(p.ws + WS_MERGED)};
        mg::gemm_phase<EpiMerge<1>, SchedStd<true>, false, true>(ring, S, E, 128, 128); } SEAM(9);
    if (IN(10)) { SchedStd<false> S{ws + WS_MERGED, ws + WS_WOUTT, 1024, 1024, 256, 4, 16, G, bx}; EpiOut E{p.in[I_X], (const float*)(p.ws + WS_MOD), p.out};
        mg::gemm_phase<EpiOut, SchedStd<false>, false, true>(ring, S, E, 128, 128); } SEAM(10);
    if (IN(11)) { p10_norm_router(p, c); } SEAM(11);
    if (IN(12)) { const MoeTab mt = moe_table(p, c); SchedUp S{ws + WS_XN, ws + WS_WUPT, (const int*)(p.ws + WS_ROWTOK), mt, G, bx}; EpiUp E{(bf16_t*)(p.ws + WS_HID), (const float*)(p.ws + WS_ROWW), mt};
        mg::gemm_phase<EpiUp, SchedUp, true, true>(ring, S, E, 128, 128); } SEAM(12);
    if (IN(13)) { const MoeTab mt = moe_table(p, c); SchedDn S{ws + WS_HID, ws + WS_WDNT, mt, G, bx}; EpiDn E{(bf16_t*)(p.ws + WS_SLOT), (const int*)(p.ws + WS_ROWTOK), mt};
        mg::gemm_phase<EpiDn, SchedDn, false, true>(ring, S, E, 128, 128); } SEAM(13);
    if (IN(14)) { p14_final(p, c); }
#undef IN
#undef SEAM
}
static int g_grid = 0;
static bool fast_setup() {
    if (g_grid != 0) return g_grid > 0;
    int dev = 0, cus = 0, per_cu = 0;
    if (hipGetDevice(&dev) != hipSuccess || hipDeviceGetAttribute(&cus, hipDeviceAttributeMultiprocessorCount, dev) != hipSuccess) { g_grid = -1; return false; }
    if (hipFuncSetAttribute((const void*)fwd, hipFuncAttributeMaxDynamicSharedMemorySize, LDS_BYTES) != hipSuccess) { fprintf(stderr, "hipFuncSetAttribute failed\n"); g_grid = -1; return false; }
    if (hipOccupancyMaxActiveBlocksPerMultiprocessor(&per_cu, (const void*)fwd, NTHREADS, LDS_BYTES) != hipSuccess || per_cu < 1) fprintf(stderr, "occupancy query: %d\n", per_cu);
    (void)hipGetLastError();
    g_grid = cus;
    return true;
}
static void fast_forward(void* const* d_in, float* out, unsigned char* ws, hipStream_t st, int lo, int hi, bool split, int region) {
    if (!fast_setup()) return;
    KArgs a{};
    for (int i = 0; i < 34; ++i) a.p.in[i] = (const float*)d_in[i];
    a.p.out = out; a.p.ws = ws; a.region = region; a.pad = 0;
    if (split) { for (int k = lo; k < hi; ++k) { a.p.ph_lo = k; a.p.ph_hi = k + 1; hipLaunchKernelGGL(fwd, dim3(g_grid), dim3(NTHREADS), LDS_BYTES, st, a); } }
    else { a.p.ph_lo = lo; a.p.ph_hi = hi; hipLaunchKernelGGL(fwd, dim3(g_grid), dim3(NTHREADS), LDS_BYTES, st, a); }
}
}
extern "C" void kernel_launch(void* const* d_in, const int* in_sizes, int n_in, void* d_out, int out_size, void* d_ws, size_t ws_size, hipStream_t stream) {
    (void)in_sizes; (void)n_in; (void)out_size; (void)ws_size;
    (void)hipMemsetAsync((char*)d_ws + fx::WS_CTL, 0, fx::CTL_ZERO_BYTES, stream);
    fx::fast_forward(d_in, (float*)d_out, (unsigned char*)d_ws, stream, 0, fx::N_PHASES, FAST_SPLIT, 0);
}
```

```cpp
#include <hip/hip_runtime.h>
#include <cstdint>
#include <cstdio>
#define FAST_SPLIT false
namespace mg {
#define MG_LAS __attribute__((address_space(3)))
typedef unsigned short bf16_t;
typedef short bf16x8 __attribute__((ext_vector_type(8)));
typedef float f32x4 __attribute__((ext_vector_type(4)));
typedef float f32x2 __attribute__((ext_vector_type(2)));
typedef unsigned u32x4 __attribute__((ext_vector_type(4)));
typedef unsigned u32x2 __attribute__((ext_vector_type(2)));
typedef int i32x8 __attribute__((ext_vector_type(8)));
typedef int i32x4 __attribute__((ext_vector_type(4)));
template <bool C, class A, class B> struct cond_t { typedef A type; };
template <class A, class B> struct cond_t<false, A, B> { typedef B type; };
constexpr int BM = 256, BK = 64, HALF = 128, HTB = HALF * BK * 2, STAGE_BYTES = 8 * HTB;

template <int SW = 5> __host__ __device__ __forceinline__ int lds_byte(int r, int c) { const int st = (r >> 4) * 2 + (c >> 5), rr = r & 15, cc = c & 31, ob = rr * 64 + cc * 2; return st * 1024 + (ob ^ (((ob >> 9) & 1) << SW)); }
template <int SW = 5> __host__ __device__ __forceinline__ void stage_rc(int b, int& R, int& C) { const int st = b / 1024, sb = b % 1024, swz = sb ^ (((sb >> 9) & 1) << SW); R = (st >> 1) * 16 + swz / 64; C = (st & 1) * 32 + (swz % 64) / 2; }
template <class S_, class = void> struct vconst_t { static constexpr bool v = false; };
template <class S_> struct vconst_t<S_, decltype((void)S_::VOFF_CONST)> { static constexpr bool v = S_::VOFF_CONST; };
template <class S_, class = void> struct lists_t { static constexpr bool v = false; };
template <class S_> struct lists_t<S_, decltype((void)S_::LISTS)> { static constexpr bool v = S_::LISTS; };
template <class S_, class = void> struct swz8_t { static constexpr int v = 5; };
template <class S_> struct swz8_t<S_, decltype((void)S_::SWZ8)> { static constexpr int v = S_::SWZ8; };
__host__ __device__ __forceinline__ int perm32(int rho) { const int n = rho >> 4, i = rho & 15; return 8 * (i >> 2) + 4 * n + (i & 3); }

constexpr int KEEP_ACC = 1 << 30;
struct Unit { const char* A0; const char* A1; const char* B0; const char* B1; int nt, pm, pn, aux; };

__device__ __forceinline__ unsigned cvt_pk_bf16(float lo, float hi) { unsigned r; asm volatile("v_cvt_pk_bf16_f32 %0, %1, %2" : "=v"(r) : "v"(lo), "v"(hi)); return r; }
__device__ __forceinline__ float bf_lo(unsigned w) { return __uint_as_float(w << 16); }
__device__ __forceinline__ float bf_hi(unsigned w) { return __uint_as_float(w & 0xffff0000u); }
__device__ __forceinline__ float fsigmoid(float x) { return __builtin_amdgcn_rcpf(1.0f + __builtin_amdgcn_exp2f(-1.4426950408889634f * x)); }
__device__ __forceinline__ float q8(float x, float s, float is) { const int v = __builtin_amdgcn_cvt_pk_fp8_f32(x * s, 0.f, 0, false); return __builtin_amdgcn_cvt_f32_fp8(v, 0) * is; }
__device__ __forceinline__ float fsilu(float x) { return x * fsigmoid(x); }
__device__ __forceinline__ float fgelu(float x) { const float u = x * (1.5957691216057308f + 0.07135481627260025f * x * x); return x * fsigmoid(u); }

__device__ __forceinline__ f32x4 mfma_bf16(const bf16x8& a, const bf16x8& b, const f32x4& c) { return __builtin_amdgcn_mfma_f32_16x16x32_bf16(a, b, c, 0, 0, 0); }
__device__ __forceinline__ f32x4 mfma_bf16(const i32x8&, const i32x8&, const f32x4& c) { return c; }
#define st16(p, ...) (*(u32x4*)(p) = (__VA_ARGS__))
#define st16f(p, ...) (*(f32x4*)(p) = (__VA_ARGS__))
#define st8(p, ...) (*(u32x2*)(p) = (__VA_ARGS__))
__device__ __forceinline__ int lane_id() { int l; asm volatile("v_mbcnt_lo_u32_b32 %0, -1, 0\n\tv_mbcnt_hi_u32_b32 %0, -1, %0" : "=v"(l)); return l; }
template <class Epi, class Sched, bool GATHER, bool ALIGN_EPI, bool FP8 = false, bool KA128 = true>
__device__ __forceinline__ void gemm_phase(const int wid, MG_LAS unsigned char* lds, const Sched& S, const Epi& E, const size_t kstepA, const size_t kstepB, const int sclA = 127, const int sclB = 127) {
    const int lane = lane_id(), tid = wid * 64 + lane, wr = wid >> 2, wc = wid & 3, fr = lane & 15, fq = lane >> 4;
    constexpr int NH = GATHER ? 2 : 1, H1 = GATHER ? 1 : 0;
    unsigned vA[NH][2], vB[2];
    const unsigned ldsw = (unsigned)wid * 1024u;
#define MG_SA(b, h) (((b) * 2 + (h)) * HTB)
#define MG_SB(b, h) ((4 + (b) * 2 + (h)) * HTB)
#define MG_STAGE(bufoff, gbase, voff, IMM) do { _Pragma("unroll") for (int _i = 0; _i < 2; ++_i) { unsigned vo_ = (voff)[_i]; asm volatile("" : "+v"(vo_));     \
        __builtin_amdgcn_global_load_lds((const unsigned*)((const char*)(gbase) + vo_), (MG_LAS unsigned*)(lds + (bufoff) + ldsw + _i * 8192 - (IMM)), 16, IMM, 0); } } while (0)
#define MG_STAGE_AK(bufoff, gbase, voff) do { if constexpr (KA128) MG_STAGE(bufoff, gbase, voff, 128); else MG_STAGE(bufoff, (gbase) + kstepA, voff, 0); } while (0)
#define MG_STAGE_BK(bufoff, gbase, voff) MG_STAGE(bufoff, gbase, voff, 128)
#define MG_LDA(dst, b, h) do { if constexpr (FP8) { _Pragma("unroll") for (int m = 0; m < 4; ++m) { const i32x4 lo_ = *(const MG_LAS i32x4*)(pA + MG_SA(b, h) + m * 2048), hi_ = *(const MG_LAS i32x4*)(((SW == 4) ? pAx : pA + 16) + MG_SA(b, h) + m * 2048); dst[m][0] = __builtin_shufflevector(lo_, hi_, 0, 1, 2, 3, 4, 5, 6, 7); } } \
        else { _Pragma("unroll") for (int m = 0; m < 4; ++m) _Pragma("unroll") for (int k = 0; k < 2; ++k) dst[m][k] = *(const MG_LAS FragT*)(pA + MG_SA(b, h) + m * 2048 + k * 1024); } } while (0)
#define MG_LDB(dst, b, h) do { if constexpr (FP8) { _Pragma("unroll") for (int n = 0; n < 2; ++n) { const i32x4 lo_ = *(const MG_LAS i32x4*)(pB + (MG_SB(b, h) - 4 * HTB) + n * 2048), hi_ = *(const MG_LAS i32x4*)(((SW == 4) ? pBx : pB + 16) + (MG_SB(b, h) - 4 * HTB) + n * 2048); dst[n][0] = __builtin_shufflevector(lo_, hi_, 0, 1, 2, 3, 4, 5, 6, 7); } } \
        else { _Pragma("unroll") for (int n = 0; n < 2; ++n) _Pragma("unroll") for (int k = 0; k < 2; ++k) dst[n][k] = *(const MG_LAS FragT*)(pB + (MG_SB(b, h) - 4 * HTB) + n * 2048 + k * 1024); } } while (0)
#define MG_MMA(ai, bj, At, Bt) do { __builtin_amdgcn_s_setprio(1); _Pragma("unroll") for (int m = 0; m < 4; ++m) _Pragma("unroll") for (int n = 0; n < 2; ++n) { \
        if constexpr (FP8) acc[ai][bj][m][n] = __builtin_amdgcn_mfma_scale_f32_16x16x128_f8f6f4(Bt[n][0], At[m][0], acc[ai][bj][m][n], 0, 0, 0, sclB, 0, sclA); \
        else { _Pragma("unroll") for (int k = 0; k < 2; ++k) acc[ai][bj][m][n] = mfma_bf16(Bt[n][k], At[m][k], acc[ai][bj][m][n]); } } __builtin_amdgcn_s_setprio(0); } while (0)
#define MG_WAIT_V(n) asm volatile("s_waitcnt vmcnt(" #n ")" ::: "memory")
#define MG_WAIT_L(n) asm volatile("s_waitcnt lgkmcnt(" #n ")" ::: "memory")
#define MG_BAR __builtin_amdgcn_s_barrier()
#define MG_SCHED __builtin_amdgcn_sched_barrier(0)
    Unit cur, nxt; int ui = 0;
    if (!S.next(0, cur)) return;
    if constexpr (lists_t<Sched>::v) { S.list_dma(cur, wid, lane_id()); asm volatile("s_waitcnt vmcnt(0)" ::: "memory"); __builtin_amdgcn_s_barrier(); asm volatile("" ::: "memory"); }
    typename Epi::Pre pre;
    f32x4 acc[2][2][4][2];
#pragma unroll
    for (int a = 0; a < 2; ++a)
#pragma unroll
        for (int b = 0; b < 2; ++b)
#pragma unroll
            for (int m = 0; m < 4; ++m)
#pragma unroll
                for (int n = 0; n < 2; ++n) acc[a][b][m][n] = (f32x4){0.f, 0.f, 0.f, 0.f};
    typedef typename cond_t<FP8, i32x8, bf16x8>::type FragT; constexpr int NK = FP8 ? 1 : 2;
    FragT At[4][NK], B0[2][NK], B1[2][NK];
    S.voff(cur, tid, vA, vB);
    MG_STAGE(MG_SB(0, 0), cur.B0, vB, 0); MG_STAGE(MG_SB(0, 1), cur.B1, vB, 0); MG_STAGE(MG_SA(0, 0), cur.A0, vA[0], 0); MG_STAGE(MG_SA(0, 1), cur.A1, vA[H1], 0);
    if (wr == 1) MG_BAR;
    MG_WAIT_V(2); MG_BAR;
    MG_STAGE_BK(MG_SB(1, 0), cur.B0, vB); MG_STAGE_AK(MG_SA(1, 0), cur.A0, vA[0]); MG_STAGE_BK(MG_SB(1, 1), cur.B1, vB);
    MG_WAIT_V(6); MG_BAR;
    constexpr int SW = FP8 ? swz8_t<Sched>::v : 5;
    const int l2_ = lane_id(), fr2_ = l2_ & 15, fq2_ = l2_ >> 4;
    const int aoff = lds_byte<SW>(wr * 64 + fr2_, FP8 ? fq2_ * 16 : fq2_ * 8), boff = lds_byte<SW>(wc * 32 + fr2_, FP8 ? fq2_ * 16 : fq2_ * 8);
    const MG_LAS unsigned char* pA = lds + aoff; const MG_LAS unsigned char* pB = lds + 4 * HTB + boff;
    const MG_LAS unsigned char* pAx = lds + ((SW == 4) ? (aoff ^ 16) : aoff + 16); const MG_LAS unsigned char* pBx = lds + 4 * HTB + ((SW == 4) ? (boff ^ 16) : boff + 16);
    asm volatile("" : "+v"(pA), "+v"(pB)); if constexpr (FP8 && SW == 4) asm volatile("" : "+v"(pAx), "+v"(pBx)); (void)pAx; (void)pBx;
    for (;;) {
        const bool has_next = S.next(ui + 1, nxt);
        if constexpr (lists_t<Sched>::v) { if (has_next) S.list_dma(nxt, wid, lane_id()); }
        if (!has_next) nxt = cur;
        const int nt = cur.nt;
        for (int t = 0; t < nt; t += 2) {
            const bool last = (t == nt - 2);
            const char* a1h = cur.A1 + (size_t)t * kstepA;
            const char* a20 = last ? nxt.A0 : cur.A0 + (size_t)(t + 2) * kstepA; const char* a21 = last ? nxt.A1 : cur.A1 + (size_t)(t + 2) * kstepA;
            const char* b20 = last ? nxt.B0 : cur.B0 + (size_t)(t + 2) * kstepB; const char* b21 = last ? nxt.B1 : cur.B1 + (size_t)(t + 2) * kstepB;
            MG_LDB(B0, 0, 0); MG_LDB(B1, 0, 1); MG_SCHED; MG_LDA(At, 0, 0); MG_STAGE_AK(MG_SA(1, 1), a1h, vA[H1]);
            if constexpr (!vconst_t<Sched>::v) { if (last && has_next) S.voff(nxt, tid, vA, vB); }
            MG_WAIT_V(8); MG_WAIT_L(0); MG_BAR; MG_MMA(0, 0, At, B0); MG_MMA(0, 1, At, B1); MG_BAR; MG_SCHED;
            MG_LDA(At, 0, 1); MG_STAGE(MG_SB(0, 0), b20, vB, 0); MG_STAGE(MG_SB(0, 1), b21, vB, 0); MG_STAGE(MG_SA(0, 0), a20, vA[0], 0);
            MG_WAIT_V(8); MG_WAIT_L(0); MG_BAR; MG_MMA(1, 0, At, B0); MG_MMA(1, 1, At, B1); MG_BAR; MG_SCHED;
            MG_LDB(B0, 1, 0); MG_LDB(B1, 1, 1); MG_SCHED; MG_LDA(At, 1, 0); MG_STAGE(MG_SA(0, 1), a21, vA[H1], 0);
            MG_WAIT_V(8); MG_WAIT_L(0); MG_BAR; MG_MMA(0, 0, At, B0); MG_MMA(0, 1, At, B1); MG_BAR; MG_SCHED;
            MG_LDA(At, 1, 1); MG_STAGE_BK(MG_SB(1, 0), b20, vB); MG_STAGE_BK(MG_SB(1, 1), b21, vB); MG_STAGE_AK(MG_SA(1, 0), a20, vA[0]);
            MG_WAIT_V(8); MG_WAIT_L(0); MG_BAR; MG_MMA(1, 0, At, B0); MG_MMA(1, 1, At, B1); MG_BAR; MG_SCHED;
        }
        if constexpr (ALIGN_EPI) { if (wr == 0) MG_BAR; }
        { const int l_ = lane_id(); int fr_ = l_ & 15, fq_ = l_ >> 4; asm volatile("" : "+v"(fr_), "+v"(fq_));
          E.prefetch(pre, cur, wr, wc, fr_, fq_);
          E(acc, cur, wr, wc, fr_, fq_, pre); }
        if (!has_next) break;
        if (!(cur.aux & KEEP_ACC)) {
#pragma unroll
        for (int a = 0; a < 2; ++a)
#pragma unroll
            for (int b = 0; b < 2; ++b)
#pragma unroll
                for (int m = 0; m < 4; ++m)
#pragma unroll
                    for (int n = 0; n < 2; ++n) acc[a][b][m][n] = (f32x4){0.f, 0.f, 0.f, 0.f};
        }
        cur = nxt; ++ui;
        if constexpr (ALIGN_EPI) { if (wr == 1) MG_BAR; }
    }
    MG_WAIT_V(0);
    if constexpr (!ALIGN_EPI) { if (wr == 0) MG_BAR; }
    MG_BAR;
#undef MG_SA
#undef MG_SB
#undef MG_STAGE
#undef MG_STAGE_AK
#undef MG_STAGE_BK
#undef MG_LDA
#undef MG_LDB
#undef MG_MMA
#undef MG_WAIT_V
#undef MG_WAIT_L
#undef MG_BAR
#undef MG_SCHED
}
template <bool PERM>
__device__ __forceinline__ void std_voff(int tid, int lda, int ldb, unsigned (&va)[1][2], unsigned (&vb)[2]) {
#pragma unroll
    for (int i = 0; i < 2; ++i) { int R, C; stage_rc(tid * 16 + i * 8192, R, C); const int Rb = PERM ? ((R & ~31) + perm32(R & 31)) : R;
        va[0][i] = (unsigned)(R * lda + C) * 2u; vb[i] = (unsigned)(Rb * ldb + C) * 2u; }
}
template <bool PERM, int SW = 5>
__device__ __forceinline__ void std_voff8(int tid, int ldaB, int ldbB, unsigned (&va)[1][2], unsigned (&vb)[2]) {
#pragma unroll
    for (int i = 0; i < 2; ++i) { int R, C; stage_rc<SW>(tid * 16 + i * 8192, R, C); const int Rb = PERM ? ((R & ~31) + perm32(R & 31)) : R;
        va[0][i] = (unsigned)(R * ldaB + C * 2); vb[i] = (unsigned)(Rb * ldbB + C * 2); }
}
__device__ __forceinline__ unsigned pk4_fp8(float a, float b, float c, float d) { int w = __builtin_amdgcn_cvt_pk_fp8_f32(a, b, 0, false); w = __builtin_amdgcn_cvt_pk_fp8_f32(c, d, w, true); return (unsigned)w; }
__device__ __forceinline__ bool static_tile(int i, int G, int c, int nM, int nN, int& pm, int& pn) {
    const int nwg = nM * nN; const long L = (long)i * G + c; if (L >= nwg) return false;
    int wgid = (int)L; { const int q = nwg / 8, r = nwg % 8, xcd = wgid % 8, off = wgid / 8; wgid = (xcd < r ? xcd * (q + 1) : r * (q + 1) + (xcd - r) * q) + off; }
    const int nig = 8 * nN, gid = wgid / nig, fm = gid * 8, gsz = (nM - fm) < 8 ? (nM - fm) : 8;
    pm = fm + ((wgid % nig) % gsz); pn = (wgid % nig) / gsz; return true;
}
}
namespace fx {
using mg::bf16_t; using mg::bf16x8; using mg::f32x4; using mg::f32x2; using mg::u32x4; using mg::u32x2; using mg::Unit;
#define GAS __attribute__((address_space(1)))
#define LAS __attribute__((address_space(3)))
typedef GAS unsigned gu32;
#define RLX_AGENT __ATOMIC_RELAXED, __HIP_MEMORY_SCOPE_AGENT
#define LDS_WAIT() asm volatile("s_waitcnt lgkmcnt(0)" ::: "memory")
#define VM_WAIT() asm volatile("s_waitcnt vmcnt(0)" ::: "memory")
constexpr int NWAVES = 8, NTHREADS = 512;
constexpr int T = 65536, D = 1024, SEQ = 2048, NB = 32;
constexpr int ECAP = 131072;
constexpr size_t MiB = 1u << 20;
constexpr size_t WS_CTL = 0, CTL_ZERO_BYTES = 1 * MiB;
constexpr size_t WS_MOD = 1 * MiB;
constexpr size_t WS_SGUW = 2 * MiB;
constexpr size_t WS_AL = 2 * MiB + 512 * 1024;
constexpr size_t WS_WRH = 3 * MiB, WS_WRL = 3 * MiB + 128 * 1024;
constexpr size_t WS_TZ = 4 * MiB;
constexpr size_t WS_WS = 6 * MiB;
constexpr size_t WS_WO = 14 * MiB;
constexpr size_t WS_W1T = 30 * MiB;
constexpr size_t WS_WGLUT = 37 * MiB;
constexpr size_t WS_WBAT = 38 * MiB, WS_WBBT = 39 * MiB;
constexpr size_t WS_WOUTT = 40 * MiB;
constexpr size_t WS_WUPT = 42 * MiB;
constexpr size_t WS_WDNT = 106 * MiB;
constexpr size_t WS_ROWTOK = 139 * MiB;
constexpr size_t WS_ROWW = 155 * MiB;
constexpr size_t WS_XN = 172 * MiB;
constexpr size_t WS_GATES = 300 * MiB;
constexpr size_t WS_ZA = 556 * MiB;
constexpr size_t WS_YG = WS_ZA;
constexpr size_t WS_U = 620 * MiB, WS_GV = 684 * MiB;
constexpr size_t WS_YI = 748 * MiB;
constexpr size_t WS_SST = 812 * MiB;
constexpr size_t WS_HP = 828 * MiB;
constexpr size_t WS_YA = 844 * MiB, WS_YB = 908 * MiB;
constexpr size_t WS_P1 = 620 * MiB;
constexpr size_t WS_MERGED = 748 * MiB;
constexpr size_t WS_HID = 300 * MiB;
constexpr size_t WS_SLOT = 556 * MiB;
constexpr size_t WS_H1B = 844 * MiB;
constexpr size_t WS_END = 972 * MiB;
constexpr size_t WS_WG8 = 972 * MiB;
constexpr int CW_TMO = 0, CW_P0CTR = 1024, CW_BAR = 4096, CW_CURSOR = 65536;
constexpr int RING_BYTES = 131072;
constexpr int LDS_BYTES = 163840;
constexpr int MISC_OFF = LDS_BYTES - 256;
constexpr int XT_OFF = RING_BYTES;

__device__ __forceinline__ unsigned f2bf(float f) { unsigned u = __builtin_bit_cast(unsigned, f); return (u + 0x7fffu + ((u >> 16) & 1u)) >> 16; }
__device__ __forceinline__ unsigned pk2(float lo, float hi) { return f2bf(lo) | (f2bf(hi) << 16); }
__device__ __forceinline__ float wave_sum(float v) {
    v += __builtin_bit_cast(float, __builtin_amdgcn_update_dpp(0, __builtin_bit_cast(int, v), 0xB1, 0xf, 0xf, false));
    v += __builtin_bit_cast(float, __builtin_amdgcn_update_dpp(0, __builtin_bit_cast(int, v), 0x4E, 0xf, 0xf, false));
    v += __builtin_bit_cast(float, __builtin_amdgcn_update_dpp(0, __builtin_bit_cast(int, v), 0x141, 0xf, 0xf, false));
    v += __builtin_bit_cast(float, __builtin_amdgcn_update_dpp(0, __builtin_bit_cast(int, v), 0x140, 0xf, 0xf, false));
    const int iv = __builtin_bit_cast(int, v);
    const float r0 = __builtin_bit_cast(float, __builtin_amdgcn_readlane(iv, 0)), r1 = __builtin_bit_cast(float, __builtin_amdgcn_readlane(iv, 16)),
                r2 = __builtin_bit_cast(float, __builtin_amdgcn_readlane(iv, 32)), r3 = __builtin_bit_cast(float, __builtin_amdgcn_readlane(iv, 48));
    return (r0 + r1) + (r2 + r3);
}
#define XB_TMO      128
#define XB_XCNT(j)  (256  + 64 * (j))
#define XB_XSUB(j)  (1280 + 64 * (j))
#define XB_XGEN(j)  (2304 + 64 * (j))
#define XB_TOP      3328
#define XB_TOPGEN   3392
#define XCD_BAR_WORDS 3456
#define XB_SPIN_CAP (1u << 18)
__device__ __forceinline__ unsigned xb_ld(unsigned* p)              { return __hip_atomic_load(p, __ATOMIC_RELAXED, __HIP_MEMORY_SCOPE_AGENT); }
__device__ __forceinline__ unsigned xb_add(unsigned* p, unsigned v) { return __hip_atomic_fetch_add(p, v, __ATOMIC_RELAXED, __HIP_MEMORY_SCOPE_AGENT); }
__device__ __forceinline__ unsigned xb_xcc_id() { return (unsigned)__builtin_amdgcn_s_getreg((3 << 11) | 20) & 0xFu; }
#define XB_SPIN(cond, bar) do { unsigned _sp = 0; while (cond) { __builtin_amdgcn_s_sleep(1); \
    if ((++_sp & 255u) == 0u) { if (xb_ld(&(bar)[XB_TMO])) break; if (_sp > XB_SPIN_CAP) { atomicAdd(&(bar)[XB_TMO], 1u); break; } } } } while (0)
struct XcdBarrier { unsigned* bar; unsigned x; volatile LAS unsigned* st; int wave; };
__device__ __forceinline__ XcdBarrier xcd_barrier_post(unsigned* bar, volatile LAS unsigned* st, int wave) {
    XcdBarrier b; b.bar = bar; b.x = xb_xcc_id(); b.st = st; b.wave = wave;
    if (wave == 0 && mg::lane_id() == 0) (void)xb_add(&bar[XB_XCNT(b.x)], 1u);
    return b;
}
__device__ __forceinline__ void xcd_barrier_complete(unsigned* bar, unsigned x, unsigned& nloc, unsigned& nx) {
    const unsigned G = gridDim.x * gridDim.y * gridDim.z;
    unsigned sum, cnt, mine, sp = 0u;
    for (;;) {
        sum = 0u; cnt = 0u; mine = 0u;
#pragma unroll
        for (unsigned j = 0; j < 16; ++j) { const unsigned c = xb_ld(&bar[XB_XCNT(j)]); sum += c; cnt += (c > 0u) ? 1u : 0u; mine = (j == x) ? c : mine; }
        if (sum == G) break;
        __builtin_amdgcn_s_sleep(1);
        if ((++sp & 255u) == 0u) { if (xb_ld(&bar[XB_TMO])) break; if (sp > XB_SPIN_CAP) { atomicAdd(&bar[XB_TMO], 1u); break; } }
    }
    nloc = mine > 0u ? mine : 1u; nx = cnt > 0u ? cnt : 1u;
}
__device__ __forceinline__ void xcd_barrier(const XcdBarrier& b) {
    asm volatile("s_waitcnt vmcnt(0)" ::: "memory");
    __syncthreads();
    if (b.wave == 0 && mg::lane_id() == 0) {
        unsigned* bar = b.bar;
        __builtin_amdgcn_s_waitcnt(0);
        unsigned nloc = b.st[0], nx = b.st[1];
        if (nloc == 0u) { xcd_barrier_complete(bar, b.x, nloc, nx); b.st[0] = nloc; b.st[1] = nx; }
        const unsigned old = xb_add(&bar[XB_XSUB(b.x)], 1u);
        const unsigned gen = old / nloc;
        if (old + 1u == (gen + 1u) * nloc) {
            __builtin_amdgcn_fence(__ATOMIC_RELEASE, "agent");
            asm volatile("s_waitcnt vmcnt(0)" ::: "memory");
            const unsigned og = xb_add(&bar[XB_TOP], 1u);
            const unsigned tg = og / nx;
            if (og + 1u == (tg + 1u) * nx) xb_add(&bar[XB_TOPGEN], 1u);
            else XB_SPIN(xb_ld(&bar[XB_TOPGEN]) == tg, bar);
            __builtin_amdgcn_fence(__ATOMIC_ACQUIRE, "agent");
            xb_add(&bar[XB_XGEN(b.x)], 1u);
            asm volatile("s_waitcnt vmcnt(0)" ::: "memory");
        } else {
            XB_SPIN(xb_ld(&bar[XB_XGEN(b.x)]) == gen, bar);
            __builtin_amdgcn_fence(__ATOMIC_ACQUIRE, "agent");
            asm volatile("s_waitcnt vmcnt(0)" ::: "memory");
        }
    }
    __syncthreads();
}

struct Params { const float* in[34]; float* out; unsigned char* ws; int ph_lo, ph_hi; };
enum { I_X = 0, I_C, I_WADA, I_BADA, I_N1G, I_WIN, I_WGATE, I_BGATE, I_ARE, I_AIM, I_BRE, I_BIM, I_CRE, I_CIM, I_DSK, I_LSTEP, I_WGLU, I_BGLU, I_LNG, I_LNB,
       I_SGUW, I_SGUB, I_WBA, I_WBB, I_WOUT, I_N2G, I_WRG, I_BRG, I_WRE, I_BRE2, I_W1, I_W3, I_W2, I_NFG };
}
namespace fx {
#ifndef Q8_P2
#define Q8_P2 0
#endif
#ifndef Q8_P10
#define Q8_P10 0
#endif
#ifndef Q8_MOE
#define Q8_MOE 0
#endif
#ifndef Q8_P8
#define Q8_P8 0
#endif
#ifndef HOT11
#define HOT11 0
#endif
#ifndef SWZ_GATE
#define SWZ_GATE 4
#endif
#ifndef SWZ_OUT
#define SWZ_OUT 4
#endif
#ifndef SWZ_UP
#define SWZ_UP 4
#endif
#ifndef SWZ_DN
#define SWZ_DN 4
#endif
#ifndef GATE8
#define GATE8 1
#endif
#ifndef NT_LD
#define NT_LD 1
#endif
#define NTLD(p_) (NT_LD ? __builtin_nontemporal_load(p_) : *(p_))
#ifndef FP8_MERGE
#define FP8_MERGE 1
#endif
#ifndef FP8_MOE
#define FP8_MOE 1
#endif
#ifndef FP8_OUT
#define FP8_OUT 1
#endif
#ifndef MERGE_ONE
#define MERGE_ONE 1
#endif
#ifndef H1_BF16
#define H1_BF16 0
#endif
#ifndef TILED_GATES
#define TILED_GATES 1
#endif
#ifndef FP8_SLOT
#define FP8_SLOT 1
#endif
#ifndef FP8_GATES
#define FP8_GATES 1
#endif
using mg::q8; using mg::pk4_fp8; using mg::cvt_pk_bf16; using mg::fsigmoid; using mg::fsilu; using mg::fgelu; using mg::bf_lo; using mg::bf_hi;
struct Ctx { LAS unsigned char* lds; int tid, lane, wave, vcu, G; };

__device__ __forceinline__ u32x4 pack8(const f32x4& a, const f32x4& b) { u32x4 w; w.x = cvt_pk_bf16(a[0], a[1]); w.y = cvt_pk_bf16(a[2], a[3]); w.z = cvt_pk_bf16(b[0], b[1]); w.w = cvt_pk_bf16(b[2], b[3]); return w; }
#ifndef WIDE8
#define WIDE8 1
#endif
__device__ __forceinline__ u32x4 widen8(const u32x2 a, const u32x2 b) {
    const auto r0 = __builtin_amdgcn_permlane16_swap(a.x, b.x, false, false); const auto r1 = __builtin_amdgcn_permlane16_swap(a.y, b.y, false, false);
    return (u32x4){r0[0], r1[0], r0[1], r1[1]}; }
__device__ __forceinline__ void unpack8(const u32x4& w, f32x4& a, f32x4& b) { a = (f32x4){bf_lo(w.x), bf_hi(w.x), bf_lo(w.y), bf_hi(w.y)}; b = (f32x4){bf_lo(w.z), bf_hi(w.z), bf_lo(w.w), bf_hi(w.w)}; }

struct TItem { const float* W; bf16_t* WT; int K, N, dest_row0, k0, n0; float qs; int fp8; };
__device__ __forceinline__ void titem_load(const TItem& t, int lane, float (&tv)[32]) {
#pragma unroll
    for (int i = 0; i < 8; ++i) { const f32x4 v = NTLD((const f32x4*)(t.W + (size_t)(t.k0 + 8 * i + (lane >> 3)) * t.N + t.n0 + 4 * (lane & 7))); tv[4 * i] = v[0]; tv[4 * i + 1] = v[1]; tv[4 * i + 2] = v[2]; tv[4 * i + 3] = v[3]; }
}
__device__ __forceinline__ void titem_finish(const TItem& t, int lane, const float (&tv)[32], LAS float* scr) {
#pragma unroll
    for (int i = 0; i < 8; ++i)
#pragma unroll
        for (int e = 0; e < 4; ++e) scr[(8 * i + (lane >> 3)) * 33 + 4 * (lane & 7) + e] = (t.qs > 0.f && !t.fp8) ? q8(tv[4 * i + e], t.qs, 1.0f / t.qs) : tv[4 * i + e];
    LDS_WAIT(); asm volatile("" ::: "memory");
    if (t.fp8) {
        const int c4 = lane & 3; const float q = t.qs;
#pragma unroll
        for (int j = 0; j < 2; ++j) { const int n = (lane >> 2) + 16 * j; const LAS float* sp = scr + (16 * c4) * 33 + n;
            u32x4 o; o.x = pk4_fp8(sp[0 * 33] * q, sp[1 * 33] * q, sp[2 * 33] * q, sp[3 * 33] * q); o.y = pk4_fp8(sp[4 * 33] * q, sp[5 * 33] * q, sp[6 * 33] * q, sp[7 * 33] * q);
            o.z = pk4_fp8(sp[8 * 33] * q, sp[9 * 33] * q, sp[10 * 33] * q, sp[11 * 33] * q); o.w = pk4_fp8(sp[12 * 33] * q, sp[13 * 33] * q, sp[14 * 33] * q, sp[15 * 33] * q);
            *(GAS u32x4*)((unsigned char*)t.WT + (size_t)(t.dest_row0 + n) * t.K + t.k0 + 16 * c4) = o; }
    } else {
        const int c = lane & 7;
#pragma unroll
    for (int j = 0; j < 4; ++j) { const int n = (lane >> 3) + 8 * j; const LAS float* sp = scr + (8 * c) * 33 + n;
        u32x4 o; o.x = cvt_pk_bf16(sp[0 * 33], sp[1 * 33]); o.y = cvt_pk_bf16(sp[2 * 33], sp[3 * 33]); o.z = cvt_pk_bf16(sp[4 * 33], sp[5 * 33]); o.w = cvt_pk_bf16(sp[6 * 33], sp[7 * 33]);
        *(GAS u32x4*)(t.WT + (size_t)(t.dest_row0 + n) * t.K + t.k0 + 8 * c) = o; }
    }
    LDS_WAIT(); asm volatile("" ::: "memory");
}
__device__ __forceinline__ void p0_s5_tables(const Params& p, const Ctx& c, int g, int part) {
    typedef float f2 __attribute__((ext_vector_type(2)));
    LAS f2* P = (LAS f2*)c.lds;
    LAS f2* BT = P + 64 * 66;
    LAS f2* CC = BT + 1024;
    LAS f2* FF = CC + 1024;
    const int tid = c.tid;
    if (tid < 64) { const int n = tid;
        const double lr = fmin((double)p.in[I_ARE][g * 64 + n], -1e-4), li = (double)p.in[I_AIM][g * 64 + n], dt = exp((double)p.in[I_LSTEP][g]);
        const double mag = exp(lr * dt), abr = mag * cos(li * dt), abi = mag * sin(li * dt), den = lr * lr + li * li, nr = abr - 1.0;
        FF[n] = (f2){(float)((nr * lr + abi * li) / den), (float)((abi * lr - nr * li) / den)};
        double pr = 1.0, pi = 0.0;
        for (int tau = 0; tau <= 64; ++tau) { P[n * 66 + tau] = (f2){(float)pr, (float)pi}; const double qr = pr * abr - pi * abi, qi = pr * abi + pi * abr; pr = qr; pi = qi; } }
    __syncthreads();
    for (int idx = tid; idx < 1024; idx += 512) {
        { const int n = idx >> 4, h = idx & 15; const f2 f = FF[n]; const float br = p.in[I_BRE][(g * 64 + n) * 16 + h], bi = p.in[I_BIM][(g * 64 + n) * 16 + h];
          BT[n * 16 + h] = (f2){f.x * br - f.y * bi, f.x * bi + f.y * br}; }
        { const int h = idx >> 6, n = idx & 63; CC[h * 64 + n] = (f2){p.in[I_CRE][(g * 16 + h) * 64 + n], p.in[I_CIM][(g * 16 + h) * 64 + n]}; }
    }
    __syncthreads();
    if (part == 0 && tid < 64) ((f2*)(p.ws + WS_AL))[g * 64 + tid] = P[tid * 66 + 64];
    bf16_t* TZ = (bf16_t*)(p.ws + WS_TZ); bf16_t* WSg = (bf16_t*)(p.ws + WS_WS); bf16_t* WOg = (bf16_t*)(p.ws + WS_WO);
    { const int pr = tid & 63, h = 4 * part + (pr >> 4), hp = pr & 15, to = tid >> 6;
      float acc[8];
#pragma unroll
      for (int i = 0; i < 8; ++i) acc[i] = 0.f;
      for (int n = 0; n < 64; ++n) {
          const f2 cc = CC[h * 64 + n], bb = BT[n * 16 + hp]; const float cbr = cc.x * bb.x - cc.y * bb.y, cbi = cc.x * bb.y + cc.y * bb.x;
#pragma unroll
          for (int i = 0; i < 8; ++i) { const f2 pw = P[n * 66 + 8 * to + i]; acc[i] += cbr * pw.x - cbi * pw.y; }
      }
      bf16_t* tz = TZ + ((size_t)(g * 16 + h) * 128) * 16 + hp;
      const float dk = p.in[I_DSK][g * 16 + h];
#pragma unroll
      for (int i = 0; i < 8; ++i) { const int tau = 8 * to + i; float v = acc[i]; if (tau == 0 && h == hp) v += dk; tz[(63 + tau) * 16] = (bf16_t)f2bf(v);
          if (tau < 63) tz[tau * 16] = 0; }
      if (to == 7) tz[127 * 16] = 0;
    }
    for (int r = 0; r < 8; ++r) { const int gi = tid + 512 * r, row = 32 * part + (gi >> 7), k8 = (gi & 127) * 8, n = row & 63, im = row >> 6, sp = k8 >> 4, hp0 = k8 & 15;
        const f2 pw = P[n * 66 + sp]; float v[8];
#pragma unroll
        for (int e = 0; e < 8; ++e) { const f2 bb = BT[n * 16 + hp0 + e]; v[e] = im ? (pw.x * bb.y + pw.y * bb.x) : (pw.x * bb.x - pw.y * bb.y); }
        *(u32x4*)(WSg + ((size_t)g * 128 + row) * 1024 + k8) = (u32x4){cvt_pk_bf16(v[0], v[1]), cvt_pk_bf16(v[2], v[3]), cvt_pk_bf16(v[4], v[5]), cvt_pk_bf16(v[6], v[7])}; }
    for (int r = 0; r < 16; ++r) { const int gi = tid + 512 * r, row = 256 * part + (gi >> 5), k8 = (gi & 31) * 8, t = row >> 4, h = row & 15; float v[8];
#pragma unroll
        for (int e = 0; e < 8; ++e) { v[e] = 0.f; if (k8 < 128) { const int n = (k8 & 63) + e; const f2 cc = CC[h * 64 + n], pw = P[n * 66 + t + 1]; v[e] = (k8 < 64) ? (cc.x * pw.x - cc.y * pw.y) : -(cc.x * pw.y + cc.y * pw.x); } }
        *(u32x4*)(WOg + ((size_t)g * 1024 + row) * 256 + k8) = (u32x4){cvt_pk_bf16(v[0], v[1]), cvt_pk_bf16(v[2], v[3]), cvt_pk_bf16(v[4], v[5]), cvt_pk_bf16(v[6], v[7])}; }
    __syncthreads();
}
__device__ __forceinline__ void p0_mod(const Params& p, const Ctx& c) {
    if (c.vcu >= 96) return;
    LAS float* cs = (LAS float*)c.lds;
    for (int idx = c.tid; idx < 32768; idx += 512) { const int k = idx >> 5, b = idx & 31; cs[idx] = fsilu(p.in[I_C][b * 1024 + k]); }
    __syncthreads();
    const float* w_ada = p.in[I_WADA];
    for (int cb = c.vcu; cb < 96; cb += c.G) {
        const int j = cb * 64 + c.lane;
        float acc[32];
#pragma unroll
        for (int b = 0; b < 32; ++b) acc[b] = 0.f;
        const float* wp = w_ada + (size_t)(128 * c.wave) * 6144 + j;
#pragma unroll 16
        for (int k = 0; k < 128; ++k) { const float w = wp[(size_t)k * 6144]; const LAS f32x4* cr = (const LAS f32x4*)(cs + (128 * c.wave + k) * 32);
#pragma unroll
            for (int q = 0; q < 8; ++q) { const f32x4 cv = cr[q]; acc[4 * q] += w * cv[0]; acc[4 * q + 1] += w * cv[1]; acc[4 * q + 2] += w * cv[2]; acc[4 * q + 3] += w * cv[3]; } }
        __syncthreads();
        LAS float* red = (LAS float*)c.lds;
#pragma unroll
        for (int b = 0; b < 32; ++b) red[(c.wave * 32 + b) * 64 + c.lane] = acc[b];
        __syncthreads();
        for (int o = c.tid; o < 2048; o += 512) { const int b = o >> 6, l = o & 63; float sacc = p.in[I_BADA][cb * 64 + l];
#pragma unroll
            for (int w = 0; w < 8; ++w) sacc += red[(w * 32 + b) * 64 + l];
            ((float*)(p.ws + WS_MOD))[b * 6144 + cb * 64 + l] = sacc; }
        __syncthreads();
        if (cb + c.G < 96) { for (int idx = c.tid; idx < 32768; idx += 512) { const int k = idx >> 5, b = idx & 31; cs[idx] = fsilu(p.in[I_C][b * 1024 + k]); } __syncthreads(); }
    }
}
#ifndef P0_PARTS
#define P0_PARTS 3
#endif
template <int PARTS>
__device__ __forceinline__ void p0_prologue(const Params& p, const Ctx& c) {
    if (PARTS & 1) {
    p0_mod(p, c);
    if (c.vcu >= c.G - 128) { const int q_ = c.G - 1 - c.vcu; p0_s5_tables(p, c, q_ >> 2, q_ & 3); }
    }
    if (PARTS & 1) {
      bf16_t* wh = (bf16_t*)(p.ws + WS_WRH); bf16_t* wl = (bf16_t*)(p.ws + WS_WRL);
      for (int idx = c.vcu * NTHREADS + c.tid; idx < 48 * 1024; idx += c.G * NTHREADS) { const int o = idx >> 10, k = idx & 1023;
          const float w = (o < 4) ? p.in[I_WRG][k * 4 + o] : (o < 36 ? p.in[I_WRE][((size_t)((o - 4) >> 3) * 1024 + k) * 8 + ((o - 4) & 7)] : 0.f);
          const unsigned hb = f2bf(w); const float hf = __uint_as_float(hb << 16); wh[idx] = (bf16_t)hb; wl[idx] = (bf16_t)f2bf(w - hf); } }
    if (PARTS & 1) {
      bf16_t* sw = (bf16_t*)(p.ws + WS_SGUW);
      for (int idx = c.vcu * NTHREADS + c.tid; idx < 8 * 128 * 128; idx += c.G * NTHREADS) { const int tt = (idx >> 7) & 127, ss = idx & 127; sw[idx] = (ss <= tt) ? (bf16_t)f2bf(p.in[I_SGUW][idx]) : (bf16_t)0; } }
    if (!(PARTS & 2)) return;
    constexpr int TW0 = (PARTS == 2) ? 4 : 0, TNW = NWAVES - TW0;
    if (c.wave < TW0) return;
    const int tw = c.wave - TW0;
    LAS float* scr = (LAS float*)(c.lds + c.wave * 16384);
    constexpr int I0 = 768, I1 = I0 + 1024, I2 = I1 + 128, I3 = I2 + 256, I4 = I3 + 256, I5 = I4 + 512, I6 = I5 + 8192, I7 = I6 + 8192, I8 = I7 + 8192;
    int it_lo = 0, it_hi = 0;
    auto decode = [&](int it) -> TItem { TItem t;
        if (it < I0) { const int nb = 1536 / 32, r = it; t = TItem{p.in[I_WIN], (bf16_t*)(p.ws + WS_W1T), 1024, 1536, 32 * (r % nb), 64 * (r / nb), 32 * (r % nb), Q8_P2 ? 32.f : 0.f, 0}; }
        else if (it < I1) { const int nb = 2048 / 32, r = it - I0; t = FP8_GATES ? TItem{p.in[I_WGATE], (bf16_t*)(p.ws + WS_WG8), 1024, 2048, MERGE_ONE ? ((((32 * (r % nb)) & 1023) >> 7) * 256 + ((32 * (r % nb)) >> 10) * 128 + ((32 * (r % nb)) & 127)) : 32 * (r % nb), 64 * (r / nb), 32 * (r % nb), 32.f, 1}
                           : TItem{p.in[I_WGATE], (bf16_t*)(p.ws + WS_W1T), 1024, 2048, 1536 + 32 * (r % nb), 64 * (r / nb), 32 * (r % nb), Q8_P2 ? 32.f : 0.f, 0}; }
        else if (it < I2) { const int nb = 512 / 32, r = it - I1; t = TItem{p.in[I_WGLU], (bf16_t*)(p.ws + WS_WGLUT), 512, 512, 32 * (r % nb), 64 * (r / nb), 32 * (r % nb), 0.f, 0}; }
        else if (it < I3) { const int nb = 1024 / 32, r = it - I2; t = TItem{p.in[I_WBA], (bf16_t*)(p.ws + WS_WBAT), 512, 1024, 32 * (r % nb), 64 * (r / nb), 32 * (r % nb), (FP8_MERGE || Q8_P8) ? 16.f : 0.f, FP8_MERGE}; }
        else if (it < I4) { const int nb = 1024 / 32, r = it - I3; t = TItem{p.in[I_WBB], (bf16_t*)(p.ws + WS_WBBT), 512, 1024, 32 * (r % nb), 64 * (r / nb), 32 * (r % nb), (FP8_MERGE || Q8_P8) ? 16.f : 0.f, FP8_MERGE}; }
        else if (it < I5) { const int nb = 1024 / 32, r = it - I4; t = TItem{p.in[I_WOUT], (bf16_t*)(p.ws + WS_WOUTT), 1024, 1024, 32 * (r % nb), 64 * (r / nb), 32 * (r % nb), (FP8_OUT || Q8_P10) ? 32.f : 0.f, FP8_OUT}; }
        else if (it < I7) { const bool is3 = it >= I6; const int r0 = it - (is3 ? I6 : I5), e = r0 >> 8, r = r0 & 255, nb = 512 / 32, n0 = 32 * (r % nb);
            t = TItem{p.in[is3 ? I_W3 : I_W1] + (size_t)e * 1024 * 512, FP8_MOE ? (bf16_t*)(p.ws + WS_WUPT + (size_t)e * 1024 * 1024) : (bf16_t*)(p.ws + WS_WUPT) + (size_t)e * 1024 * 1024, 1024, 512, (n0 >> 7) * 256 + (is3 ? 128 : 0) + (n0 & 127), 64 * (r / nb), n0, (FP8_MOE || Q8_MOE) ? 32.f : 0.f, FP8_MOE}; }
        else { const int r0 = it - I7, e = r0 >> 8, r = r0 & 255, nb = 1024 / 32;
            t = TItem{p.in[I_W2] + (size_t)e * 512 * 1024, FP8_MOE ? (bf16_t*)(p.ws + WS_WDNT + (size_t)e * 1024 * 512) : (bf16_t*)(p.ws + WS_WDNT) + (size_t)e * 1024 * 512, 512, 1024, 32 * (r % nb), 64 * (r / nb), 32 * (r % nb), (FP8_MOE || Q8_MOE) ? 16.f : 0.f, FP8_MOE}; }
        return t; };
    (void)it_lo; (void)it_hi;
    if (PARTS == 3) {
        unsigned* ctr = (unsigned*)(p.ws + WS_CTL) + CW_P0CTR; LAS unsigned* slot = (LAS unsigned*)(c.lds + XT_OFF + 8192);
        constexpr int NCH = (I8 + NWAVES - 1) / NWAVES;
#define P0_BAR() do { LDS_WAIT(); __builtin_amdgcn_s_barrier(); asm volatile("" ::: "memory"); } while (0)
        unsigned my_next = 0;
        if (c.tid == 0) { slot[0] = __hip_atomic_fetch_add(ctr, 1u, RLX_AGENT); my_next = __hip_atomic_fetch_add(ctr, 1u, RLX_AGENT); }
        P0_BAR();
        unsigned ch = slot[0];
        P0_BAR();
        float tv[32], tn[32]; TItem cur{}; bool have = false;
        if (ch < (unsigned)NCH) { const int it = (int)ch * NWAVES + c.wave; if (it < I8) { cur = decode(it); titem_load(cur, c.lane, tn); have = true; } }
        while (ch < (unsigned)NCH) {
            if (c.tid == 0) { slot[0] = my_next; my_next = __hip_atomic_fetch_add(ctr, 1u, RLX_AGENT); }
            P0_BAR();
            const unsigned nch = slot[0];
            P0_BAR();
#pragma unroll
            for (int i = 0; i < 32; ++i) tv[i] = tn[i];
            const bool had = have; const TItem fin = cur; have = false;
            if (nch < (unsigned)NCH) { const int it = (int)nch * NWAVES + c.wave; if (it < I8) { cur = decode(it); titem_load(cur, c.lane, tn); have = true; } }
            if (had) titem_finish(fin, c.lane, tv, scr);
            ch = nch;
        }
#undef P0_BAR
    } else if (it_lo < it_hi) {
        float tv[32], tn[32];
        TItem cur = decode(it_lo); titem_load(cur, c.lane, tn);
        for (int it = it_lo; it < it_hi; it += TNW) {
#pragma unroll
            for (int i = 0; i < 32; ++i) tv[i] = tn[i];
            TItem nx = cur; if (it + TNW < it_hi) { nx = decode(it + TNW); titem_load(nx, c.lane, tn); }
            titem_finish(cur, c.lane, tv, scr);
            cur = nx;
        }
    }
}

template <int NW>
__device__ __forceinline__ void p1_xn(const Params& p, const Ctx& c) {
    if (c.wave >= NW) return;
    const float* mod = (const float*)(p.ws + WS_MOD); bf16_t* XN = (bf16_t*)(p.ws + WS_XN);
    LAS unsigned char* wl = c.lds + c.wave * 12288;
    for (int rb = c.vcu; rb < 256; rb += c.G) {
        const int b = rb >> 3;
        f32x4 A[4], Bc[4];
#pragma unroll
        for (int j = 0; j < 4; ++j) { const int k = 4 * c.lane + 256 * j; const f32x4 g = *(const f32x4*)(p.in[I_N1G] + k), sc = *(const f32x4*)(mod + b * 6144 + 1024 + k); A[j] = g * (sc + 1.0f); Bc[j] = *(const f32x4*)(mod + b * 6144 + k); }
        for (int i = 0; i < 256 / NW; i += 4) {
            const size_t row = (size_t)rb * 256 + c.wave * (256 / NW) + i;
            f32x4 v[4][4];
#pragma unroll
            for (int q = 0; q < 4; ++q) { const GAS f32x4* xr = (const GAS f32x4*)(p.in[I_X] + (row + q) * D) + c.lane;
#pragma unroll
                for (int j = 0; j < 4; ++j) v[q][j] = NTLD(xr + 64 * j); }
#pragma unroll
            for (int q = 0; q < 4; ++q) { float s = 0.f;
#pragma unroll
                for (int j = 0; j < 4; ++j) s += (v[q][j].x * v[q][j].x + v[q][j].y * v[q][j].y) + (v[q][j].z * v[q][j].z + v[q][j].w * v[q][j].w);
                const float r = 1.0f / sqrtf(wave_sum(s) * (1.0f / D) + 1e-6f);
#pragma unroll
                for (int j = 0; j < 4; ++j) { f32x4 y = v[q][j] * r * A[j] + Bc[j]; if (Q8_P2) { y.x = q8(y.x, 1.f, 1.f); y.y = q8(y.y, 1.f, 1.f); y.z = q8(y.z, 1.f, 1.f); y.w = q8(y.w, 1.f, 1.f); }
                    *(LAS u32x2*)(wl + q * 3072 + 8 * c.lane + 512 * j) = (u32x2){cvt_pk_bf16(y.x, y.y), cvt_pk_bf16(y.z, y.w)};
                    if (FP8_GATES) *(LAS unsigned*)(wl + q * 3072 + 2048 + 4 * c.lane + 256 * j) = pk4_fp8(y.x, y.y, y.z, y.w); } }
            LDS_WAIT();
#pragma unroll
            for (int q = 0; q < 4; ++q) {
                const u32x4 b0 = *(const LAS u32x4*)(wl + q * 3072 + 16 * c.lane), b1 = *(const LAS u32x4*)(wl + q * 3072 + 1024 + 16 * c.lane);
                GAS u32x4* o16 = (GAS u32x4*)(XN + (row + q) * D) + c.lane; o16[0] = b0; o16[64] = b1;
                if (FP8_GATES) { const u32x4 f0 = *(const LAS u32x4*)(wl + q * 3072 + 2048 + 16 * c.lane); ((GAS u32x4*)((unsigned char*)p.out + (row + q) * D))[c.lane] = f0; } }
            LDS_WAIT();
        }
    }
}

template <bool PERM_> struct SchedStd { static constexpr bool VOFF_CONST = true;
    const char* A; const char* B; int lda, ldb, nM, nN, nt, G, c;
    __device__ __forceinline__ bool next(int i, Unit& u) const { int pm, pn; if (!mg::static_tile(i, G, c, nM, nN, pm, pn)) return false; u.pm = pm; u.pn = pn; u.nt = nt; u.aux = 0;
        u.A0 = A + (size_t)pm * 512 * lda; u.A1 = u.A0 + (size_t)256 * lda; u.B0 = B + (size_t)pn * 512 * ldb; u.B1 = u.B0 + (size_t)256 * ldb; return true; }
    __device__ __forceinline__ void voff(const Unit&, int tid, unsigned (&va)[1][2], unsigned (&vb)[2]) const { mg::std_voff<PERM_>(tid, lda, ldb, va, vb); }
};
template <bool PERM_> struct SchedStd8 { static constexpr bool VOFF_CONST = true; static constexpr int SWZ8 = PERM_ ? SWZ_GATE : SWZ_OUT;
    const char* A; const char* B; int ldaB, ldbB, nM, nN, nt, G, c;
    __device__ __forceinline__ bool next(int i, Unit& u) const { int pm, pn; if (!mg::static_tile(i, G, c, nM, nN, pm, pn)) return false; u.pm = pm; u.pn = pn; u.nt = nt; u.aux = 0;
        u.A0 = A + (size_t)pm * 256 * ldaB; u.A1 = u.A0 + (size_t)128 * ldaB; u.B0 = B + (size_t)pn * 256 * ldbB; u.B1 = u.B0 + (size_t)128 * ldbB; return true; }
    __device__ __forceinline__ void voff(const Unit&, int tid, unsigned (&va)[1][2], unsigned (&vb)[2]) const { mg::std_voff8<PERM_, SWZ8>(tid, ldaB, ldbB, va, vb); }
};
struct NoPre {};
#define NO_PREFETCH typedef NoPre Pre; __device__ __forceinline__ void prefetch(Pre&, const Unit&, int, int, int, int) const {}
#define EPI_ARGS const f32x4 (&acc)[2][2][4][2], const Unit& u, int wr, int wc, int fr, int fq, const Pre& pre
struct EpiNull { static constexpr bool PERM = true; NO_PREFETCH
    __device__ __forceinline__ void operator()(EPI_ARGS) const {
#pragma unroll
        for (int ai = 0; ai < 2; ++ai)
#pragma unroll
            for (int bj = 0; bj < 2; ++bj)
#pragma unroll
                for (int m = 0; m < 4; ++m) { asm volatile("" :: "v"(acc[ai][bj][m][0]), "v"(acc[ai][bj][m][1])); }
    }
};
struct Epi1 { static constexpr bool PERM = true; NO_PREFETCH bf16_t* ZA; bf16_t* U; bf16_t* GV; bf16_t* GATES; const LAS float* b_gate;
    __device__ __forceinline__ void operator()(EPI_ARGS) const {
        const int pn = u.pn;
#pragma unroll
        for (int bj = 0; bj < 2; ++bj) {
            const int col0 = pn * 256 + bj * 128 + wc * 32 + 8 * fq;
            f32x4 b0 = (f32x4){0.f, 0.f, 0.f, 0.f}, b1 = b0;
            if (pn >= 6) { b0 = *(const LAS f32x4*)(b_gate + col0 - 1536); b1 = *(const LAS f32x4*)(b_gate + col0 - 1536 + 4); }
#pragma unroll
            for (int ai = 0; ai < 2; ++ai)
#pragma unroll
                for (int m = 0; m < 4; ++m) {
                    const int t = u.pm * 256 + ai * 128 + wr * 64 + m * 16 + fr;
                    f32x4 v0 = acc[ai][bj][m][0], v1 = acc[ai][bj][m][1];
                    if (pn < 2) { const int g = col0 >> 4, half = (col0 >> 3) & 1, bb = t >> 11, pp = t & 2047, cc = pp >> 6, sp = 63 - (pp & 63);
                        st16((void*)(ZA + ((size_t)(g * 1024 + bb * 32 + cc) * 1024 + sp * 16 + half * 8)), pack8(v0, v1)); }
                    else if (pn < 6) {
#pragma unroll
                        for (int j = 0; j < 4; ++j) { v0[j] = fgelu(v0[j]); v1[j] = fgelu(v1[j]); }
                        bf16_t* dst = (pn < 4) ? (U + (size_t)t * 512 + (col0 - 512)) : (GV + (size_t)t * 512 + (col0 - 1024));
                        *(u32x4*)dst = pack8(v0, v1); }
                    else {
#pragma unroll
                        for (int j = 0; j < 4; ++j) { v0[j] = fsigmoid(v0[j] + b0[j]); v1[j] = fsigmoid(v1[j] + b1[j]); }
                        st16((void*)(GATES + (size_t)t * 2048 + (col0 - 1536)), pack8(v0, v1)); }
                }
        }
    }
};
#if MERGE_ONE
constexpr size_t TILED2_HALF = (size_t)256 * 8 * 8 * 8 * 64 * 8;
struct Epi1g { static constexpr bool PERM = true; NO_PREFETCH bf16_t* GATES; const LAS float* b_gate; bf16_t* GB2;
    __device__ __forceinline__ void operator()(EPI_ARGS) const {
        const int j0 = u.pn * 128 + wc * 32 + 8 * fq;
        const f32x4 ba0 = *(const LAS f32x4*)(b_gate + j0), ba1 = *(const LAS f32x4*)(b_gate + j0 + 4), bb0 = *(const LAS f32x4*)(b_gate + 1024 + j0), bb1 = *(const LAS f32x4*)(b_gate + 1024 + j0 + 4);
#pragma unroll
        for (int ai = 0; ai < 2; ++ai)
#pragma unroll
            for (int m = 0; m < 4; ++m) { f32x4 r0, r1, g0, g1;
#pragma unroll
                for (int q = 0; q < 4; ++q) {
                    const float ea0 = __builtin_amdgcn_exp2f(__builtin_amdgcn_fmed3f(-1.4426950408889634f * (acc[ai][0][m][0][q] + ba0[q]), -57.0f, 57.0f)), eb0 = __builtin_amdgcn_exp2f(__builtin_amdgcn_fmed3f(-1.4426950408889634f * (acc[ai][1][m][0][q] + bb0[q]), -57.0f, 57.0f));
                    const float ea1 = __builtin_amdgcn_exp2f(__builtin_amdgcn_fmed3f(-1.4426950408889634f * (acc[ai][0][m][1][q] + ba1[q]), -57.0f, 57.0f)), eb1 = __builtin_amdgcn_exp2f(__builtin_amdgcn_fmed3f(-1.4426950408889634f * (acc[ai][1][m][1][q] + bb1[q]), -57.0f, 57.0f));
                    if (GATE8) { r0[q] = __builtin_amdgcn_rcpf(1.0f + ea0); r1[q] = __builtin_amdgcn_rcpf(1.0f + ea1); g0[q] = __builtin_amdgcn_rcpf(1.0f + eb0); g1[q] = __builtin_amdgcn_rcpf(1.0f + eb1); }
                    else { r0[q] = (1.0f + eb0) * __builtin_amdgcn_rcpf(1.0f + ea0); g0[q] = __builtin_amdgcn_rcpf(1.0f + eb0);
                        r1[q] = (1.0f + eb1) * __builtin_amdgcn_rcpf(1.0f + ea1); g1[q] = __builtin_amdgcn_rcpf(1.0f + eb1); } }
                bf16_t* d = GATES + ((((size_t)(u.pm * 8 + u.pn) * 8 + (ai * 4 + m)) * 8 + (wr * 4 + wc)) * 64 + (fq * 16 + fr)) * 8;
                if (GATE8) { u32x4 w8 = (u32x4){0u, 0u, 0u, 0u};
#pragma unroll
                    for (int q = 0; q < 4; ++q) { w8.x = __builtin_amdgcn_cvt_pk_u8_f32(r0[q] * 256.0f - 0.5f, q, w8.x); w8.y = __builtin_amdgcn_cvt_pk_u8_f32(r1[q] * 256.0f - 0.5f, q, w8.y);
                        w8.z = __builtin_amdgcn_cvt_pk_u8_f32(g0[q] * 256.0f - 0.5f, q, w8.z); w8.w = __builtin_amdgcn_cvt_pk_u8_f32(g1[q] * 256.0f - 0.5f, q, w8.w); }
                    st16((void*)d, w8); }
                else { const u32x4 rw = pack8(r0, r1), gw2 = pack8(g0, g1);
                    st16((void*)d, rw); asm volatile("" ::: "memory"); st16((void*)(GB2 + (size_t)(d - GATES)), gw2); } }
    }
};
#else
struct Epi1g { static constexpr bool PERM = true; NO_PREFETCH bf16_t* GATES; const LAS float* b_gate;
    __device__ __forceinline__ void operator()(EPI_ARGS) const {
#pragma unroll
        for (int bj = 0; bj < 2; ++bj) { const int col0 = u.pn * 256 + bj * 128 + wc * 32 + 8 * fq;
            const f32x4 b0 = *(const LAS f32x4*)(b_gate + col0), b1 = *(const LAS f32x4*)(b_gate + col0 + 4);
#pragma unroll
            for (int ai = 0; ai < 2; ++ai)
#pragma unroll
                for (int m = 0; m < 4; ++m) { const size_t t = (size_t)u.pm * 256 + ai * 128 + wr * 64 + m * 16 + fr; f32x4 v0 = acc[ai][bj][m][0], v1 = acc[ai][bj][m][1];
#pragma unroll
                    for (int j = 0; j < 4; ++j) { v0[j] = fsigmoid(v0[j] + b0[j]); v1[j] = fsigmoid(v1[j] + b1[j]); }
                    if (TILED_GATES) st16((void*)(GATES + ((((size_t)(u.pm * 8 + u.pn) * 16 + (ai * 8 + m * 2 + bj)) * 8 + (wr * 4 + wc)) * 64 + (fq * 16 + fr)) * 8), pack8(v0, v1));
                    else st16((void*)(GATES + t * 2048 + col0), pack8(v0, v1)); }
        }
    }
};
#endif
struct SchedS5a { const char* ZA; const char* TZ; const char* WS; int G, c;
    __device__ __forceinline__ void fill(int v, int k, Unit& u) const {
        const int pair = v >> 1, g = pair >> 2, rt = pair & 3;
        const int j = (v & 1) ? (k == 0 ? 1 : (k == 1 ? 0 : 4)) : (k == 0 ? 3 : 2);
        const int kt0 = (j < 4) ? 12 - 4 * j : 0;
        u.A0 = ZA + ((size_t)(g * 1024 + rt * 256) * 1024 + kt0 * 64) * 2; u.A1 = u.A0 + 128 * 2048;
        if (j < 4) { u.B0 = TZ + ((size_t)g * 32768 + 16 * j * 16 + kt0 * 64) * 2; u.B1 = u.B0 + 256; }
        else { u.B0 = WS + (size_t)g * 131072 * 2; u.B1 = u.B0; }
        u.nt = 16 - kt0; u.pm = g * 4 + rt; u.pn = j; u.aux = 0;
    }
    __device__ __forceinline__ bool next(int i, Unit& u) const { int k = i; for (int v = c; v < 256; v += G) { const int n = (v & 1) ? 3 : 2; if (k < n) { fill(v, k, u); return true; } k -= n; } return false; }
    __device__ __forceinline__ void voff(const Unit& u, int tid, unsigned (&va)[1][2], unsigned (&vb)[2]) const {
#pragma unroll
        for (int i = 0; i < 2; ++i) { int R, C; mg::stage_rc(tid * 16 + i * 8192, R, C); const int Rb = (R & ~31) + mg::perm32(R & 31);
            va[0][i] = (unsigned)(R * 1024 + C) * 2u; vb[i] = (u.pn < 4) ? (unsigned)((Rb & 15) * 2048 + (Rb >> 4) * 16 + C) * 2u : (unsigned)(Rb * 1024 + C) * 2u; }
    }
};
struct EpiS5a { static constexpr bool PERM = true; NO_PREFETCH bf16_t* YI; float* SST;
    __device__ __forceinline__ void operator()(EPI_ARGS) const {
        const int j = u.pn;
#pragma unroll
        for (int ai = 0; ai < 2; ++ai)
#pragma unroll
            for (int m = 0; m < 4; ++m) { const size_t row = (size_t)u.pm * 256 + ai * 128 + wr * 64 + m * 16 + fr;
                if (j < 4) {
#pragma unroll
                    for (int bj = 0; bj < 2; ++bj) st16((void*)(YI + row * 1024 + j * 256 + bj * 128 + wc * 32 + 8 * fq), pack8(acc[ai][bj][m][0], acc[ai][bj][m][1]));
                } else { float* d = SST + row * 128 + wc * 32 + 8 * fq; st16f(d, acc[ai][0][m][0]); st16f(d + 4, acc[ai][0][m][1]); }
            }
    }
};
struct SchedS5b { const char* HP; const char* WO; int G, c;
    __device__ __forceinline__ bool next(int i, Unit& u) const { const long L = (long)i * G + c; if (L >= 512) return false; const int g = (int)L >> 4, rt = ((int)L >> 2) & 3, j = (int)L & 3;
        u.A0 = HP + (size_t)(g * 1024 + rt * 256) * 512; u.A1 = u.A0 + 128 * 512; u.B0 = WO + (size_t)(g * 1024 + j * 256) * 512; u.B1 = u.B0 + 128 * 512; u.nt = 4; u.pm = g * 4 + rt; u.pn = j; u.aux = 0; return true; }
    __device__ __forceinline__ void voff(const Unit&, int tid, unsigned (&va)[1][2], unsigned (&vb)[2]) const { mg::std_voff<true>(tid, 256, 256, va, vb); }
};
struct EpiS5b { static constexpr bool PERM = true; const bf16_t* YI; bf16_t* YG;
    struct Pre { u32x4 yq[4]; };
#define ES_OFF(s_) (base + (size_t)(((s_) >> 3) * 128 + (((s_) >> 1) & 3) * 16) * 1024 + ((s_) & 1) * 128)
    __device__ __forceinline__ void prefetch(Pre& pre, const Unit& u, int wr, int wc, int fr, int fq) const {
        const size_t base = ((size_t)u.pm * 256 + wr * 64 + fr) * 1024 + u.pn * 256 + wc * 32 + 8 * fq;
#pragma unroll
        for (int s_ = 0; s_ < 4; ++s_) pre.yq[s_] = NTLD((const u32x4*)(YI + ES_OFF(s_)));
    }
    __device__ __forceinline__ void operator()(EPI_ARGS) const {
        const size_t base = ((size_t)u.pm * 256 + wr * 64 + fr) * 1024 + u.pn * 256 + wc * 32 + 8 * fq;
        u32x4 yq[4]; u32x2 pke = (u32x2){0u, 0u}; (void)pke;
#pragma unroll
        for (int s_ = 0; s_ < 4; ++s_) yq[s_] = pre.yq[s_];
#pragma unroll
        for (int s_ = 0; s_ < 16; ++s_) { const int ai = s_ >> 3, m = (s_ >> 1) & 3, bj = s_ & 1;
            const u32x4 yw = yq[s_ & 3];
            if (s_ + 4 < 16) yq[s_ & 3] = NTLD((const u32x4*)(YI + ES_OFF(s_ + 4)));
            f32x4 y0, y1; unpack8(yw, y0, y1); y0 += acc[ai][bj][m][0]; y1 += acc[ai][bj][m][1];
#pragma unroll
            for (int q = 0; q < 4; ++q) { y0[q] = fgelu(y0[q]); y1[q] = fgelu(y1[q]); }
            st16((void*)(YG + ES_OFF(s_)), pack8(y0, y1)); }
    }
#undef ES_OFF
};
struct SchedGlu { static constexpr bool VOFF_CONST = true; const char* YG; const char* B; int G, c;
    __device__ __forceinline__ bool next(int i, Unit& u) const { int pm, pn; if (!mg::static_tile(i, G, c, 256, 2, pm, pn)) return false; u.pm = pm; u.pn = pn; u.nt = 8; u.aux = 0;
        u.A0 = YG + (size_t)pm * 256 * 32; u.A1 = u.A0 + 128 * 32; u.B0 = B + (size_t)pn * 512 * 512; u.B1 = u.B0 + (size_t)256 * 512; return true; }
    __device__ __forceinline__ void voff(const Unit&, int tid, unsigned (&va)[1][2], unsigned (&vb)[2]) const {
#pragma unroll
        for (int i = 0; i < 2; ++i) { int R, C; mg::stage_rc(tid * 16 + i * 8192, R, C); const int Rb = (R & ~31) + mg::perm32(R & 31);
            va[0][i] = (unsigned)((C >> 4) * 1048576 + R * 16 + (C & 15)) * 2u; vb[i] = (unsigned)(Rb * 512 + C) * 2u; }
    }
};
struct EpiGlu { static constexpr bool PERM = true; const bf16_t* YG; bf16_t* YA; const float* b_glu;
    struct Pre { u32x4 yq[4]; };
#define EG_T(s_) (trow + ((s_) >> 3) * 128 + (((s_) >> 1) & 3) * 16)
#define EG_C(s_) (colb + ((s_) & 1) * 128)
#define EG_Y(s_) (YG + ((size_t)(EG_C(s_) >> 4) * 65536 + EG_T(s_)) * 16 + (EG_C(s_) & 15))
    __device__ __forceinline__ void prefetch(Pre& pre, const Unit& u, int wr, int wc, int fr, int fq) const {
        const size_t trow = (size_t)u.pm * 256 + wr * 64 + fr; const int colb = u.pn * 256 + wc * 32 + 8 * fq;
#pragma unroll
        for (int s_ = 0; s_ < 4; ++s_) pre.yq[s_] = NTLD((const u32x4*)EG_Y(s_));
    }
    __device__ __forceinline__ void operator()(EPI_ARGS) const {
        const size_t trow = (size_t)u.pm * 256 + wr * 64 + fr; const int colb = u.pn * 256 + wc * 32 + 8 * fq;
        f32x4 bq[2][2];
#pragma unroll
        for (int bj = 0; bj < 2; ++bj) { bq[bj][0] = *(const f32x4*)(b_glu + colb + bj * 128); bq[bj][1] = *(const f32x4*)(b_glu + colb + bj * 128 + 4); }
        u32x4 yq[4]; u32x2 pke = (u32x2){0u, 0u}; (void)pke;
#pragma unroll
        for (int s_ = 0; s_ < 4; ++s_) yq[s_] = pre.yq[s_];
#pragma unroll
        for (int s_ = 0; s_ < 16; ++s_) { const int ai = s_ >> 3, m = (s_ >> 1) & 3, bj = s_ & 1;
            const u32x4 yw = yq[s_ & 3];
            if (s_ + 4 < 16) yq[s_ & 3] = NTLD((const u32x4*)EG_Y(s_ + 4));
            f32x4 y0, y1; unpack8(yw, y0, y1);
            f32x4 v0 = acc[ai][bj][m][0] + bq[bj][0], v1 = acc[ai][bj][m][1] + bq[bj][1];
#pragma unroll
            for (int q = 0; q < 4; ++q) { v0[q] = y0[q] * fsigmoid(v0[q]); v1[q] = y1[q] * fsigmoid(v1[q]); if (Q8_P8) { v0[q] = q8(v0[q], 8.f, 0.125f); v1[q] = q8(v1[q], 8.f, 0.125f); } }
            if (FP8_MERGE) { v0 *= 8.0f; v1 *= 8.0f; const u32x2 pk = (u32x2){pk4_fp8(v0[0], v0[1], v0[2], v0[3]), pk4_fp8(v1[0], v1[1], v1[2], v1[3])};
                if (WIDE8) { if (bj == 0) pke = pk; else { const u32x4 w16 = widen8(pke, pk);
                        st16((void*)((unsigned char*)YA + EG_T(s_) * 512 + (colb - 8 * fq) + ((fq & 1) ? 128 + 8 * (fq - 1) : 8 * fq)), w16); } }
                else st8((void*)((unsigned char*)YA + EG_T(s_) * 512 + EG_C(s_)), pk); }
            else st16((void*)(YA + EG_T(s_) * 512 + EG_C(s_)), pack8(v0, v1)); }
    }
#undef EG_T
#undef EG_C
#undef EG_Y
};
template <int SECOND> struct EpiMerge { static constexpr bool PERM = true; const bf16_t* GATES; bf16_t* P1; bf16_t* MERGED;
    static constexpr int PD = SECOND ? 4 : 8;
    struct Pre { u32x4 gq[PD]; u32x4 pq[SECOND ? 4 : 1]; };
#define EM_GT(s_) (GATES + ((((size_t)(u.pm * 8 + SECOND * 4 + u.pn) * 16 + (s_)) * 8 + (wr * 4 + wc)) * 64 + (fq * 16 + fr)) * 8)
#define EM_PT(s_) (P1 + ((((size_t)(u.pm * 4 + u.pn) * 16 + (s_)) * 8 + (wr * 4 + wc)) * 64 + (fq * 16 + fr)) * 8)
#define EM_T(s_) (trow + ((s_) >> 3) * 128 + (((s_) >> 1) & 3) * 16)
#define EM_C(s_) (colb + ((s_) & 1) * 128)
    __device__ __forceinline__ void prefetch(Pre& pre, const Unit& u, int wr, int wc, int fr, int fq) const {
        const size_t trow = (size_t)u.pm * 256 + wr * 64 + fr; const int colb = u.pn * 256 + wc * 32 + 8 * fq;
#pragma unroll
        for (int s_ = 0; s_ < PD; ++s_) { pre.gq[s_] = TILED_GATES ? *(const u32x4*)EM_GT(s_) : *(const u32x4*)(GATES + EM_T(s_) * 2048 + SECOND * 1024 + EM_C(s_)); if (SECOND) pre.pq[s_] = TILED_GATES ? *(const u32x4*)EM_PT(s_) : *(const u32x4*)(P1 + EM_T(s_) * 1024 + EM_C(s_)); }
    }
    __device__ __forceinline__ void operator()(EPI_ARGS) const {
        const size_t trow = (size_t)u.pm * 256 + wr * 64 + fr; const int colb = u.pn * 256 + wc * 32 + 8 * fq;
        u32x4 gq[PD], pq[4];
#pragma unroll
        for (int s_ = 0; s_ < PD; ++s_) { gq[s_] = pre.gq[s_]; if (SECOND) pq[s_] = pre.pq[s_ & 3]; }
#pragma unroll
        for (int s_ = 0; s_ < 16; ++s_) { const int ai = s_ >> 3, m = (s_ >> 1) & 3, bj = s_ & 1;
            const u32x4 gw = gq[s_ % PD]; u32x4 pw; if (SECOND) pw = pq[s_ & 3];
            if (s_ + PD < 16) { gq[s_ % PD] = TILED_GATES ? *(const u32x4*)EM_GT(s_ + PD) : *(const u32x4*)(GATES + EM_T(s_ + PD) * 2048 + SECOND * 1024 + EM_C(s_ + PD)); if (SECOND) pq[s_ & 3] = TILED_GATES ? *(const u32x4*)EM_PT(s_ + 4) : *(const u32x4*)(P1 + EM_T(s_ + 4) * 1024 + EM_C(s_ + 4)); }
            f32x4 g0, g1; unpack8(gw, g0, g1);
            f32x4 v0 = acc[ai][bj][m][0] * g0, v1 = acc[ai][bj][m][1] * g1;
            if (SECOND) { f32x4 q0, q1; unpack8(pw, q0, q1); v0 += q0; v1 += q1;
                if (Q8_P10) { for (int q = 0; q < 4; ++q) { v0[q] = q8(v0[q], 4.f, 0.25f); v1[q] = q8(v1[q], 4.f, 0.25f); } }
                if (FP8_OUT) { v0 *= 4.0f; v1 *= 4.0f; st8((void*)((unsigned char*)MERGED + EM_T(s_) * 1024 + EM_C(s_)), (u32x2){pk4_fp8(v0[0], v0[1], v0[2], v0[3]), pk4_fp8(v1[0], v1[1], v1[2], v1[3])}); }
                else st16((void*)(MERGED + EM_T(s_) * 1024 + EM_C(s_)), pack8(v0, v1)); }
            else { if (TILED_GATES) st16((void*)EM_PT(s_), pack8(v0, v1)); else st16((void*)(P1 + EM_T(s_) * 1024 + EM_C(s_)), pack8(v0, v1)); } }
    }
#undef EM_T
#undef EM_C
#undef EM_GT
#undef EM_PT
};
struct SchedMerge { static constexpr bool VOFF_CONST = true; static constexpr int SWZ8 = 4; const char* YA; const char* YB; const char* WA; const char* WB; int G, c;
    __device__ __forceinline__ bool next(int i, Unit& u) const { int pm, pn; if (!mg::static_tile(i >> 1, G, c, 256, 4, pm, pn)) return false; const int seg = i & 1; u.pm = pm; u.pn = pn; u.nt = FP8_MERGE ? 4 : 8; u.aux = seg ? 0 : mg::KEEP_ACC;
        const char* A = seg ? YB : YA; const char* B = seg ? WB : WA; constexpr int EB = FP8_MERGE ? 1 : 2;
        u.A0 = A + (size_t)pm * 256 * 512 * EB; u.A1 = u.A0 + (size_t)128 * 512 * EB; u.B0 = B + (size_t)pn * 256 * 512 * EB; u.B1 = u.B0 + (size_t)128 * 512 * EB; return true; }
    __device__ __forceinline__ void voff(const Unit&, int tid, unsigned (&va)[1][2], unsigned (&vb)[2]) const { if (FP8_MERGE) mg::std_voff8<true, SWZ8>(tid, 512, 512, va, vb); else mg::std_voff<true>(tid, 512, 512, va, vb); }
};
struct EpiMergeOne { static constexpr bool PERM = true; const bf16_t* GATES; bf16_t* MERGED;
    static constexpr int PD = GATE8 ? 3 : 4;
    struct Pre { u32x4 gq[PD]; };
#define EM1_G(s_) (gbase + ((((size_t)(u.pm * 8 + 2 * u.pn + ((s_) & 1)) * 8 + (((s_) >> 3) * 4 + (((s_) >> 1) & 3))) * 8 + (wr * 4 + wc)) * 64 + (fq * 16 + fr)) * 8)
    __device__ __forceinline__ void prefetch(Pre& pre, const Unit& u, int wr, int wc, int fr, int fq) const {
        const bf16_t* gbase = GATES + ((GATE8 || (u.aux & mg::KEEP_ACC)) ? (size_t)0 : TILED2_HALF);
#pragma unroll
        for (int s_ = 0; s_ < PD; ++s_) pre.gq[s_] = *(const u32x4*)EM1_G(s_);
    }
    __device__ __forceinline__ void operator()(f32x4 (&acc)[2][2][4][2], const Unit& u, int wr, int wc, int fr, int fq, const Pre& pre) const {
        const bool first = (u.aux & mg::KEEP_ACC) != 0;
        const bf16_t* gbase = GATES + ((GATE8 || first) ? (size_t)0 : TILED2_HALF);
        const size_t trow = (size_t)u.pm * 256 + wr * 64 + fr; const int colm = u.pn * 256 + wc * 32 + 8 * fq;
        u32x4 gq[PD]; u32x2 pke = (u32x2){0u, 0u}; (void)pke;
#pragma unroll
        for (int s_ = 0; s_ < PD; ++s_) gq[s_] = pre.gq[s_];
#pragma unroll
        for (int s_ = 0; s_ < 16; ++s_) { const int ai = s_ >> 3, m = (s_ >> 1) & 3, bj = s_ & 1;
            const u32x4 gw = gq[s_ % PD];
            if (s_ + PD < 16) gq[s_ % PD] = *(const u32x4*)EM1_G(s_ + PD);
            f32x4 g0, g1;
            if (GATE8) {
                const unsigned na0 = first ? gw.x : 0x80808080u, na1 = first ? gw.y : 0x80808080u;
#pragma unroll
                for (int e = 0; e < 4; ++e) { const float kb0 = (float)((gw.z >> (8 * e)) & 0xffu) + 0.5f, kb1 = (float)((gw.w >> (8 * e)) & 0xffu) + 0.5f;
                    const float ka0 = (float)((na0 >> (8 * e)) & 0xffu) + 0.5f, ka1 = (float)((na1 >> (8 * e)) & 0xffu) + 0.5f;
                    g0[e] = first ? ka0 * __builtin_amdgcn_rcpf(kb0) : kb0 * 0.00390625f; g1[e] = first ? ka1 * __builtin_amdgcn_rcpf(kb1) : kb1 * 0.00390625f; } }
            else unpack8(gw, g0, g1);
            if (first) { acc[ai][bj][m][0] *= g0; acc[ai][bj][m][1] *= g1; }
            else { f32x4 v0 = acc[ai][bj][m][0] * g0, v1 = acc[ai][bj][m][1] * g1; const size_t mo = (trow + ai * 128 + m * 16) * 1024 + colm + bj * 128;
                if (FP8_OUT) { v0 *= 4.0f; v1 *= 4.0f; const u32x2 pk = (u32x2){pk4_fp8(v0[0], v0[1], v0[2], v0[3]), pk4_fp8(v1[0], v1[1], v1[2], v1[3])};
                    if (WIDE8) { if (bj == 0) pke = pk; else { const u32x4 w16 = widen8(pke, pk);
                            st16((void*)((unsigned char*)MERGED + (trow + ai * 128 + m * 16) * 1024 + (colm - 8 * fq) + ((fq & 1) ? 128 + 8 * (fq - 1) : 8 * fq)), w16); } }
                    else st8((void*)((unsigned char*)MERGED + mo), pk); }
                else st16((void*)(MERGED + mo), pack8(v0, v1)); } }
    }
#undef EM1_G
};
#ifndef EO_FULL
#define EO_FULL 1
#endif
struct EpiOut { static constexpr bool PERM = false; const float* x; const float* mod; float* H1;
    struct Pre { f32x4 xq[8]; };
#define EO_OFF(s_) (rowb + (size_t)(((s_) >> 4) * 128 + (((s_) >> 2) & 3) * 16 + (EO_FULL ? ((s_) & 1) * 8 : 0)) * 1024 + (((s_) >> 1) & 1) * 128 + (EO_FULL ? 0 : ((s_) & 1) * 16))
    __device__ __forceinline__ void prefetch(Pre& pre, const Unit& u, int wr, int wc, int fr, int fq) const {
        const size_t rowb = EO_FULL ? ((size_t)u.pm * 256 + wr * 64 + (fr & 7)) * 1024 + u.pn * 256 + wc * 32 + (fr >> 3) * 16 + 4 * fq : ((size_t)u.pm * 256 + wr * 64 + fr) * 1024 + u.pn * 256 + wc * 32 + 4 * fq;
#pragma unroll
        for (int s_ = 0; s_ < 8; ++s_) pre.xq[s_] = NTLD((const f32x4*)(x + EO_OFF(s_)));
    }
    __device__ __forceinline__ void operator()(EPI_ARGS) const {
        const int bb = (u.pm * 256) >> 11; const bool lo8 = fr < 8;
        const size_t rowb = EO_FULL ? ((size_t)u.pm * 256 + wr * 64 + (fr & 7)) * 1024 + u.pn * 256 + wc * 32 + (fr >> 3) * 16 + 4 * fq : ((size_t)u.pm * 256 + wr * 64 + fr) * 1024 + u.pn * 256 + wc * 32 + 4 * fq;
        f32x4 gt[4];
#pragma unroll
        for (int q = 0; q < 4; ++q) gt[q] = *(const f32x4*)(mod + bb * 6144 + 2048 + u.pn * 256 + wc * 32 + 4 * fq + (q >> 1) * 128 + (q & 1) * 16);
        if (EO_FULL) {
#pragma unroll
            for (int b2 = 0; b2 < 2; ++b2)
#pragma unroll
                for (int e = 0; e < 4; ++e) { const float g_ = lo8 ? gt[b2 * 2][e] : gt[b2 * 2 + 1][e]; gt[b2 * 2][e] = g_; gt[b2 * 2 + 1][e] = g_; } }
        f32x4 xq[8];
#pragma unroll
        for (int s_ = 0; s_ < 8; ++s_) xq[s_] = pre.xq[s_];
        f32x4 aA = (f32x4){0.f, 0.f, 0.f, 0.f}, aB = aA;
#pragma unroll
        for (int s_ = 0; s_ < 32; ++s_) { const int ai = s_ >> 4, m = (s_ >> 2) & 3, bj = (s_ >> 1) & 1, n = s_ & 1;
            const f32x4 xv = xq[s_ & 7];
            if (s_ + 8 < 32) xq[s_ & 7] = NTLD((const f32x4*)(x + EO_OFF(s_ + 8)));
            f32x4 av = acc[ai][bj][m][n];
            if (EO_FULL) {
                if (n == 0) {
#pragma unroll
                    for (int e = 0; e < 4; ++e) { const float mine0 = acc[ai][bj][m][0][e], mine1 = acc[ai][bj][m][1][e]; const float give = lo8 ? mine1 : mine0;
                        const float got = __builtin_bit_cast(float, __builtin_amdgcn_update_dpp(0, __builtin_bit_cast(int, give), 0x128, 0xf, 0xf, false));
                        aA[e] = lo8 ? mine0 : got; aB[e] = lo8 ? got : mine1; } }
                av = (n == 0) ? aA : aB; }
            f32x4 hv_ = xv + gt[bj * 2 + n] * av;
#ifdef H1_BF16_EMU
            { const unsigned w0 = cvt_pk_bf16(hv_[0], hv_[1]), w1 = cvt_pk_bf16(hv_[2], hv_[3]); hv_ = (f32x4){bf_lo(w0), bf_hi(w0), bf_lo(w1), bf_hi(w1)}; }
#endif
            st16f((void*)(H1 + EO_OFF(s_)), hv_); }
    }
#undef EO_OFF
};
struct EpiOutB { static constexpr bool PERM = true; const float* x; const float* mod; bf16_t* H1B;
    struct Pre { f32x4 xq[8]; };
#define EO_OFF(s_) (rowb + (size_t)(((s_) >> 3) * 128 + (((s_) >> 1) & 3) * 16) * 1024 + ((s_) & 1) * 128)
    __device__ __forceinline__ void prefetch(Pre& pre, const Unit& u, int wr, int wc, int fr, int fq) const {
        const size_t rowb = ((size_t)u.pm * 256 + wr * 64 + fr) * 1024 + u.pn * 256 + wc * 32 + 8 * fq;
#pragma unroll
        for (int s_ = 0; s_ < 4; ++s_) { pre.xq[2 * s_] = *(const f32x4*)(x + EO_OFF(s_)); pre.xq[2 * s_ + 1] = *(const f32x4*)(x + EO_OFF(s_) + 4); }
    }
    __device__ __forceinline__ void operator()(EPI_ARGS) const {
        const int bb = (u.pm * 256) >> 11;
        const size_t rowb = ((size_t)u.pm * 256 + wr * 64 + fr) * 1024 + u.pn * 256 + wc * 32 + 8 * fq;
        f32x4 gt[2][2];
#pragma unroll
        for (int bj = 0; bj < 2; ++bj) { const float* gp = mod + bb * 6144 + 2048 + u.pn * 256 + wc * 32 + 8 * fq + bj * 128; gt[bj][0] = *(const f32x4*)gp; gt[bj][1] = *(const f32x4*)(gp + 4); }
        f32x4 xq[8];
#pragma unroll
        for (int s_ = 0; s_ < 8; ++s_) xq[s_] = pre.xq[s_];
#pragma unroll
        for (int s_ = 0; s_ < 16; ++s_) { const int ai = s_ >> 3, m = (s_ >> 1) & 3, bj = s_ & 1;
            const f32x4 x0 = xq[2 * (s_ & 3)], x1 = xq[2 * (s_ & 3) + 1];
            if (s_ + 4 < 16) { xq[2 * (s_ & 3)] = *(const f32x4*)(x + EO_OFF(s_ + 4)); xq[2 * (s_ & 3) + 1] = *(const f32x4*)(x + EO_OFF(s_ + 4) + 4); }
            st16((void*)(H1B + EO_OFF(s_)), pack8(x0 + gt[bj][0] * acc[ai][bj][m][0], x1 + gt[bj][1] * acc[ai][bj][m][1])); }
    }
#undef EO_OFF
};
struct MoeTab { const LAS int* cnt; const LAS int* tstart; LAS int* lists; const LAS int* segp; };
__device__ __forceinline__ void moe_find(const MoeTab& mt, int rt, int& e, int& lt) { int ee = 0; for (int q = 1; q < 32; ++q) if (mt.tstart[q] <= rt) ee = q; e = __builtin_amdgcn_readfirstlane(ee); lt = __builtin_amdgcn_readfirstlane(rt - mt.tstart[ee]); }
__device__ __forceinline__ void moe_unit(long L, int nt_total, int& rt, int& pn) {
    const int ntf = (nt_total >> 3) << 3;
    if (L < 4l * ntf) { const int x = (int)(L & 7), y = (int)(L >> 3); rt = (y >> 2) * 8 + x; pn = y & 3; }
    else { const int l2 = (int)(L - 4l * ntf); rt = ntf + (l2 >> 2); pn = l2 & 3; }
}
__device__ __forceinline__ int moe_phys(const MoeTab& mt, int e, int ri) { const int p1 = mt.segp[e * 4 + 1], p2 = mt.segp[e * 4 + 2], p3 = mt.segp[e * 4 + 3];
    const int sg = (ri >= p1) + (ri >= p2) + (ri >= p3); const int pb = sg == 0 ? 0 : (sg == 1 ? p1 : (sg == 2 ? p2 : p3)); return sg * (ECAP / 4) + (ri - pb); }
#define MOE_E(a_) ((a_) & 255)
#define MOE_LT(a_) (((a_) >> 8) & 0xfffff)
#define MOE_BUF(a_) (((a_) >> 28) & 3)
struct SchedUp { static constexpr bool LISTS = true; static constexpr int SWZ8 = SWZ_UP; const char* XN2; const char* WUPT; const int* rowtok; MoeTab mt; int G, c; const float* roww;
    __device__ __forceinline__ bool next(int i, Unit& u) const { const long L = (long)i * G + c; const int ntt = __builtin_amdgcn_readfirstlane(mt.tstart[32]); if (L >= 4l * ntt) return false; int rt, pn; moe_unit(L, ntt, rt, pn); int e, lt; moe_find(mt, rt, e, lt);
        constexpr int EB = FP8_MOE ? 1 : 2;
        u.A0 = XN2; u.A1 = XN2; u.B0 = WUPT + ((size_t)(e * 1024 + pn * 256) * 1024) * EB; u.B1 = u.B0 + 128 * 1024 * EB; u.nt = FP8_MOE ? 8 : 16; u.pm = rt; u.pn = pn; u.aux = e | (lt << 8) | ((i % 3) << 28); return true; }
    __device__ __forceinline__ void list_dma(const Unit& u, int wid, int lane) const { const int e = MOE_E(u.aux), lt = MOE_LT(u.aux), cn = mt.cnt[e]; const int r = (wid & 3) * 64 + lane, ri = lt * 256 + r, ric = ri < cn ? ri : cn - 1;
        const int* src = ((wid < 4) ? rowtok : (const int*)roww) + (size_t)e * ECAP + moe_phys(mt, e, ric);
        __builtin_amdgcn_global_load_lds((const unsigned*)src, (LAS unsigned*)(mt.lists + MOE_BUF(u.aux) * 512 + wid * 64), 4, 0, 0); }
    __device__ __forceinline__ void voff(const Unit& u, int tid, unsigned (&va)[2][2], unsigned (&vb)[2]) const {
        asm volatile("" : "+v"(tid));
        constexpr int EB = FP8_MOE ? 1 : 2; const LAS int* tl = mt.lists + MOE_BUF(u.aux) * 512;
#pragma unroll
        for (int i = 0; i < 2; ++i) { int R, C; mg::stage_rc<FP8_MOE ? SWZ8 : 5>(tid * 16 + i * 8192, R, C); const int Rb = (R & ~31) + mg::perm32(R & 31); vb[i] = (unsigned)(Rb * 1024 * EB + C * 2);
#pragma unroll
            for (int h = 0; h < 2; ++h) { const int tok = tl[h * 128 + R] >> 1; va[h][i] = (unsigned)tok * (1024u * EB) + (unsigned)C * 2u; } }
    }
};
struct EpiUp { static constexpr bool PERM = true; bf16_t* HID; const float* roww; MoeTab mt;
    struct Pre { float w[8]; };
    __device__ __forceinline__ void prefetch(Pre& pre, const Unit& u, int wr, int wc, int fr, int fq) const {
        const int e = MOE_E(u.aux), lt = MOE_LT(u.aux), cn = mt.cnt[e]; const LAS float* wl_ = (const LAS float*)(mt.lists + MOE_BUF(u.aux) * 512 + 256);
#pragma unroll
        for (int q = 0; q < 8; ++q) { const int r = (q >> 2) * 128 + wr * 64 + (q & 3) * 16 + fr; const float wv = wl_[r]; pre.w[q] = (lt * 256 + r < cn) ? wv : 0.f; }
    }
    __device__ __forceinline__ void operator()(EPI_ARGS) const {
        u32x2 pke = (u32x2){0u, 0u}; (void)pke;
#pragma unroll
        for (int ai = 0; ai < 2; ++ai)
#pragma unroll
            for (int m = 0; m < 4; ++m) { const int r = ai * 128 + wr * 64 + m * 16 + fr; const float w = pre.w[ai * 4 + m];
                f32x4 h0, h1;
#pragma unroll
                for (int q = 0; q < 4; ++q) { h0[q] = fsilu(acc[ai][0][m][0][q]) * acc[ai][1][m][0][q] * w; h1[q] = fsilu(acc[ai][0][m][1][q]) * acc[ai][1][m][1][q] * w; if (Q8_MOE) { h0[q] = q8(h0[q], 8.f, 0.125f); h1[q] = q8(h1[q], 8.f, 0.125f); } }
                if (FP8_MOE) { h0 *= 8.0f; h1 *= 8.0f; const u32x2 pk = (u32x2){pk4_fp8(h0[0], h0[1], h0[2], h0[3]), pk4_fp8(h1[0], h1[1], h1[2], h1[3])};
                    if (WIDE8) { if ((m & 1) == 0) pke = pk; else { const u32x4 w16 = widen8(pke, pk);
                            const int rr = (fq & 1) ? r : r - 16; const int cb = (fq & 1) ? 8 * (fq - 1) : 8 * fq;
                            st16((void*)((unsigned char*)HID + ((size_t)u.pm * 256 + rr) * 512 + u.pn * 128 + wc * 32 + cb), w16); } }
                    else st8((void*)((unsigned char*)HID + ((size_t)u.pm * 256 + r) * 512 + u.pn * 128 + wc * 32 + 8 * fq), pk); }
                else st16((void*)(HID + ((size_t)u.pm * 256 + r) * 512 + u.pn * 128 + wc * 32 + 8 * fq), pack8(h0, h1)); }
    }
};
struct EpiUpMath { static constexpr bool PERM = true; NO_PREFETCH const float* roww; MoeTab mt;
    __device__ __forceinline__ void operator()(EPI_ARGS) const {
        const int e = MOE_E(u.aux), lt = MOE_LT(u.aux), cn = mt.cnt[e];
#pragma unroll
        for (int ai = 0; ai < 2; ++ai)
#pragma unroll
            for (int m = 0; m < 4; ++m) { const int r = ai * 128 + wr * 64 + m * 16 + fr, ri = lt * 256 + r; const float w = (ri < cn) ? roww[(size_t)e * ECAP + ri] : 0.f;
                f32x4 h0, h1;
#pragma unroll
                for (int q = 0; q < 4; ++q) { h0[q] = fsilu(acc[ai][0][m][0][q]) * acc[ai][1][m][0][q] * w * 8.0f; h1[q] = fsilu(acc[ai][0][m][1][q]) * acc[ai][1][m][1][q] * w * 8.0f; }
                const u32x2 o = (u32x2){pk4_fp8(h0[0], h0[1], h0[2], h0[3]), pk4_fp8(h1[0], h1[1], h1[2], h1[3])}; asm volatile("" :: "v"(o)); }
    }
};
struct SchedDn { static constexpr bool LISTS = true; static constexpr bool VOFF_CONST = true; static constexpr int SWZ8 = SWZ_DN; const char* HID; const char* WDNT; MoeTab mt; int G, c; const int* rowtok;
    __device__ __forceinline__ bool next(int i, Unit& u) const { const long L = (long)i * G + c; const int ntt = __builtin_amdgcn_readfirstlane(mt.tstart[32]); if (L >= 4l * ntt) return false; int rt, pn; moe_unit(L, ntt, rt, pn); int e, lt; moe_find(mt, rt, e, lt);
        constexpr int EB = FP8_MOE ? 1 : 2;
        u.A0 = HID + (size_t)rt * 256 * 512 * EB; u.A1 = u.A0 + 128 * 512 * EB; u.B0 = WDNT + ((size_t)(e * 1024 + pn * 256) * 512) * EB; u.B1 = u.B0 + 128 * 512 * EB; u.nt = FP8_MOE ? 4 : 8; u.pm = rt; u.pn = pn; u.aux = e | (lt << 8) | ((i % 3) << 28); return true; }
    __device__ __forceinline__ void list_dma(const Unit& u, int wid, int lane) const { if (wid >= 4) return; const int e = MOE_E(u.aux), lt = MOE_LT(u.aux), cn = mt.cnt[e]; const int ri = lt * 256 + wid * 64 + lane, ric = ri < cn ? ri : cn - 1;
        __builtin_amdgcn_global_load_lds((const unsigned*)(rowtok + (size_t)e * ECAP + moe_phys(mt, e, ric)), (LAS unsigned*)(mt.lists + MOE_BUF(u.aux) * 512 + wid * 64), 4, 0, 0); }
    __device__ __forceinline__ void voff(const Unit&, int tid, unsigned (&va)[1][2], unsigned (&vb)[2]) const { if (FP8_MOE) mg::std_voff8<true, SWZ8>(tid, 512, 512, va, vb); else mg::std_voff<true>(tid, 512, 512, va, vb); }
};
struct EpiDn { static constexpr bool PERM = true; bf16_t* SLOT; const int* rowtok; MoeTab mt;
    struct Pre { int slot[8]; };
    __device__ __forceinline__ void prefetch(Pre& pre, const Unit& u, int wr, int wc, int fr, int fq) const {
        const int e = MOE_E(u.aux), lt = MOE_LT(u.aux), cn = mt.cnt[e]; const LAS int* sl_ = mt.lists + MOE_BUF(u.aux) * 512;
#pragma unroll
        for (int q = 0; q < 8; ++q) { const int r = (q >> 2) * 128 + wr * 64 + (q & 3) * 16 + fr; const int sv = sl_[r]; pre.slot[q] = (lt * 256 + r < cn) ? sv : -1; }
    }
    __device__ __forceinline__ void operator()(EPI_ARGS) const {
#pragma unroll
        for (int ai = 0; ai < 2; ++ai)
#pragma unroll
            for (int m = 0; m < 4; ++m) { const int sl = pre.slot[ai * 4 + m];
                if (FP8_SLOT && WIDE8) {
                    const f32x4 a0 = acc[ai][0][m][0] * 16.0f, a1 = acc[ai][0][m][1] * 16.0f, b0 = acc[ai][1][m][0] * 16.0f, b1 = acc[ai][1][m][1] * 16.0f;
                    const u32x4 w16 = widen8((u32x2){pk4_fp8(a0[0], a0[1], a0[2], a0[3]), pk4_fp8(a1[0], a1[1], a1[2], a1[3])}, (u32x2){pk4_fp8(b0[0], b0[1], b0[2], b0[3]), pk4_fp8(b1[0], b1[1], b1[2], b1[3])});
                    if (sl >= 0) st16((void*)((unsigned char*)SLOT + (size_t)sl * 1024 + u.pn * 256 + wc * 32 + ((fq & 1) ? 128 + 8 * (fq - 1) : 8 * fq)), w16);
                } else if (sl >= 0) { const size_t slot = (size_t)sl;
#pragma unroll
                    for (int bj = 0; bj < 2; ++bj) {
                        if (FP8_SLOT) { const f32x4 a0 = acc[ai][bj][m][0] * 16.0f, a1 = acc[ai][bj][m][1] * 16.0f;
                            st8((void*)((unsigned char*)SLOT + slot * 1024 + u.pn * 256 + bj * 128 + wc * 32 + 8 * fq), (u32x2){pk4_fp8(a0[0], a0[1], a0[2], a0[3]), pk4_fp8(a1[0], a1[1], a1[2], a1[3])}); }
                        else st16((void*)(SLOT + slot * 1024 + u.pn * 256 + bj * 128 + wc * 32 + 8 * fq), pack8(acc[ai][bj][m][0], acc[ai][bj][m][1])); } }
            }
    }
};
__device__ __forceinline__ MoeTab moe_table(const Params& p, const Ctx& c) {
    LAS int* cnt = (LAS int*)(c.lds + XT_OFF); LAS int* ts = (LAS int*)(c.lds + XT_OFF + 256);
    LAS int* sp = (LAS int*)(c.lds + XT_OFF + 512);
    if (c.tid < 32) { int a = 0;
#pragma unroll
        for (int sg = 0; sg < 4; ++sg) { sp[c.tid * 4 + sg] = a; a += (int)__hip_atomic_load((unsigned*)(p.ws + WS_CTL) + CW_CURSOR + 64 * (c.tid * 4 + sg), RLX_AGENT); }
        cnt[c.tid] = a; }
    __syncthreads();
    if (c.tid == 0) { int s = 0; for (int e = 0; e < 32; ++e) { ts[e] = s; s += (cnt[e] + 255) >> 8; } ts[32] = s; }
    __syncthreads();
    MoeTab mt; mt.cnt = cnt; mt.tstart = ts; mt.lists = (LAS int*)(c.lds + XT_OFF + 1024); mt.segp = (const LAS int*)(c.lds + XT_OFF + 512); return mt;
}

__device__ __forceinline__ void p4_scan(const Params& p, const Ctx& c) {
    typedef float f2 __attribute__((ext_vector_type(2)));
    const float* SST = (const float*)(p.ws + WS_SST); bf16_t* HP = (bf16_t*)(p.ws + WS_HP);
    for (int gid = c.vcu * NTHREADS + c.tid; gid < 65536; gid += c.G * NTHREADS) {
        const int g = gid >> 11, b = (gid >> 6) & 31, n = gid & 63;
        const f2 al = ((const f2*)(p.ws + WS_AL))[g * 64 + n];
        float hr = 0.f, hi = 0.f;
        for (int cc = 0; cc < 32; ++cc) { const size_t row = (size_t)g * 1024 + b * 32 + cc;
            HP[row * 256 + n] = (bf16_t)f2bf(hr); HP[row * 256 + 64 + n] = (bf16_t)f2bf(hi); HP[row * 256 + 128 + n] = 0; HP[row * 256 + 192 + n] = 0;
            const float sr = SST[row * 128 + n], si = SST[row * 128 + 64 + n];
            const float nr = al.x * hr - al.y * hi + sr, ni = al.x * hi + al.y * hr + si; hr = nr; hi = ni; }
    }
}

__device__ __forceinline__ void p7_sgu(const Params& p, const Ctx& c) {
    typedef float f32x16 __attribute__((ext_vector_type(16)));
    constexpr int VS = 136;
    LAS bf16_t* VT = (LAS bf16_t*)c.lds;
    const bf16_t* GV = (const bf16_t*)(p.ws + WS_GV); const bf16_t* U = (const bf16_t*)(p.ws + WS_U); bf16_t* YB = (bf16_t*)(p.ws + WS_YB);
    const bf16_t* SW = (const bf16_t*)(p.ws + WS_SGUW);
    const int lane = c.lane, w = c.wave;
    f32x4 lg0 = *(const f32x4*)(p.in[I_LNG] + 8 * lane), lg1 = *(const f32x4*)(p.in[I_LNG] + 8 * lane + 4), lb0 = *(const f32x4*)(p.in[I_LNB] + 8 * lane), lb1 = *(const f32x4*)(p.in[I_LNB] + 8 * lane + 4);
    for (int un = c.vcu; un < 512; un += c.G) {
        const size_t t0 = (size_t)un * 128;
        unsigned pk[8][8];
#pragma unroll
        for (int rr = 0; rr < 16; ++rr) {
            f32x4 a, b; unpack8(NTLD((const u32x4*)(GV + (t0 + 16 * w + rr) * 512 + 8 * lane)), a, b);
            const float mu = wave_sum((a[0] + a[1]) + (a[2] + a[3]) + (b[0] + b[1]) + (b[2] + b[3])) * (1.0f / 512.0f);
            a -= mu; b -= mu;
            const float var = wave_sum((a[0] * a[0] + a[1] * a[1]) + (a[2] * a[2] + a[3] * a[3]) + (b[0] * b[0] + b[1] * b[1]) + (b[2] * b[2] + b[3] * b[3])) * (1.0f / 512.0f);
            const float rs = 1.0f / sqrtf(var + 1e-5f);
            a = a * rs * lg0 + lb0; b = b * rs * lg1 + lb1;
#pragma unroll
            for (int j = 0; j < 4; ++j) {
                if (rr & 1) { pk[j][rr >> 1] |= f2bf(a[j]) << 16; pk[4 + j][rr >> 1] |= f2bf(b[j]) << 16; }
                else { pk[j][rr >> 1] = f2bf(a[j]); pk[4 + j][rr >> 1] = f2bf(b[j]); }
            }
        }
#pragma unroll
        for (int j = 0; j < 8; ++j) { LAS bf16_t* d = VT + (8 * lane + j) * VS + 16 * w;
            *(LAS u32x4*)d = (u32x4){pk[j][0], pk[j][1], pk[j][2], pk[j][3]}; *(LAS u32x4*)(d + 8) = (u32x4){pk[j][4], pk[j][5], pk[j][6], pk[j][7]}; }
        __syncthreads();
        const int tb = w & 3, db = w >> 2, l31 = lane & 31, hi = lane >> 5;
        LAS unsigned char* wu = c.lds + 139264 + w * 2560;
        const int lr = lane >> 2, lp = lane & 3;
        const size_t gbase = (t0 + tb * 32 + lr) * 512 + db * 32 + lp * 8;
        u32x4 un0 = NTLD((const u32x4*)(U + gbase)), un1 = NTLD((const u32x4*)(U + gbase + 16 * 512));
        for (int h = 0; h < 8; ++h) {
            *(LAS u32x4*)(wu + lr * 80 + lp * 16) = un0; *(LAS u32x4*)(wu + (lr + 16) * 80 + lp * 16) = un1;
            if (h < 7) { un0 = NTLD((const u32x4*)(U + gbase + (h + 1) * 64)); un1 = NTLD((const u32x4*)(U + gbase + 16 * 512 + (h + 1) * 64)); }
            f32x16 acc;
#pragma unroll
            for (int q = 0; q < 16; ++q) acc[q] = 0.f;
            const LAS bf16_t* arow = VT + (h * 64 + db * 32 + l31) * VS + 8 * hi;
            const bf16_t* brow = SW + ((size_t)(h * 128 + tb * 32 + l31)) * 128 + 8 * hi;
            const int nks = 2 * tb + 2;
            bf16x8 bq[8];
            (void)nks;
#pragma unroll
            for (int ks = 0; ks < 8; ++ks) bq[ks] = *(const bf16x8*)(brow + 16 * ks);
#pragma unroll
            for (int ks = 0; ks < 8; ++ks) { const bf16x8 af = *(const LAS bf16x8*)(arow + 16 * ks); acc = __builtin_amdgcn_mfma_f32_32x32x16_bf16(af, bq[ks], acc, 0, 0, 0); }
            const int tt = tb * 32 + l31; const float bs = p.in[I_SGUB][h * 128 + tt];
#pragma unroll
            for (int q = 0; q < 4; ++q) {
                LAS u32x2* up = (LAS u32x2*)(wu + l31 * 80 + 16 * q + 8 * hi);
                const u32x2 uu = *up;
                float y0 = bf_lo(uu.x) * (acc[4 * q] + bs), y1 = bf_hi(uu.x) * (acc[4 * q + 1] + bs), y2 = bf_lo(uu.y) * (acc[4 * q + 2] + bs), y3 = bf_hi(uu.y) * (acc[4 * q + 3] + bs);
                if (Q8_P8) { y0 = q8(y0, 8.f, 0.125f); y1 = q8(y1, 8.f, 0.125f); y2 = q8(y2, 8.f, 0.125f); y3 = q8(y3, 8.f, 0.125f); }
                if (FP8_MERGE) *(LAS unsigned*)(wu + l31 * 80 + 8 * q + 4 * hi) = pk4_fp8(y0 * 8.0f, y1 * 8.0f, y2 * 8.0f, y3 * 8.0f);
                else *up = (u32x2){cvt_pk_bf16(y0, y1), cvt_pk_bf16(y2, y3)};
            }
            if (FP8_MERGE) { const u32x4 yo = *(const LAS u32x4*)(wu + (lane >> 1) * 80 + (lane & 1) * 16);
                *(u32x4*)((unsigned char*)YB + (t0 + tb * 32 + (lane >> 1)) * 512 + h * 64 + db * 32 + (lane & 1) * 16) = yo; }
            else { const u32x4 yo0 = *(const LAS u32x4*)(wu + lr * 80 + lp * 16), yo1 = *(const LAS u32x4*)(wu + (lr + 16) * 80 + lp * 16);
                *(u32x4*)(YB + gbase + h * 64) = yo0; *(u32x4*)(YB + gbase + 16 * 512 + h * 64) = yo1; }
            LDS_WAIT();
        }
        __syncthreads();
    }
}

__device__ __forceinline__ void p10_norm_router(const Params& p, const Ctx& c, const bool probe = false) {
    LAS f32x4* WR = (LAS f32x4*)c.lds;
    LAS int* RT = (LAS int*)(c.lds + 147456);
    LAS int* hist = (LAS int*)(c.lds + 147456 + 4096);
    const float* mod = (const float*)(p.ws + WS_MOD); const float* H1 = p.out; bf16_t* XN2 = (bf16_t*)(p.ws + (probe ? WS_GATES : WS_XN));
    int* rowtok = (int*)(p.ws + (probe ? WS_SLOT : WS_ROWTOK)); float* roww = (float*)(p.ws + (probe ? WS_SLOT + 32 * MiB : WS_ROWW)); unsigned* cursor = (unsigned*)(p.ws + WS_CTL) + CW_CURSOR + (probe ? 64 * 64 : 0);
    for (int idx = c.tid; idx < 16 * 9 * 64; idx += NTHREADS) { const int l = idx & 63, q = (idx >> 6) % 9, ji = idx / 576, k = 4 * l + (ji & 3) + 256 * (ji >> 2);
        WR[idx] = (q == 0) ? *(const f32x4*)(p.in[I_WRG] + k * 4) : *(const f32x4*)(p.in[I_WRE] + ((size_t)((q - 1) >> 1) * 1024 + k) * 8 + ((q - 1) & 1) * 4); }
    LAS float* BRE = (LAS float*)(c.lds + 147456 + 4096 + 512);
    if (c.tid < 64) hist[c.tid] = 0;
    if (c.tid < 32) BRE[c.tid] = p.in[I_BRE2][c.tid];
    const float brg[4] = {p.in[I_BRG][0], p.in[I_BRG][1], p.in[I_BRG][2], p.in[I_BRG][3]};
    __syncthreads();
    for (int rb = c.vcu; rb < 256; rb += c.G) {
        const int b = rb >> 3;
        f32x4 vn[2][4];
#pragma unroll
        for (int u2 = 0; u2 < 2; ++u2) { const GAS f32x4* xr0 = (const GAS f32x4*)(H1 + ((size_t)rb * 256 + c.wave * 32 + u2) * D) + c.lane;
#pragma unroll
          for (int j = 0; j < 4; ++j) vn[u2][j] = xr0[64 * j]; }
        for (int i = 0; i < 32; i += 2) {
            const LAS f32x4* WRl = WR + c.lane; asm volatile("" : "+v"(WRl));
            f32x4 v[2][4]; float rr[2];
#pragma unroll
            for (int u2 = 0; u2 < 2; ++u2) { float s = 0.f;
#pragma unroll
                for (int j = 0; j < 4; ++j) { v[u2][j] = vn[u2][j]; s += (v[u2][j].x * v[u2][j].x + v[u2][j].y * v[u2][j].y) + (v[u2][j].z * v[u2][j].z + v[u2][j].w * v[u2][j].w); }
                rr[u2] = s; }
            { const int inx = (i < 30) ? i + 2 : i;
#pragma unroll
              for (int u2 = 0; u2 < 2; ++u2) { const GAS f32x4* xrn = (const GAS f32x4*)(H1 + ((size_t)rb * 256 + c.wave * 32 + inx + u2) * D) + c.lane;
#pragma unroll
                for (int j = 0; j < 4; ++j) vn[u2][j] = xrn[64 * j]; } }
            f32x4 lg[2];
#pragma unroll
            for (int u2 = 0; u2 < 2; ++u2) { const size_t row = (size_t)rb * 256 + c.wave * 32 + i + u2;
                const float r = 1.0f / sqrtf(wave_sum(rr[u2]) * (1.0f / D) + 1e-6f);
                GAS unsigned long long* o8 = (GAS unsigned long long*)(XN2 + row * D) + c.lane;
                lg[u2] = (f32x4){0.f, 0.f, 0.f, 0.f};
#pragma unroll
                for (int j = 0; j < 4; ++j) { const int k = 4 * c.lane + 256 * j;
                    const f32x4 g_ = *(const f32x4*)(p.in[I_N2G] + k), sc_ = *(const f32x4*)(mod + b * 6144 + 4096 + k), sh_ = *(const f32x4*)(mod + b * 6144 + 3072 + k);
                    v[u2][j] = v[u2][j] * r * (g_ * (sc_ + 1.0f)) + sh_; { f32x4 y = v[u2][j]; if (Q8_MOE) { y.x = q8(y.x, 1.f, 1.f); y.y = q8(y.y, 1.f, 1.f); y.z = q8(y.z, 1.f, 1.f); y.w = q8(y.w, 1.f, 1.f); }
                      if (FP8_MOE) ((GAS unsigned*)((unsigned char*)XN2 + row * D) + c.lane)[64 * j] = pk4_fp8(y.x, y.y, y.z, y.w);
                      else o8[64 * j] = (unsigned long long)pk2(y.x, y.y) | ((unsigned long long)pk2(y.z, y.w) << 32); } } }
#pragma unroll
            for (int j = 0; j < 4; ++j) {
#pragma unroll
                for (int ii = 0; ii < 4; ++ii) { const f32x4 w = WRl[((j * 4 + ii) * 9 + 0) * 64]; lg[0] += w * v[0][j][ii]; lg[1] += w * v[1][j][ii]; }
                if (j & 1) __builtin_amdgcn_sched_barrier(0); }
            int grp[2]; float pg[2];
#pragma unroll
            for (int u2 = 0; u2 < 2; ++u2) { float l4[4];
#pragma unroll
                for (int q = 0; q < 4; ++q) l4[q] = wave_sum(lg[u2][q]) + brg[q];
                int g_ = 0; float mx = l4[0];
#pragma unroll
                for (int q = 1; q < 4; ++q) if (l4[q] > mx) { mx = l4[q]; g_ = q; }
                float se = 0.f;
#pragma unroll
                for (int q = 0; q < 4; ++q) se += __expf(l4[q] - mx);
                pg[u2] = 1.0f / se; grp[u2] = __builtin_amdgcn_readfirstlane(g_); }
            f32x4 ex0[2], ex1[2];
#pragma unroll
            for (int u2 = 0; u2 < 2; ++u2) { ex0[u2] = (f32x4){0.f, 0.f, 0.f, 0.f}; ex1[u2] = ex0[u2]; }
#pragma unroll
            for (int j = 0; j < 4; ++j) {
#pragma unroll
                for (int ii = 0; ii < 4; ++ii)
#pragma unroll
                    for (int u2 = 0; u2 < 2; ++u2) { const LAS f32x4* wp = WRl + ((j * 4 + ii) * 9 + 1 + 2 * grp[u2]) * 64; ex0[u2] += wp[0] * v[u2][j][ii]; ex1[u2] += wp[64] * v[u2][j][ii]; }
                __builtin_amdgcn_sched_barrier(0); }
#pragma unroll
            for (int u2 = 0; u2 < 2; ++u2) { const int rl = c.wave * 32 + i + u2; float le[8];
#pragma unroll
                for (int q = 0; q < 4; ++q) { le[q] = wave_sum(ex0[u2][q]) + BRE[grp[u2] * 8 + q]; le[4 + q] = wave_sum(ex1[u2][q]) + BRE[grp[u2] * 8 + 4 + q]; }
                int i0 = 0; float v0 = le[0];
#pragma unroll
                for (int q = 1; q < 8; ++q) if (le[q] > v0) { v0 = le[q]; i0 = q; }
                int i1 = -1; float v1 = -3.0e38f;
#pragma unroll
                for (int q = 0; q < 8; ++q) if (q != i0 && le[q] > v1) { v1 = le[q]; i1 = q; }
                const float ex = __expf(v1 - v0), p0 = 1.0f / (1.0f + ex), p1 = ex / (1.0f + ex);
                if (c.lane == 0) { RT[rl * 4 + 0] = grp[u2] * 8 + i0; RT[rl * 4 + 1] = grp[u2] * 8 + i1; RT[rl * 4 + 2] = (int)__float_as_uint(pg[u2] * p0); RT[rl * 4 + 3] = (int)__float_as_uint(pg[u2] * p1); } }
        }
        __syncthreads();
        int e0 = 0, e1 = 0, r0 = 0, r1 = 0;
        if (c.tid < 256) { e0 = RT[c.tid * 4]; e1 = RT[c.tid * 4 + 1]; r0 = __hip_atomic_fetch_add(&hist[e0], 1, __ATOMIC_RELAXED, __HIP_MEMORY_SCOPE_WORKGROUP); r1 = __hip_atomic_fetch_add(&hist[e1], 1, __ATOMIC_RELAXED, __HIP_MEMORY_SCOPE_WORKGROUP); }
        __syncthreads();
        if (c.tid < 32) hist[32 + c.tid] = (int)__hip_atomic_fetch_add(cursor + 64 * c.tid, (unsigned)hist[c.tid], RLX_AGENT);
        __syncthreads();
        if (c.tid < 256) { const int tok = rb * 256 + c.tid; const int p0 = hist[32 + e0] + r0, p1 = hist[32 + e1] + r1;
            rowtok[(size_t)e0 * ECAP + p0] = tok * 2; roww[(size_t)e0 * ECAP + p0] = __uint_as_float((unsigned)RT[c.tid * 4 + 2]);
            rowtok[(size_t)e1 * ECAP + p1] = tok * 2 + 1; roww[(size_t)e1 * ECAP + p1] = __uint_as_float((unsigned)RT[c.tid * 4 + 3]); }
        __syncthreads();
        if (c.tid < 32) hist[c.tid] = 0;
        __syncthreads();
    }
}

__device__ __forceinline__ void p11_router_mfma(const Params& p, const Ctx& c, const bool probe = false) {
    constexpr int TS = 1032;
    LAS bf16_t* TH = (LAS bf16_t*)c.lds; LAS bf16_t* TL = TH + 16 * TS;
    LAS float* PART = (LAS float*)(c.lds + 2 * 16 * TS * 2);
    LAS float* LGA = (LAS float*)(c.lds + 114688);
    LAS int* RT = (LAS int*)(c.lds + 147456); LAS int* hist = (LAS int*)(c.lds + 147456 + 4096);
    LAS unsigned char* wl8 = c.lds + 98304 + c.wave * 2048;
    const float* mod = (const float*)(p.ws + WS_MOD); const float* H1 = p.out; const size_t dmul = (HOT11 && probe) ? (size_t)0 : (size_t)D; const bf16_t* H1B = (const bf16_t*)(p.ws + WS_H1B); unsigned char* XN2 = p.ws + (probe ? WS_GATES : WS_XN);
    int* rowtok = (int*)(p.ws + (probe ? WS_SLOT : WS_ROWTOK)); float* roww = (float*)(p.ws + (probe ? WS_SLOT + 32 * MiB : WS_ROWW)); unsigned* cursor = (unsigned*)(p.ws + WS_CTL) + CW_CURSOR + (probe ? 64 * 256 : 0);
    const int lane = c.lane, w = c.wave, l15 = lane & 15, lq = lane >> 4;
    bf16x8 bh[4][3], bl[4][3];
#pragma unroll
    for (int ks = 0; ks < 4; ++ks)
#pragma unroll
        for (int cb = 0; cb < 3; ++cb) { const size_t o = (size_t)(cb * 16 + l15) * 1024 + 128 * w + 32 * ks + 8 * lq; bh[ks][cb] = *(const bf16x8*)((const bf16_t*)(p.ws + WS_WRH) + o); bl[ks][cb] = *(const bf16x8*)((const bf16_t*)(p.ws + WS_WRL) + o); }
    LAS float* BIAS = (LAS float*)(c.lds + 147456 + 4096 + 512);
    if (c.tid < 64) hist[c.tid] = 0;
    if (c.tid < 4) BIAS[c.tid] = p.in[I_BRG][c.tid]; else if (c.tid < 36) BIAS[c.tid] = p.in[I_BRE2][c.tid - 4];
    __syncthreads();
    for (int rb = c.vcu; rb < 256; rb += c.G) {
        const int b = rb >> 3;
        f32x4 A[4], Bc[4];
#pragma unroll
        for (int j = 0; j < 4; ++j) { const int k = 4 * lane + 256 * j; const f32x4 g_ = *(const f32x4*)(p.in[I_N2G] + k), sc_ = *(const f32x4*)(mod + b * 6144 + 4096 + k); A[j] = g_ * (sc_ + 1.0f); Bc[j] = *(const f32x4*)(mod + b * 6144 + 3072 + k); }
        f32x4 vn[2][4], vm[2][4];
#pragma unroll
        for (int u2 = 0; u2 < 2; ++u2) { const size_t r0_ = (size_t)rb * 256 + 2 * w + u2;
#pragma unroll
            for (int j = 0; j < 4; ++j) { vn[u2][j] = NTLD((const GAS f32x4*)(H1 + r0_ * dmul) + lane + 64 * j); vm[u2][j] = NTLD((const GAS f32x4*)(H1 + (r0_ + 16) * dmul) + lane + 64 * j); } }
        auto chunk = [&](const int ch, f32x4 (&vq)[2][4]) __attribute__((always_inline)) {
#pragma unroll
            for (int u2 = 0; u2 < 2; ++u2) { const int rl = 2 * w + u2; const size_t row = (size_t)rb * 256 + ch * 16 + rl;
                f32x4 v[4]; float s = 0.f;
#pragma unroll
                for (int j = 0; j < 4; ++j) { v[j] = vq[u2][j]; s += (v[j].x * v[j].x + v[j].y * v[j].y) + (v[j].z * v[j].z + v[j].w * v[j].w); }
                if (ch < 14) {
#pragma unroll
                    for (int j = 0; j < 4; ++j) vq[u2][j] = NTLD((const GAS f32x4*)(H1 + (row + 32) * dmul) + lane + 64 * j); }
                const float r = 1.0f / sqrtf(wave_sum(s) * (1.0f / D) + 1e-6f);
#pragma unroll
                for (int j = 0; j < 4; ++j) { const int k = 4 * lane + 256 * j;
                    const f32x4 y = v[j] * r * A[j] + Bc[j];
                    *(LAS unsigned*)(wl8 + u2 * 1024 + 4 * lane + 256 * j) = pk4_fp8(y.x, y.y, y.z, y.w);
                    const unsigned h0 = cvt_pk_bf16(y.x, y.y), h1 = cvt_pk_bf16(y.z, y.w);
                    const unsigned l0 = cvt_pk_bf16(y.x - bf_lo(h0), y.y - bf_hi(h0)), l1 = cvt_pk_bf16(y.z - bf_lo(h1), y.w - bf_hi(h1));
                    *(LAS u32x2*)(TH + rl * TS + k) = (u32x2){h0, h1}; *(LAS u32x2*)(TL + rl * TS + k) = (u32x2){l0, l1}; }
            }
            LDS_WAIT();
#pragma unroll
            for (int u2 = 0; u2 < 2; ++u2) ((GAS u32x4*)(XN2 + ((size_t)rb * 256 + ch * 16 + 2 * w + u2) * D))[lane] = *(const LAS u32x4*)(wl8 + u2 * 1024 + 16 * lane);
            __syncthreads();
            f32x4 acc[3];
#pragma unroll
            for (int cb = 0; cb < 3; ++cb) acc[cb] = (f32x4){0.f, 0.f, 0.f, 0.f};
#pragma unroll
            for (int ks = 0; ks < 4; ++ks) { const int ko = l15 * TS + 128 * w + 32 * ks + 8 * lq;
                const bf16x8 ah = *(const LAS bf16x8*)(TH + ko), al = *(const LAS bf16x8*)(TL + ko);
#pragma unroll
                for (int cb = 0; cb < 3; ++cb) { acc[cb] = __builtin_amdgcn_mfma_f32_16x16x32_bf16(ah, bh[ks][cb], acc[cb], 0, 0, 0); acc[cb] = __builtin_amdgcn_mfma_f32_16x16x32_bf16(ah, bl[ks][cb], acc[cb], 0, 0, 0); acc[cb] = __builtin_amdgcn_mfma_f32_16x16x32_bf16(al, bh[ks][cb], acc[cb], 0, 0, 0); } }
#pragma unroll
            for (int cb = 0; cb < 3; ++cb)
#pragma unroll
                for (int q = 0; q < 4; ++q) PART[(w * 16 + lq * 4 + q) * 48 + cb * 16 + l15] = acc[cb][q];
            __syncthreads();
            for (int o = c.tid; o < 768; o += NTHREADS) { const int rr_ = o / 48, cc_ = o - rr_ * 48; float sacc = 0.f;
#pragma unroll
                for (int ww = 0; ww < 8; ++ww) sacc += PART[ww * 768 + o];
                if (cc_ < 36) LGA[(ch * 16 + rr_) * 36 + cc_] = sacc; }
        };
        for (int ch = 0; ch < 16; ch += 2) { chunk(ch, vn); chunk(ch + 1, vm); }
        __syncthreads();
        float rw0 = 0.f, rw1 = 0.f; int re0 = 0, re1 = 0;
        if (c.tid < 256) { const LAS float* lgp = LGA + c.tid * 36; float l4[4];
#pragma unroll
            for (int q = 0; q < 4; ++q) l4[q] = lgp[q] + BIAS[q];
            int grp = 0; float mx = l4[0];
#pragma unroll
            for (int q = 1; q < 4; ++q) if (l4[q] > mx) { mx = l4[q]; grp = q; }
            float se = 0.f;
#pragma unroll
            for (int q = 0; q < 4; ++q) se += __expf(l4[q] - mx);
            const float pg = 1.0f / se;
            float le[8];
#pragma unroll
            for (int q = 0; q < 8; ++q) le[q] = lgp[4 + grp * 8 + q] + BIAS[4 + grp * 8 + q];
            int i0 = 0; float v0 = le[0];
#pragma unroll
            for (int q = 1; q < 8; ++q) if (le[q] > v0) { v0 = le[q]; i0 = q; }
            int i1 = -1; float v1 = -3.0e38f;
#pragma unroll
            for (int q = 0; q < 8; ++q) if (q != i0 && le[q] > v1) { v1 = le[q]; i1 = q; }
            const float ex = __expf(v1 - v0), p0 = 1.0f / (1.0f + ex), p1 = ex / (1.0f + ex);
            re0 = grp * 8 + i0; re1 = grp * 8 + i1; rw0 = pg * p0; rw1 = pg * p1; }
        __syncthreads();
        if (c.tid < 256) { RT[c.tid * 4 + 0] = re0; RT[c.tid * 4 + 1] = re1; RT[c.tid * 4 + 2] = (int)__float_as_uint(rw0); RT[c.tid * 4 + 3] = (int)__float_as_uint(rw1); }
        __syncthreads();
        int e0 = 0, e1 = 0, r0 = 0, r1 = 0;
        if (c.tid < 256) { e0 = RT[c.tid * 4]; e1 = RT[c.tid * 4 + 1]; r0 = __hip_atomic_fetch_add(&hist[e0], 1, __ATOMIC_RELAXED, __HIP_MEMORY_SCOPE_WORKGROUP); r1 = __hip_atomic_fetch_add(&hist[e1], 1, __ATOMIC_RELAXED, __HIP_MEMORY_SCOPE_WORKGROUP); }
        __syncthreads();
        const int seg = rb & 3;
        if (c.tid < 32) hist[32 + c.tid] = seg * (ECAP / 4) + (int)__hip_atomic_fetch_add(cursor + 64 * (c.tid * 4 + seg), (unsigned)hist[c.tid], RLX_AGENT);
        __syncthreads();
        if (c.tid < 256) { const int tok = rb * 256 + c.tid; const int q0 = hist[32 + e0] + r0, q1 = hist[32 + e1] + r1;
            rowtok[(size_t)e0 * ECAP + q0] = tok * 2; roww[(size_t)e0 * ECAP + q0] = __uint_as_float((unsigned)RT[c.tid * 4 + 2]);
            rowtok[(size_t)e1 * ECAP + q1] = tok * 2 + 1; roww[(size_t)e1 * ECAP + q1] = __uint_as_float((unsigned)RT[c.tid * 4 + 3]); }
        __syncthreads();
        if (c.tid < 32) hist[c.tid] = 0;
        __syncthreads();
    }
}

__device__ __forceinline__ void p14_final(const Params& p, const Ctx& c, float* dst = nullptr) {
    const float* mod = (const float*)(p.ws + WS_MOD); const unsigned char* SLOT8 = (const unsigned char*)(p.ws + WS_SLOT); const float* out = p.out; float* wout = dst ? dst : p.out;
    static_assert(FP8_SLOT == 1 && H1_BF16 == 0, "p14_final: fp8 slots, f32 h1");
    LAS unsigned char* wl = c.lds + c.wave * 4096;
    for (int rb = c.vcu; rb < 256; rb += c.G) {
        const int b = rb >> 3;
        f32x4 gt[4], gf[4];
#pragma unroll
        for (int j = 0; j < 4; ++j) { const int k = 4 * c.lane + 256 * j; gt[j] = *(const f32x4*)(mod + b * 6144 + 5120 + k) * (1.0f / 16.0f); gf[j] = *(const f32x4*)(p.in[I_NFG] + k); }
        auto ld = [&](const size_t row, f32x4 (&hv)[2][4], u32x4 (&sl)[2][2]) __attribute__((always_inline)) {
#pragma unroll
            for (int q = 0; q < 2; ++q) { const GAS f32x4* xr = (const GAS f32x4*)(out + (row + q) * D) + c.lane;
#pragma unroll
                for (int j = 0; j < 4; ++j) hv[q][j] = NTLD(xr + 64 * j);
                sl[q][0] = NTLD((const GAS u32x4*)(SLOT8 + ((row + q) * 2) * D) + c.lane); sl[q][1] = NTLD((const GAS u32x4*)(SLOT8 + ((row + q) * 2 + 1) * D) + c.lane); }
        };
        auto proc = [&](const size_t row, f32x4 (&hv)[2][4], u32x4 (&sl)[2][2]) __attribute__((always_inline)) {
#pragma unroll
            for (int q = 0; q < 2; ++q) { *(LAS u32x4*)(wl + (q * 2) * 1024 + 16 * c.lane) = sl[q][0]; *(LAS u32x4*)(wl + (q * 2 + 1) * 1024 + 16 * c.lane) = sl[q][1]; }
            LDS_WAIT();
#pragma unroll
            for (int q = 0; q < 2; ++q) { float s = 0.f; f32x4 v[4];
#pragma unroll
                for (int j = 0; j < 4; ++j) { const int sa = *(const LAS int*)(wl + (q * 2) * 1024 + 4 * c.lane + 256 * j), sb = *(const LAS int*)(wl + (q * 2 + 1) * 1024 + 4 * c.lane + 256 * j);
                    const f32x2 a0 = __builtin_amdgcn_cvt_pk_f32_fp8(sa, false), a1 = __builtin_amdgcn_cvt_pk_f32_fp8(sa, true), b0 = __builtin_amdgcn_cvt_pk_f32_fp8(sb, false), b1 = __builtin_amdgcn_cvt_pk_f32_fp8(sb, true);
                    const f32x4 y = (f32x4){a0.x + b0.x, a0.y + b0.y, a1.x + b1.x, a1.y + b1.y};
                    v[j] = hv[q][j] + gt[j] * y; s += (v[j].x * v[j].x + v[j].y * v[j].y) + (v[j].z * v[j].z + v[j].w * v[j].w); }
                const float r = 1.0f / sqrtf(wave_sum(s) * (1.0f / D) + 1e-6f);
                GAS f32x4* xo = (GAS f32x4*)(wout + (row + q) * D) + c.lane;
#pragma unroll
                for (int j = 0; j < 4; ++j) xo[64 * j] = v[j] * r * gf[j]; }
            LDS_WAIT();
        };
        const size_t row0 = (size_t)rb * 256 + c.wave * 32;
        f32x4 hA[2][4], hB[2][4]; u32x4 sA[2][2], sB[2][2];
        ld(row0, hA, sA);
        for (int i = 0; i < 32; i += 4) {
            ld(row0 + i + 2, hB, sB);
            proc(row0 + i, hA, sA);
            if (i + 4 < 32) ld(row0 + i + 4, hA, sA);
            proc(row0 + i + 2, hB, sB);
        }
    }
}
}
namespace fx {
constexpr int N_PHASES = 15;
struct KArgs { Params p; int region, pad; };
__global__ void __launch_bounds__(NTHREADS, 2) fwd(KArgs ka) {
    extern __shared__ __attribute__((aligned(16))) unsigned char lds_[];
    const Params& p = ka.p;
    Ctx c0; c0.lds = (LAS unsigned char*)lds_; c0.wave = __builtin_amdgcn_readfirstlane((int)threadIdx.x >> 6); c0.lane = 0; c0.tid = 0;
    c0.G = gridDim.x; { const int bx = blockIdx.x; c0.vcu = (c0.G % 8 == 0) ? (bx % 8) * (c0.G / 8) + bx / 8 : bx; }
#define CTX Ctx c = c0; c.lane = mg::lane_id(); c.tid = c.wave * 64 + c.lane;
    CTX
    volatile LAS unsigned* MISC = (volatile LAS unsigned*)(c.lds + MISC_OFF);
    if (c.tid < 64) MISC[c.tid] = 0u;
    __syncthreads();
    unsigned* ctl = (unsigned*)(p.ws + WS_CTL);
    const int lo = p.ph_lo, hi = p.ph_hi;
    XcdBarrier bar; bar.bar = ctl + CW_BAR + ka.region * XCD_BAR_WORDS; bar.x = 0; bar.st = nullptr; bar.wave = c0.wave;
    if (hi - lo > 1) bar = xcd_barrier_post(ctl + CW_BAR + ka.region * XCD_BAR_WORDS, MISC + 8, c0.wave);
#ifndef PHASE_MASK
#define PHASE_MASK 0x7fff
#endif
#define IN(k) ((((PHASE_MASK) >> (k)) & 1) && lo <= (k) && (k) < hi)
#ifndef REPEAT_MASK
#define REPEAT_MASK 0
#endif
#ifndef REPEAT_N
#define REPEAT_N 1
#endif

#ifdef TSTAMP
#define STAMP(k) do { if (blockIdx.x == 0 && c.tid == 0) ((unsigned long long*)(p.ws + (size_t)972 * MiB))[(k)] = __builtin_amdgcn_s_memrealtime(); } while (0)
#else
#define STAMP(k) do { } while (0)
#endif
#define SEAM(k) do { if (IN(k) && IN((k) + 1)) xcd_barrier(bar); STAMP((k) + 1); } while (0)
    LAS unsigned char* ring = c0.lds;
    const int G = c0.G, bx = (int)blockIdx.x;
    const char* ws = (const char*)p.ws;
#ifndef SPLIT_P0
#define SPLIT_P0 0
#endif
#if SPLIT_P0
#define PH0 { CTX p0_prologue<1>(p, c); }
#else
#define PH0 { CTX p0_prologue<3>(p, c); }
#endif
#define PH0B { CTX p0_prologue<P0_PARTS>(p, c); }
#if SPLIT_P0
#define PH1 { CTX p1_xn<4>(p, c); p0_prologue<2>(p, c); }
#else
#define PH1 { CTX p1_xn<8>(p, c); }
#endif
#if MERGE_ONE
#define E1G_EXTRA , (bf16_t*)(p.ws + WS_GATES) + TILED2_HALF
#else
#define E1G_EXTRA
#endif
#ifndef LATE_GATES
#define LATE_GATES 0
#endif
#if FP8_GATES
#define PH2A { CTX LAS float* bgl = (LAS float*)(c.lds + XT_OFF); (void)bgl; \
        { SchedStd<true> S{ws + WS_XN, ws + WS_W1T, 1024, 1024, 256, 6, 16, G, bx}; \
          Epi1 E{(bf16_t*)(p.ws + WS_ZA), (bf16_t*)(p.ws + WS_U), (bf16_t*)(p.ws + WS_GV), (bf16_t*)(p.ws + WS_GATES), bgl}; \
          mg::gemm_phase<Epi1, SchedStd<true>, false, true>(c.wave, ring, S, E, 128, 128); } }
#define PH2B { CTX LAS float* bgl = (LAS float*)(c.lds + XT_OFF); for (int q_ = c.tid; q_ < 2048; q_ += NTHREADS) bgl[q_] = p.in[I_BGATE][q_]; __syncthreads(); \
        { SchedStd8<true> S{(const char*)p.out, ws + WS_WG8, 1024, 1024, 256, 8, 8, G, bx}; Epi1g E{(bf16_t*)(p.ws + WS_GATES), bgl E1G_EXTRA}; \
          mg::gemm_phase<Epi1g, SchedStd8<true>, false, true, true>(c.wave, ring, S, E, 128, 128, 127, 122); } }
#if LATE_GATES
#define PH2 PH2A
#define PH6X PH2B
#else
#define PH2 { PH2A PH2B }
#define PH6X { }
#endif
#else
#define PH2 { CTX LAS float* bgl = (LAS float*)(c.lds + XT_OFF); for (int q_ = c.tid; q_ < 2048; q_ += NTHREADS) bgl[q_] = p.in[I_BGATE][q_]; __syncthreads(); \
        SchedStd<true> S{ws + WS_XN, ws + WS_W1T, 1024, 1024, 256, 14, 16, G, bx}; \
        Epi1 E{(bf16_t*)(p.ws + WS_ZA), (bf16_t*)(p.ws + WS_U), (bf16_t*)(p.ws + WS_GV), (bf16_t*)(p.ws + WS_GATES), bgl}; \
        mg::gemm_phase<Epi1, SchedStd<true>, false, true>(c.wave, ring, S, E, 128, 128); }
#endif
#define PH2N { CTX { SchedStd<true> S{ws + WS_XN, ws + WS_W1T, 1024, 1024, 256, 6, 16, G, bx}; EpiNull E{}; mg::gemm_phase<EpiNull, SchedStd<true>, false, true>(c.wave, ring, S, E, 128, 128); } \
        { SchedStd8<true> S{(const char*)p.out, ws + WS_WG8, 1024, 1024, 256, 8, 8, G, bx}; EpiNull E{}; mg::gemm_phase<EpiNull, SchedStd8<true>, false, true, true>(c.wave, ring, S, E, 128, 128, 127, 122); } }
#define PH8N { CTX SchedStd<true> S{ws + WS_YA, ws + WS_WBAT, 512, 512, 256, 4, 8, G, bx}; EpiNull E{}; mg::gemm_phase<EpiNull, SchedStd<true>, false, true>(c.wave, ring, S, E, 128, 128); }
#define PH10N { CTX SchedStd8<true> S{ws + WS_MERGED, ws + WS_WOUTT, 1024, 1024, 256, 4, 8, G, bx}; EpiNull E{}; mg::gemm_phase<EpiNull, SchedStd8<true>, false, true, true>(c.wave, ring, S, E, 128, 128, 125, 122); }
#define PH12N { CTX const MoeTab mt = moe_table(p, c); SchedUp S{ws + WS_XN, ws + WS_WUPT, (const int*)(p.ws + WS_ROWTOK), mt, G, bx, (const float*)(p.ws + WS_ROWW)}; EpiNull E{}; mg::gemm_phase<EpiNull, SchedUp, true, true, FP8_MOE>(c.wave, ring, S, E, 128, 128, 127, 122); }
#define PH12M { CTX const MoeTab mt = moe_table(p, c); SchedUp S{ws + WS_XN, ws + WS_WUPT, (const int*)(p.ws + WS_ROWTOK), mt, G, bx, (const float*)(p.ws + WS_ROWW)}; EpiUpMath E{(const float*)(p.ws + WS_ROWW), mt}; mg::gemm_phase<EpiUpMath, SchedUp, true, true, FP8_MOE>(c.wave, ring, S, E, 128, 128, 127, 122); }
#ifndef NOEPI_MASK
#define NOEPI_MASK 0
#endif
#ifndef STAG10
#define STAG10 0
#endif
#ifndef STAG8
#define STAG8 0
#endif
#ifndef STAG2
#define STAG2 0
#endif
#define STAGGER(us) do { if ((us) > 0 && (c0.vcu & 1)) { const unsigned long long t0_ = __builtin_amdgcn_s_memrealtime(); while (__builtin_amdgcn_s_memrealtime() - t0_ < (unsigned long long)(us) * 100ull) __builtin_amdgcn_s_sleep(8); } } while (0)
#define PH3 { CTX SchedS5a S{ws + WS_ZA, ws + WS_TZ, ws + WS_WS, G, c.vcu}; EpiS5a E{(bf16_t*)(p.ws + WS_YI), (float*)(p.ws + WS_SST)}; \
        mg::gemm_phase<EpiS5a, SchedS5a, false, true>(c.wave, ring, S, E, 128, 128); }
#define PH4 { CTX p4_scan(p, c); }
#define PH5 { CTX SchedS5b S{ws + WS_HP, ws + WS_WO, G, bx}; EpiS5b E{(const bf16_t*)(p.ws + WS_YI), (bf16_t*)(p.ws + WS_YG)}; \
        mg::gemm_phase<EpiS5b, SchedS5b, false, true>(c.wave, ring, S, E, 128, 128); }
#define PH6 { CTX SchedGlu S{ws + WS_YG, ws + WS_WGLUT, G, bx}; EpiGlu E{(const bf16_t*)(p.ws + WS_YG), (bf16_t*)(p.ws + WS_YA), p.in[I_BGLU]}; \
        mg::gemm_phase<EpiGlu, SchedGlu, false, true, false, false>(c.wave, ring, S, E, (size_t)8388608, 128); }
#define PH7 { CTX p7_sgu(p, c); }
#define PH8 { CTX SchedStd<true> S{ws + WS_YA, ws + WS_WBAT, 512, 512, 256, 4, 8, G, bx}; EpiMerge<0> E{(const bf16_t*)(p.ws + WS_GATES), (bf16_t*)(p.ws + WS_P1), (bf16_t*)(p.ws + WS_MERGED)}; \
        mg::gemm_phase<EpiMerge<0>, SchedStd<true>, false, true>(c.wave, ring, S, E, 128, 128); }
#define PH9 { CTX SchedStd<true> S{ws + WS_YB, ws + WS_WBBT, 512, 512, 256, 4, 8, G, bx}; EpiMerge<1> E{(const bf16_t*)(p.ws + WS_GATES), (bf16_t*)(p.ws + WS_P1), (bf16_t*)(p.ws + WS_MERGED)}; \
        mg::gemm_phase<EpiMerge<1>, SchedStd<true>, false, true>(c.wave, ring, S, E, 128, 128); }
#if FP8_OUT
#define PH89 { CTX SchedMerge S{ws + WS_YA, ws + WS_YB, ws + WS_WBAT, ws + WS_WBBT, G, bx}; EpiMergeOne E{(const bf16_t*)(p.ws + WS_GATES), (bf16_t*)(p.ws + WS_MERGED)}; \
        mg::gemm_phase<EpiMergeOne, SchedMerge, false, true, (FP8_MERGE != 0)>(c.wave, ring, S, E, 128, 128, FP8_MERGE ? 124 : 127, FP8_MERGE ? 123 : 127); }
#if H1_BF16
#define PH10 { CTX SchedStd8<true> S{ws + WS_MERGED, ws + WS_WOUTT, 1024, 1024, 256, 4, 8, G, bx}; EpiOutB E{p.in[I_X], (const float*)(p.ws + WS_MOD), (bf16_t*)(p.ws + WS_H1B)}; \
        mg::gemm_phase<EpiOutB, SchedStd8<true>, false, true, true>(c.wave, ring, S, E, 128, 128, 125, 122); }
#else
#define PH10 { CTX SchedStd8<false> S{ws + WS_MERGED, ws + WS_WOUTT, 1024, 1024, 256, 4, 8, G, bx}; EpiOut E{p.in[I_X], (const float*)(p.ws + WS_MOD), p.out}; \
        mg::gemm_phase<EpiOut, SchedStd8<false>, false, true, true>(c.wave, ring, S, E, 128, 128, 125, 122); }
#endif
#else
#define PH10 { CTX SchedStd<false> S{ws + WS_MERGED, ws + WS_WOUTT, 1024, 1024, 256, 4, 16, G, bx}; EpiOut E{p.in[I_X], (const float*)(p.ws + WS_MOD), p.out}; \
        mg::gemm_phase<EpiOut, SchedStd<false>, false, true>(c.wave, ring, S, E, 128, 128); }
#endif
#ifndef ROUTER_MFMA
#define ROUTER_MFMA 1
#endif
#if ROUTER_MFMA
#define PH11 { CTX p11_router_mfma(p, c); }
#else
#define PH11 { CTX p10_norm_router(p, c); }
#endif
#define PH12 { CTX const MoeTab mt = moe_table(p, c); SchedUp S{ws + WS_XN, ws + WS_WUPT, (const int*)(p.ws + WS_ROWTOK), mt, G, bx, (const float*)(p.ws + WS_ROWW)}; EpiUp E{(bf16_t*)(p.ws + WS_HID), (const float*)(p.ws + WS_ROWW), mt}; \
        mg::gemm_phase<EpiUp, SchedUp, true, true, FP8_MOE>(c.wave, ring, S, E, 128, 128, 127, 122); }
#define PH13 { CTX const MoeTab mt = moe_table(p, c); SchedDn S{ws + WS_HID, ws + WS_WDNT, mt, G, bx, (const int*)(p.ws + WS_ROWTOK)}; EpiDn E{(bf16_t*)(p.ws + WS_SLOT), (const int*)(p.ws + WS_ROWTOK), mt}; \
        mg::gemm_phase<EpiDn, SchedDn, false, true, FP8_MOE>(c.wave, ring, S, E, 128, 128, 124, 123); }
#define PH14 { CTX p14_final(p, c); }
#define RUN(k, BODY) do { if (IN((k) & 15)) { BODY if constexpr (((REPEAT_MASK) >> (k)) & 1) { xcd_barrier(bar); BODY } } } while (0)
    const bool one = (hi - lo > 1);
#define GBAR do { if (one) xcd_barrier(bar); } while (0)
    do { if (IN(0)) { PH0 if constexpr ((REPEAT_MASK) & 1) { xcd_barrier(bar); PH0B } } } while (0); GBAR;
    RUN(1, PH1); GBAR;
    if constexpr ((NOEPI_MASK >> 2) & 1) { PH2N xcd_barrier(bar); }
    STAGGER(STAG2); RUN(2, PH2); GBAR;
    RUN(3, PH3); GBAR;
    RUN(4, PH4); if (one) { RUN(7, PH7); } GBAR;
    RUN(5, PH5); GBAR;
    RUN(6, PH6); if (IN(6)) { PH6X } GBAR;
    if (!one) { RUN(7, PH7); }
#if MERGE_ONE
    RUN(8, PH89); GBAR;
#else
    if constexpr ((NOEPI_MASK >> 8) & 1) { PH8N xcd_barrier(bar); }
    STAGGER(STAG8); RUN(8, PH8);
    if (one) { asm volatile("s_waitcnt vmcnt(0)" ::: "memory"); __syncthreads();
        if (c0.wave == 0 && mg::lane_id() == 0) { __builtin_amdgcn_fence(__ATOMIC_ACQUIRE, "agent"); asm volatile("s_waitcnt vmcnt(0)" ::: "memory"); }
        __syncthreads(); }
    RUN(9, PH9); GBAR;
#endif
    if constexpr ((NOEPI_MASK >> 10) & 1) { PH10N xcd_barrier(bar); }
    STAGGER(STAG10); RUN(10, PH10); GBAR;
    if constexpr (((REPEAT_MASK) >> 11) & 1) { if (IN(11)) { { CTX if (ROUTER_MFMA) p11_router_mfma(p, c, true); else p10_norm_router(p, c, true); } xcd_barrier(bar); } }
    RUN(11 + 16, PH11); GBAR;
    if constexpr ((NOEPI_MASK >> 12) & 1) { PH12N xcd_barrier(bar); }
    if constexpr ((NOEPI_MASK >> 20) & 1) { PH12M xcd_barrier(bar); }
    RUN(12, PH12); GBAR;
    RUN(13, PH13); GBAR;
    if constexpr (((REPEAT_MASK) >> 14) & 1) { if (IN(14)) { { CTX p14_final(p, c, (float*)(p.ws + WS_GATES)); } xcd_barrier(bar); } }
    RUN(14 + 16, PH14);
#undef IN
#undef SEAM
}
static int g_grid = 0;
static bool fast_setup() {
    if (g_grid != 0) return g_grid > 0;
    int dev = 0, cus = 0, per_cu = 0;
    if (hipGetDevice(&dev) != hipSuccess || hipDeviceGetAttribute(&cus, hipDeviceAttributeMultiprocessorCount, dev) != hipSuccess) { g_grid = -1; return false; }
    if (hipFuncSetAttribute((const void*)fwd, hipFuncAttributeMaxDynamicSharedMemorySize, LDS_BYTES) != hipSuccess) { fprintf(stderr, "hipFuncSetAttribute failed\n"); g_grid = -1; return false; }
    if (hipOccupancyMaxActiveBlocksPerMultiprocessor(&per_cu, (const void*)fwd, NTHREADS, LDS_BYTES) != hipSuccess || per_cu < 1) fprintf(stderr, "occupancy query: %d\n", per_cu);
    (void)hipGetLastError();
    g_grid = cus;
    return true;
}
static void fast_forward(void* const* d_in, float* out, unsigned char* ws, hipStream_t st, int lo, int hi, bool split, int region) {
    if (!fast_setup()) return;
    KArgs a{};
    for (int i = 0; i < 34; ++i) a.p.in[i] = (const float*)d_in[i];
    a.p.out = out; a.p.ws = ws; a.region = region; a.pad = 0;
    if (split) { for (int k = lo; k < hi; ++k) { a.p.ph_lo = k; a.p.ph_hi = k + 1; hipLaunchKernelGGL(fwd, dim3(g_grid), dim3(NTHREADS), LDS_BYTES, st, a); } }
    else { a.p.ph_lo = lo; a.p.ph_hi = hi; hipLaunchKernelGGL(fwd, dim3(g_grid), dim3(NTHREADS), LDS_BYTES, st, a); }
}
}
extern "C" void kernel_launch(void* const* d_in, const int* in_sizes, int n_in, void* d_out, int out_size, void* d_ws, size_t ws_size, hipStream_t stream) {
    (void)in_sizes; (void)n_in; (void)out_size; (void)ws_size;
    (void)hipMemsetAsync((char*)d_ws + fx::WS_CTL, 0, fx::CTL_ZERO_BYTES, stream);
    fx::fast_forward(d_in, (float*)d_out, (unsigned char*)d_ws, stream, 0, fx::N_PHASES, FAST_SPLIT, 0);
}
```

```cpp
#include <hip/hip_runtime.h>
#include <cstdint>
#include <cstdio>
#define FAST_SPLIT false
namespace mg {
#define MG_LAS __attribute__((address_space(3)))
typedef unsigned short bf16_t;
typedef short bf16x8 __attribute__((ext_vector_type(8)));
typedef float f32x4 __attribute__((ext_vector_type(4)));
typedef float f32x2 __attribute__((ext_vector_type(2)));
typedef unsigned u32x4 __attribute__((ext_vector_type(4)));
typedef unsigned u32x2 __attribute__((ext_vector_type(2)));
typedef int i32x8 __attribute__((ext_vector_type(8)));
typedef int i32x4 __attribute__((ext_vector_type(4)));
template <bool C, class A, class B> struct cond_t { typedef A type; };
template <class A, class B> struct cond_t<false, A, B> { typedef B type; };
constexpr int BM = 256, BK = 64, HALF = 128, HTB = HALF * BK * 2, STAGE_BYTES = 8 * HTB;

template <int SW = 5> __host__ __device__ __forceinline__ int lds_byte(int r, int c) { const int st = (r >> 4) * 2 + (c >> 5), rr = r & 15, cc = c & 31, ob = rr * 64 + cc * 2; return st * 1024 + (ob ^ (((ob >> 9) & 1) << SW)); }
template <int SW = 5> __host__ __device__ __forceinline__ void stage_rc(int b, int& R, int& C) { const int st = b / 1024, sb = b % 1024, swz = sb ^ (((sb >> 9) & 1) << SW); R = (st >> 1) * 16 + swz / 64; C = (st & 1) * 32 + (swz % 64) / 2; }
template <class S_, class = void> struct vconst_t { static constexpr bool v = false; };
template <class S_> struct vconst_t<S_, decltype((void)S_::VOFF_CONST)> { static constexpr bool v = S_::VOFF_CONST; };
template <class S_, class = void> struct lists_t { static constexpr bool v = false; };
template <class S_> struct lists_t<S_, decltype((void)S_::LISTS)> { static constexpr bool v = S_::LISTS; };
template <class S_, class = void> struct swz8_t { static constexpr int v = 5; };
template <class S_> struct swz8_t<S_, decltype((void)S_::SWZ8)> { static constexpr int v = S_::SWZ8; };
__host__ __device__ __forceinline__ int perm32(int rho) { const int n = rho >> 4, i = rho & 15; return 8 * (i >> 2) + 4 * n + (i & 3); }

constexpr int KEEP_ACC = 1 << 30;
struct Unit { const char* A0; const char* A1; const char* B0; const char* B1; int nt, pm, pn, aux; };

__device__ __forceinline__ unsigned cvt_pk_bf16(float lo, float hi) { unsigned r; asm volatile("v_cvt_pk_bf16_f32 %0, %1, %2" : "=v"(r) : "v"(lo), "v"(hi)); return r; }
__device__ __forceinline__ float bf_lo(unsigned w) { return __uint_as_float(w << 16); }
__device__ __forceinline__ float bf_hi(unsigned w) { return __uint_as_float(w & 0xffff0000u); }
__device__ __forceinline__ float fsigmoid(float x) { return __builtin_amdgcn_rcpf(1.0f + __builtin_amdgcn_exp2f(-1.4426950408889634f * x)); }
__device__ __forceinline__ float q8(float x, float s, float is) { const int v = __builtin_amdgcn_cvt_pk_fp8_f32(x * s, 0.f, 0, false); return __builtin_amdgcn_cvt_f32_fp8(v, 0) * is; }
__device__ __forceinline__ float fsilu(float x) { return x * fsigmoid(x); }
__device__ __forceinline__ float fgelu(float x) { const float u = x * (1.5957691216057308f + 0.07135481627260025f * x * x); return x * fsigmoid(u); }

__device__ __forceinline__ f32x4 mfma_bf16(const bf16x8& a, const bf16x8& b, const f32x4& c) { return __builtin_amdgcn_mfma_f32_16x16x32_bf16(a, b, c, 0, 0, 0); }
__device__ __forceinline__ f32x4 mfma_bf16(const i32x8&, const i32x8&, const f32x4& c) { return c; }
#define st16(p, ...) (*(u32x4*)(p) = (__VA_ARGS__))
#define st16f(p, ...) (*(f32x4*)(p) = (__VA_ARGS__))
#define st8(p, ...) (*(u32x2*)(p) = (__VA_ARGS__))
__device__ __forceinline__ int lane_id() { int l; asm volatile("v_mbcnt_lo_u32_b32 %0, -1, 0\n\tv_mbcnt_hi_u32_b32 %0, -1, %0" : "=v"(l)); return l; }
template <class Epi, class Sched, bool GATHER, bool ALIGN_EPI, bool FP8 = false, bool KA128 = true>
__device__ __forceinline__ void gemm_phase(const int wid, MG_LAS unsigned char* lds, const Sched& S, const Epi& E, const size_t kstepA, const size_t kstepB, const int sclA = 127, const int sclB = 127) {
    const int lane = lane_id(), tid = wid * 64 + lane, wr = wid >> 2, wc = wid & 3, fr = lane & 15, fq = lane >> 4;
    constexpr int NH = GATHER ? 2 : 1, H1 = GATHER ? 1 : 0;
    unsigned vA[NH][2], vB[2];
    const unsigned ldsw = (unsigned)wid * 1024u;
#define MG_SA(b, h) (((b) * 2 + (h)) * HTB)
#define MG_SB(b, h) ((4 + (b) * 2 + (h)) * HTB)
#define MG_STAGE(bufoff, gbase, voff, IMM) do { _Pragma("unroll") for (int _i = 0; _i < 2; ++_i) { unsigned vo_ = (voff)[_i]; asm volatile("" : "+v"(vo_));     \
        __builtin_amdgcn_global_load_lds((const unsigned*)((const char*)(gbase) + vo_), (MG_LAS unsigned*)(lds + (bufoff) + ldsw + _i * 8192 - (IMM)), 16, IMM, 0); } } while (0)
#define MG_STAGE_AK(bufoff, gbase, voff) do { if constexpr (KA128) MG_STAGE(bufoff, gbase, voff, 128); else MG_STAGE(bufoff, (gbase) + kstepA, voff, 0); } while (0)
#define MG_STAGE_BK(bufoff, gbase, voff) MG_STAGE(bufoff, gbase, voff, 128)
#define MG_LDA(dst, b, h) do { if constexpr (FP8) { _Pragma("unroll") for (int m = 0; m < 4; ++m) { const i32x4 lo_ = *(const MG_LAS i32x4*)(pA + MG_SA(b, h) + m * 2048), hi_ = *(const MG_LAS i32x4*)(((SW == 4) ? pAx : pA + 16) + MG_SA(b, h) + m * 2048); dst[m][0] = __builtin_shufflevector(lo_, hi_, 0, 1, 2, 3, 4, 5, 6, 7); } } \
        else { _Pragma("unroll") for (int m = 0; m < 4; ++m) _Pragma("unroll") for (int k = 0; k < 2; ++k) dst[m][k] = *(const MG_LAS FragT*)(pA + MG_SA(b, h) + m * 2048 + k * 1024); } } while (0)
#define MG_LDB(dst, b, h) do { if constexpr (FP8) { _Pragma("unroll") for (int n = 0; n < 2; ++n) { const i32x4 lo_ = *(const MG_LAS i32x4*)(pB + (MG_SB(b, h) - 4 * HTB) + n * 2048), hi_ = *(const MG_LAS i32x4*)(((SW == 4) ? pBx : pB + 16) + (MG_SB(b, h) - 4 * HTB) + n * 2048); dst[n][0] = __builtin_shufflevector(lo_, hi_, 0, 1, 2, 3, 4, 5, 6, 7); } } \
        else { _Pragma("unroll") for (int n = 0; n < 2; ++n) _Pragma("unroll") for (int k = 0; k < 2; ++k) dst[n][k] = *(const MG_LAS FragT*)(pB + (MG_SB(b, h) - 4 * HTB) + n * 2048 + k * 1024); } } while (0)
#define MG_MMA(ai, bj, At, Bt) do { __builtin_amdgcn_s_setprio(1); _Pragma("unroll") for (int m = 0; m < 4; ++m) _Pragma("unroll") for (int n = 0; n < 2; ++n) { \
        if constexpr (FP8) acc[ai][bj][m][n] = __builtin_amdgcn_mfma_scale_f32_16x16x128_f8f6f4(Bt[n][0], At[m][0], acc[ai][bj][m][n], 0, 0, 0, sclB, 0, sclA); \
        else { _Pragma("unroll") for (int k = 0; k < 2; ++k) acc[ai][bj][m][n] = mfma_bf16(Bt[n][k], At[m][k], acc[ai][bj][m][n]); } } __builtin_amdgcn_s_setprio(0); } while (0)
#define MG_WAIT_V(n) asm volatile("s_waitcnt vmcnt(" #n ")" ::: "memory")
#define MG_WAIT_L(n) asm volatile("s_waitcnt lgkmcnt(" #n ")" ::: "memory")
#define MG_BAR __builtin_amdgcn_s_barrier()
#define MG_SCHED __builtin_amdgcn_sched_barrier(0)
    Unit cur, nxt; int ui = 0;
    if (!S.next(0, cur)) return;
    if constexpr (lists_t<Sched>::v) { S.list_dma(cur, wid, lane_id()); asm volatile("s_waitcnt vmcnt(0)" ::: "memory"); __builtin_amdgcn_s_barrier(); asm volatile("" ::: "memory"); }
    typename Epi::Pre pre;
    f32x4 acc[2][2][4][2];
#pragma unroll
    for (int a = 0; a < 2; ++a)
#pragma unroll
        for (int b = 0; b < 2; ++b)
#pragma unroll
            for (int m = 0; m < 4; ++m)
#pragma unroll
                for (int n = 0; n < 2; ++n) acc[a][b][m][n] = (f32x4){0.f, 0.f, 0.f, 0.f};
    typedef typename cond_t<FP8, i32x8, bf16x8>::type FragT; constexpr int NK = FP8 ? 1 : 2;
    FragT At[4][NK], B0[2][NK], B1[2][NK];
    S.voff(cur, tid, vA, vB);
    MG_STAGE(MG_SB(0, 0), cur.B0, vB, 0); MG_STAGE(MG_SB(0, 1), cur.B1, vB, 0); MG_STAGE(MG_SA(0, 0), cur.A0, vA[0], 0); MG_STAGE(MG_SA(0, 1), cur.A1, vA[H1], 0);
    if (wr == 1) MG_BAR;
    MG_WAIT_V(2); MG_BAR;
    MG_STAGE_BK(MG_SB(1, 0), cur.B0, vB); MG_STAGE_AK(MG_SA(1, 0), cur.A0, vA[0]); MG_STAGE_BK(MG_SB(1, 1), cur.B1, vB);
    MG_WAIT_V(6); MG_BAR;
    constexpr int SW = FP8 ? swz8_t<Sched>::v : 5;
    const int l2_ = lane_id(), fr2_ = l2_ & 15, fq2_ = l2_ >> 4;
    const int aoff = lds_byte<SW>(wr * 64 + fr2_, FP8 ? fq2_ * 16 : fq2_ * 8), boff = lds_byte<SW>(wc * 32 + fr2_, FP8 ? fq2_ * 16 : fq2_ * 8);
    const MG_LAS unsigned char* pA = lds + aoff; const MG_LAS unsigned char* pB = lds + 4 * HTB + boff;
    const MG_LAS unsigned char* pAx = lds + ((SW == 4) ? (aoff ^ 16) : aoff + 16); const MG_LAS unsigned char* pBx = lds + 4 * HTB + ((SW == 4) ? (boff ^ 16) : boff + 16);
    asm volatile("" : "+v"(pA), "+v"(pB)); if constexpr (FP8 && SW == 4) asm volatile("" : "+v"(pAx), "+v"(pBx)); (void)pAx; (void)pBx;
    for (;;) {
        const bool has_next = S.next(ui + 1, nxt);
        if constexpr (lists_t<Sched>::v) { if (has_next) S.list_dma(nxt, wid, lane_id()); }
        if (!has_next) nxt = cur;
        const int nt = cur.nt;
        for (int t = 0; t < nt; t += 2) {
            const bool last = (t == nt - 2);
            const char* a1h = cur.A1 + (size_t)t * kstepA;
            const char* a20 = last ? nxt.A0 : cur.A0 + (size_t)(t + 2) * kstepA; const char* a21 = last ? nxt.A1 : cur.A1 + (size_t)(t + 2) * kstepA;
            const char* b20 = last ? nxt.B0 : cur.B0 + (size_t)(t + 2) * kstepB; const char* b21 = last ? nxt.B1 : cur.B1 + (size_t)(t + 2) * kstepB;
            MG_LDB(B0, 0, 0); MG_LDB(B1, 0, 1); MG_SCHED; MG_LDA(At, 0, 0); MG_STAGE_AK(MG_SA(1, 1), a1h, vA[H1]);
            if constexpr (!vconst_t<Sched>::v) { if (last && has_next) S.voff(nxt, tid, vA, vB); }
            MG_WAIT_V(8); MG_WAIT_L(0); MG_BAR; MG_MMA(0, 0, At, B0); MG_MMA(0, 1, At, B1); MG_BAR; MG_SCHED;
            MG_LDA(At, 0, 1); MG_STAGE(MG_SB(0, 0), b20, vB, 0); MG_STAGE(MG_SB(0, 1), b21, vB, 0); MG_STAGE(MG_SA(0, 0), a20, vA[0], 0);
            MG_WAIT_V(8); MG_WAIT_L(0); MG_BAR; MG_MMA(1, 0, At, B0); MG_MMA(1, 1, At, B1); MG_BAR; MG_SCHED;
            MG_LDB(B0, 1, 0); MG_LDB(B1, 1, 1); MG_SCHED; MG_LDA(At, 1, 0); MG_STAGE(MG_SA(0, 1), a21, vA[H1], 0);
            MG_WAIT_V(8); MG_WAIT_L(0); MG_BAR; MG_MMA(0, 0, At, B0); MG_MMA(0, 1, At, B1); MG_BAR; MG_SCHED;
            MG_LDA(At, 1, 1); MG_STAGE_BK(MG_SB(1, 0), b20, vB); MG_STAGE_BK(MG_SB(1, 1), b21, vB); MG_STAGE_AK(MG_SA(1, 0), a20, vA[0]);
            MG_WAIT_V(8); MG_WAIT_L(0); MG_BAR; MG_MMA(1, 0, At, B0); MG_MMA(1, 1, At, B1); MG_BAR; MG_SCHED;
        }
        if constexpr (ALIGN_EPI) { if (wr == 0) MG_BAR; }
        { const int l_ = lane_id(); int fr_ = l_ & 15, fq_ = l_ >> 4; asm volatile("" : "+v"(fr_), "+v"(fq_));
          E.prefetch(pre, cur, wr, wc, fr_, fq_);
          E(acc, cur, wr, wc, fr_, fq_, pre); }
        if (!has_next) break;
        if (!(cur.aux & KEEP_ACC)) {
#pragma unroll
        for (int a = 0; a < 2; ++a)
#pragma unroll
            for (int b = 0; b < 2; ++b)
#pragma unroll
                for (int m = 0; m < 4; ++m)
#pragma unroll
                    for (int n = 0; n < 2; ++n) acc[a][b][m][n] = (f32x4){0.f, 0.f, 0.f, 0.f};
        }
        cur = nxt; ++ui;
        if constexpr (ALIGN_EPI) { if (wr == 1) MG_BAR; }
    }
    MG_WAIT_V(0);
    if constexpr (!ALIGN_EPI) { if (wr == 0) MG_BAR; }
    MG_BAR;
#undef MG_SA
#undef MG_SB
#undef MG_STAGE
#undef MG_STAGE_AK
#undef MG_STAGE_BK
#undef MG_LDA
#undef MG_LDB
#undef MG_MMA
#undef MG_WAIT_V
#undef MG_WAIT_L
#undef MG_BAR
#undef MG_SCHED
}
template <bool PERM>
__device__ __forceinline__ void std_voff(int tid, int lda, int ldb, unsigned (&va)[1][2], unsigned (&vb)[2]) {
#pragma unroll
    for (int i = 0; i < 2; ++i) { int R, C; stage_rc(tid * 16 + i * 8192, R, C); const int Rb = PERM ? ((R & ~31) + perm32(R & 31)) : R;
        va[0][i] = (unsigned)(R * lda + C) * 2u; vb[i] = (unsigned)(Rb * ldb + C) * 2u; }
}
template <bool PERM, int SW = 5>
__device__ __forceinline__ void std_voff8(int tid, int ldaB, int ldbB, unsigned (&va)[1][2], unsigned (&vb)[2]) {
#pragma unroll
    for (int i = 0; i < 2; ++i) { int R, C; stage_rc<SW>(tid * 16 + i * 8192, R, C); const int Rb = PERM ? ((R & ~31) + perm32(R & 31)) : R;
        va[0][i] = (unsigned)(R * ldaB + C * 2); vb[i] = (unsigned)(Rb * ldbB + C * 2); }
}
__device__ __forceinline__ unsigned pk4_fp8(float a, float b, float c, float d) { int w = __builtin_amdgcn_cvt_pk_fp8_f32(a, b, 0, false); w = __builtin_amdgcn_cvt_pk_fp8_f32(c, d, w, true); return (unsigned)w; }
__device__ __forceinline__ bool static_tile(int i, int G, int c, int nM, int nN, int& pm, int& pn) {
    const int nwg = nM * nN; const long L = (long)i * G + c; if (L >= nwg) return false;
    int wgid = (int)L; { const int q = nwg / 8, r = nwg % 8, xcd = wgid % 8, off = wgid / 8; wgid = (xcd < r ? xcd * (q + 1) : r * (q + 1) + (xcd - r) * q) + off; }
    const int nig = 8 * nN, gid = wgid / nig, fm = gid * 8, gsz = (nM - fm) < 8 ? (nM - fm) : 8;
    pm = fm + ((wgid % nig) % gsz); pn = (wgid % nig) / gsz; return true;
}
}
namespace fx {
using mg::bf16_t; using mg::bf16x8; using mg::f32x4; using mg::f32x2; using mg::u32x4; using mg::u32x2; using mg::Unit;
#define GAS __attribute__((address_space(1)))
#define LAS __attribute__((address_space(3)))
typedef GAS unsigned gu32;
#define RLX_AGENT __ATOMIC_RELAXED, __HIP_MEMORY_SCOPE_AGENT
#define LDS_WAIT() asm volatile("s_waitcnt lgkmcnt(0)" ::: "memory")
#define VM_WAIT() asm volatile("s_waitcnt vmcnt(0)" ::: "memory")
constexpr int NWAVES = 8, NTHREADS = 512;
constexpr int T = 65536, D = 1024, SEQ = 2048, NB = 32;
constexpr int ECAP = 131072;
constexpr size_t MiB = 1u << 20;
constexpr size_t WS_CTL = 0, CTL_ZERO_BYTES = 1 * MiB;
constexpr size_t WS_MOD = 1 * MiB;
constexpr size_t WS_SGUW = 2 * MiB;
constexpr size_t WS_AL = 2 * MiB + 512 * 1024;
constexpr size_t WS_WRH = 3 * MiB, WS_WRL = 3 * MiB + 128 * 1024;
constexpr size_t WS_TZ = 4 * MiB;
constexpr size_t WS_WS = 6 * MiB;
constexpr size_t WS_WO = 14 * MiB;
constexpr size_t WS_W1T = 30 * MiB;
constexpr size_t WS_WGLUT = 37 * MiB;
constexpr size_t WS_WBAT = 38 * MiB, WS_WBBT = 39 * MiB;
constexpr size_t WS_WOUTT = 40 * MiB;
constexpr size_t WS_WUPT = 42 * MiB;
constexpr size_t WS_WDNT = 106 * MiB;
constexpr size_t WS_ROWTOK = 139 * MiB;
constexpr size_t WS_ROWW = 155 * MiB;
constexpr size_t WS_XN = 172 * MiB;
constexpr size_t WS_GATES = 300 * MiB;
constexpr size_t WS_ZA = 556 * MiB;
constexpr size_t WS_YG = WS_ZA;
constexpr size_t WS_U = 620 * MiB, WS_GV = 684 * MiB;
constexpr size_t WS_YI = 748 * MiB;
constexpr size_t WS_SST = 812 * MiB;
constexpr size_t WS_HP = 828 * MiB;
constexpr size_t WS_YA = 844 * MiB, WS_YB = 908 * MiB;
constexpr size_t WS_P1 = 620 * MiB;
constexpr size_t WS_MERGED = 748 * MiB;
constexpr size_t WS_HID = 300 * MiB;
constexpr size_t WS_SLOT = 556 * MiB;
constexpr size_t WS_H1B = 844 * MiB;
constexpr size_t WS_END = 972 * MiB;
constexpr size_t WS_WG8 = 972 * MiB;
constexpr int CW_TMO = 0, CW_P0CTR = 1024, CW_BAR = 4096, CW_CURSOR = 65536;
constexpr int RING_BYTES = 131072;
constexpr int LDS_BYTES = 163840;
constexpr int MISC_OFF = LDS_BYTES - 256;
constexpr int XT_OFF = RING_BYTES;

__device__ __forceinline__ unsigned f2bf(float f) { unsigned u = __builtin_bit_cast(unsigned, f); return (u + 0x7fffu + ((u >> 16) & 1u)) >> 16; }
__device__ __forceinline__ unsigned pk2(float lo, float hi) { return f2bf(lo) | (f2bf(hi) << 16); }
__device__ __forceinline__ float wave_sum(float v) {
    v += __builtin_bit_cast(float, __builtin_amdgcn_update_dpp(0, __builtin_bit_cast(int, v), 0xB1, 0xf, 0xf, false));
    v += __builtin_bit_cast(float, __builtin_amdgcn_update_dpp(0, __builtin_bit_cast(int, v), 0x4E, 0xf, 0xf, false));
    v += __builtin_bit_cast(float, __builtin_amdgcn_update_dpp(0, __builtin_bit_cast(int, v), 0x141, 0xf, 0xf, false));
    v += __builtin_bit_cast(float, __builtin_amdgcn_update_dpp(0, __builtin_bit_cast(int, v), 0x140, 0xf, 0xf, false));
    const int iv = __builtin_bit_cast(int, v);
    const float r0 = __builtin_bit_cast(float, __builtin_amdgcn_readlane(iv, 0)), r1 = __builtin_bit_cast(float, __builtin_amdgcn_readlane(iv, 16)),
                r2 = __builtin_bit_cast(float, __builtin_amdgcn_readlane(iv, 32)), r3 = __builtin_bit_cast(float, __builtin_amdgcn_readlane(iv, 48));
    return (r0 + r1) + (r2 + r3);
}
#define XB_TMO      128
#define XB_XCNT(j)  (256  + 64 * (j))
#define XB_XSUB(j)  (1280 + 64 * (j))
#define XB_XGEN(j)  (2304 + 64 * (j))
#define XB_TOP      3328
#define XB_TOPGEN   3392
#define XCD_BAR_WORDS 3456
#define XB_SPIN_CAP (1u << 18)
__device__ __forceinline__ unsigned xb_ld(unsigned* p)              { return __hip_atomic_load(p, __ATOMIC_RELAXED, __HIP_MEMORY_SCOPE_AGENT); }
__device__ __forceinline__ unsigned xb_add(unsigned* p, unsigned v) { return __hip_atomic_fetch_add(p, v, __ATOMIC_RELAXED, __HIP_MEMORY_SCOPE_AGENT); }
__device__ __forceinline__ unsigned xb_xcc_id() { return (unsigned)__builtin_amdgcn_s_getreg((3 << 11) | 20) & 0xFu; }
#define XB_SPIN(cond, bar) do { unsigned _sp = 0; while (cond) { __builtin_amdgcn_s_sleep(1); \
    if ((++_sp & 255u) == 0u) { if (xb_ld(&(bar)[XB_TMO])) break; if (_sp > XB_SPIN_CAP) { atomicAdd(&(bar)[XB_TMO], 1u); break; } } } } while (0)
struct XcdBarrier { unsigned* bar; unsigned x; volatile LAS unsigned* st; int wave; };
__device__ __forceinline__ XcdBarrier xcd_barrier_post(unsigned* bar, volatile LAS unsigned* st, int wave) {
    XcdBarrier b; b.bar = bar; b.x = xb_xcc_id(); b.st = st; b.wave = wave;
    if (wave == 0 && mg::lane_id() == 0) (void)xb_add(&bar[XB_XCNT(b.x)], 1u);
    return b;
}
__device__ __forceinline__ void xcd_barrier_complete(unsigned* bar, unsigned x, unsigned& nloc, unsigned& nx) {
    const unsigned G = gridDim.x * gridDim.y * gridDim.z;
    unsigned sum, cnt, mine, sp = 0u;
    for (;;) {
        sum = 0u; cnt = 0u; mine = 0u;
#pragma unroll
        for (unsigned j = 0; j < 16; ++j) { const unsigned c = xb_ld(&bar[XB_XCNT(j)]); sum += c; cnt += (c > 0u) ? 1u : 0u; mine = (j == x) ? c : mine; }
        if (sum == G) break;
        __builtin_amdgcn_s_sleep(1);
        if ((++sp & 255u) == 0u) { if (xb_ld(&bar[XB_TMO])) break; if (sp > XB_SPIN_CAP) { atomicAdd(&bar[XB_TMO], 1u); break; } }
    }
    nloc = mine > 0u ? mine : 1u; nx = cnt > 0u ? cnt : 1u;
}
__device__ __forceinline__ void xcd_barrier(const XcdBarrier& b) {
    asm volatile("s_waitcnt vmcnt(0)" ::: "memory");
    __syncthreads();
    if (b.wave == 0 && mg::lane_id() == 0) {
        unsigned* bar = b.bar;
        __builtin_amdgcn_s_waitcnt(0);
        unsigned nloc = b.st[0], nx = b.st[1];
        if (nloc == 0u) { xcd_barrier_complete(bar, b.x, nloc, nx); b.st[0] = nloc; b.st[1] = nx; }
        const unsigned old = xb_add(&bar[XB_XSUB(b.x)], 1u);
        const unsigned gen = old / nloc;
        if (old + 1u == (gen + 1u) * nloc) {
            __builtin_amdgcn_fence(__ATOMIC_RELEASE, "agent");
            asm volatile("s_waitcnt vmcnt(0)" ::: "memory");
            const unsigned og = xb_add(&bar[XB_TOP], 1u);
            const unsigned tg = og / nx;
            if (og + 1u == (tg + 1u) * nx) xb_add(&bar[XB_TOPGEN], 1u);
            else XB_SPIN(xb_ld(&bar[XB_TOPGEN]) == tg, bar);
            __builtin_amdgcn_fence(__ATOMIC_ACQUIRE, "agent");
            xb_add(&bar[XB_XGEN(b.x)], 1u);
            asm volatile("s_waitcnt vmcnt(0)" ::: "memory");
        } else {
            XB_SPIN(xb_ld(&bar[XB_XGEN(b.x)]) == gen, bar);
            __builtin_amdgcn_fence(__ATOMIC_ACQUIRE, "agent");
            asm volatile("s_waitcnt vmcnt(0)" ::: "memory");
        }
    }
    __syncthreads();
}

struct Params { const float* in[34]; float* out; unsigned char* ws; int ph_lo, ph_hi; };
enum { I_X = 0, I_C, I_WADA, I_BADA, I_N1G, I_WIN, I_WGATE, I_BGATE, I_ARE, I_AIM, I_BRE, I_BIM, I_CRE, I_CIM, I_DSK, I_LSTEP, I_WGLU, I_BGLU, I_LNG, I_LNB,
       I_SGUW, I_SGUB, I_WBA, I_WBB, I_WOUT, I_N2G, I_WRG, I_BRG, I_WRE, I_BRE2, I_W1, I_W3, I_W2, I_NFG };
}
namespace fx {
#ifndef Q8_P2
#define Q8_P2 0
#endif
#ifndef Q8_P10
#define Q8_P10 0
#endif
#ifndef Q8_MOE
#define Q8_MOE 0
#endif
#ifndef Q8_P8
#define Q8_P8 0
#endif
#ifndef HOT11
#define HOT11 0
#endif
#ifndef SWZ_GATE
#define SWZ_GATE 4
#endif
#ifndef SWZ_OUT
#define SWZ_OUT 4
#endif
#ifndef SWZ_UP
#define SWZ_UP 4
#endif
#ifndef SWZ_DN
#define SWZ_DN 4
#endif
#ifndef GATE8
#define GATE8 1
#endif
#ifndef NT_LD
#define NT_LD 1
#endif
#define NTLD(p_) (NT_LD ? __builtin_nontemporal_load(p_) : *(p_))
#ifndef FP8_MERGE
#define FP8_MERGE 1
#endif
#ifndef FP8_MOE
#define FP8_MOE 1
#endif
#ifndef FP8_OUT
#define FP8_OUT 1
#endif
#ifndef MERGE_ONE
#define MERGE_ONE 1
#endif
#ifndef H1_BF16
#define H1_BF16 0
#endif
#ifndef TILED_GATES
#define TILED_GATES 1
#endif
#ifndef FP8_SLOT
#define FP8_SLOT 1
#endif
#ifndef FP8_GATES
#define FP8_GATES 1
#endif
using mg::q8; using mg::pk4_fp8; using mg::cvt_pk_bf16; using mg::fsigmoid; using mg::fsilu; using mg::fgelu; using mg::bf_lo; using mg::bf_hi;
struct Ctx { LAS unsigned char* lds; int tid, lane, wave, vcu, G; };

__device__ __forceinline__ u32x4 pack8(const f32x4& a, const f32x4& b) { u32x4 w; w.x = cvt_pk_bf16(a[0], a[1]); w.y = cvt_pk_bf16(a[2], a[3]); w.z = cvt_pk_bf16(b[0], b[1]); w.w = cvt_pk_bf16(b[2], b[3]); return w; }
#ifndef WIDE8
#define WIDE8 1
#endif
__device__ __forceinline__ u32x4 widen8(const u32x2 a, const u32x2 b) {
    const auto r0 = __builtin_amdgcn_permlane16_swap(a.x, b.x, false, false); const auto r1 = __builtin_amdgcn_permlane16_swap(a.y, b.y, false, false);
    return (u32x4){r0[0], r1[0], r0[1], r1[1]}; }
__device__ __forceinline__ void unpack8(const u32x4& w, f32x4& a, f32x4& b) { a = (f32x4){bf_lo(w.x), bf_hi(w.x), bf_lo(w.y), bf_hi(w.y)}; b = (f32x4){bf_lo(w.z), bf_hi(w.z), bf_lo(w.w), bf_hi(w.w)}; }

struct TItem { const float* W; bf16_t* WT; int K, N, dest_row0, k0, n0; float qs; int fp8; };
__device__ __forceinline__ void titem_load(const TItem& t, int lane, float (&tv)[32]) {
#pragma unroll
    for (int i = 0; i < 8; ++i) { const f32x4 v = NTLD((const f32x4*)(t.W + (size_t)(t.k0 + 8 * i + (lane >> 3)) * t.N + t.n0 + 4 * (lane & 7))); tv[4 * i] = v[0]; tv[4 * i + 1] = v[1]; tv[4 * i + 2] = v[2]; tv[4 * i + 3] = v[3]; }
}
__device__ __forceinline__ void titem_finish(const TItem& t, int lane, const float (&tv)[32], LAS float* scr) {
#pragma unroll
    for (int i = 0; i < 8; ++i)
#pragma unroll
        for (int e = 0; e < 4; ++e) scr[(8 * i + (lane >> 3)) * 33 + 4 * (lane & 7) + e] = (t.qs > 0.f && !t.fp8) ? q8(tv[4 * i + e], t.qs, 1.0f / t.qs) : tv[4 * i + e];
    LDS_WAIT(); asm volatile("" ::: "memory");
    if (t.fp8) {
        const int c4 = lane & 3; const float q = t.qs;
#pragma unroll
        for (int j = 0; j < 2; ++j) { const int n = (lane >> 2) + 16 * j; const LAS float* sp = scr + (16 * c4) * 33 + n;
            u32x4 o; o.x = pk4_fp8(sp[0 * 33] * q, sp[1 * 33] * q, sp[2 * 33] * q, sp[3 * 33] * q); o.y = pk4_fp8(sp[4 * 33] * q, sp[5 * 33] * q, sp[6 * 33] * q, sp[7 * 33] * q);
            o.z = pk4_fp8(sp[8 * 33] * q, sp[9 * 33] * q, sp[10 * 33] * q, sp[11 * 33] * q); o.w = pk4_fp8(sp[12 * 33] * q, sp[13 * 33] * q, sp[14 * 33] * q, sp[15 * 33] * q);
            *(GAS u32x4*)((unsigned char*)t.WT + (size_t)(t.dest_row0 + n) * t.K + t.k0 + 16 * c4) = o; }
    } else {
        const int c = lane & 7;
#pragma unroll
    for (int j = 0; j < 4; ++j) { const int n = (lane >> 3) + 8 * j; const LAS float* sp = scr + (8 * c) * 33 + n;
        u32x4 o; o.x = cvt_pk_bf16(sp[0 * 33], sp[1 * 33]); o.y = cvt_pk_bf16(sp[2 * 33], sp[3 * 33]); o.z = cvt_pk_bf16(sp[4 * 33], sp[5 * 33]); o.w = cvt_pk_bf16(sp[6 * 33], sp[7 * 33]);
        *(GAS u32x4*)(t.WT + (size_t)(t.dest_row0 + n) * t.K + t.k0 + 8 * c) = o; }
    }
    LDS_WAIT(); asm volatile("" ::: "memory");
}
__device__ __forceinline__ void p0_s5_tables(const Params& p, const Ctx& c, int g, int part) {
    typedef float f2 __attribute__((ext_vector_type(2)));
    LAS f2* P = (LAS f2*)c.lds;
    LAS f2* BT = P + 64 * 66;
    LAS f2* CC = BT + 1024;
    LAS f2* FF = CC + 1024;
    const int tid = c.tid;
    if (tid < 64) { const int n = tid;
        const double lr = fmin((double)p.in[I_ARE][g * 64 + n], -1e-4), li = (double)p.in[I_AIM][g * 64 + n], dt = exp((double)p.in[I_LSTEP][g]);
        const double mag = exp(lr * dt), abr = mag * cos(li * dt), abi = mag * sin(li * dt), den = lr * lr + li * li, nr = abr - 1.0;
        FF[n] = (f2){(float)((nr * lr + abi * li) / den), (float)((abi * lr - nr * li) / den)};
        double pr = 1.0, pi = 0.0;
        for (int tau = 0; tau <= 64; ++tau) { P[n * 66 + tau] = (f2){(float)pr, (float)pi}; const double qr = pr * abr - pi * abi, qi = pr * abi + pi * abr; pr = qr; pi = qi; } }
    __syncthreads();
    for (int idx = tid; idx < 1024; idx += 512) {
        { const int n = idx >> 4, h = idx & 15; const f2 f = FF[n]; const float br = p.in[I_BRE][(g * 64 + n) * 16 + h], bi = p.in[I_BIM][(g * 64 + n) * 16 + h];
          BT[n * 16 + h] = (f2){f.x * br - f.y * bi, f.x * bi + f.y * br}; }
        { const int h = idx >> 6, n = idx & 63; CC[h * 64 + n] = (f2){p.in[I_CRE][(g * 16 + h) * 64 + n], p.in[I_CIM][(g * 16 + h) * 64 + n]}; }
    }
    __syncthreads();
    if (part == 0 && tid < 64) ((f2*)(p.ws + WS_AL))[g * 64 + tid] = P[tid * 66 + 64];
    bf16_t* TZ = (bf16_t*)(p.ws + WS_TZ); bf16_t* WSg = (bf16_t*)(p.ws + WS_WS); bf16_t* WOg = (bf16_t*)(p.ws + WS_WO);
    { const int pr = tid & 63, h = 4 * part + (pr >> 4), hp = pr & 15, to = tid >> 6;
      float acc[8];
#pragma unroll
      for (int i = 0; i < 8; ++i) acc[i] = 0.f;
      for (int n = 0; n < 64; ++n) {
          const f2 cc = CC[h * 64 + n], bb = BT[n * 16 + hp]; const float cbr = cc.x * bb.x - cc.y * bb.y, cbi = cc.x * bb.y + cc.y * bb.x;
#pragma unroll
          for (int i = 0; i < 8; ++i) { const f2 pw = P[n * 66 + 8 * to + i]; acc[i] += cbr * pw.x - cbi * pw.y; }
      }
      bf16_t* tz = TZ + ((size_t)(g * 16 + h) * 128) * 16 + hp;
      const float dk = p.in[I_DSK][g * 16 + h];
#pragma unroll
      for (int i = 0; i < 8; ++i) { const int tau = 8 * to + i; float v = acc[i]; if (tau == 0 && h == hp) v += dk; tz[(63 + tau) * 16] = (bf16_t)f2bf(v);
          if (tau < 63) tz[tau * 16] = 0; }
      if (to == 7) tz[127 * 16] = 0;
    }
    for (int r = 0; r < 8; ++r) { const int gi = tid + 512 * r, row = 32 * part + (gi >> 7), k8 = (gi & 127) * 8, n = row & 63, im = row >> 6, sp = k8 >> 4, hp0 = k8 & 15;
        const f2 pw = P[n * 66 + sp]; float v[8];
#pragma unroll
        for (int e = 0; e < 8; ++e) { const f2 bb = BT[n * 16 + hp0 + e]; v[e] = im ? (pw.x * bb.y + pw.y * bb.x) : (pw.x * bb.x - pw.y * bb.y); }
        *(u32x4*)(WSg + ((size_t)g * 128 + row) * 1024 + k8) = (u32x4){cvt_pk_bf16(v[0], v[1]), cvt_pk_bf16(v[2], v[3]), cvt_pk_bf16(v[4], v[5]), cvt_pk_bf16(v[6], v[7])}; }
    for (int r = 0; r < 16; ++r) { const int gi = tid + 512 * r, row = 256 * part + (gi >> 5), k8 = (gi & 31) * 8, t = row >> 4, h = row & 15; float v[8];
#pragma unroll
        for (int e = 0; e < 8; ++e) { v[e] = 0.f; if (k8 < 128) { const int n = (k8 & 63) + e; const f2 cc = CC[h * 64 + n], pw = P[n * 66 + t + 1]; v[e] = (k8 < 64) ? (cc.x * pw.x - cc.y * pw.y) : -(cc.x * pw.y + cc.y * pw.x); } }
        *(u32x4*)(WOg + ((size_t)g * 1024 + row) * 256 + k8) = (u32x4){cvt_pk_bf16(v[0], v[1]), cvt_pk_bf16(v[2], v[3]), cvt_pk_bf16(v[4], v[5]), cvt_pk_bf16(v[6], v[7])}; }
    __syncthreads();
}
__device__ __forceinline__ void p0_mod(const Params& p, const Ctx& c) {
    if (c.vcu >= 96) return;
    LAS float* cs = (LAS float*)c.lds;
    for (int idx = c.tid; idx < 32768; idx += 512) { const int k = idx >> 5, b = idx & 31; cs[idx] = fsilu(p.in[I_C][b * 1024 + k]); }
    __syncthreads();
    const float* w_ada = p.in[I_WADA];
    for (int cb = c.vcu; cb < 96; cb += c.G) {
        const int j = cb * 64 + c.lane;
        float acc[32];
#pragma unroll
        for (int b = 0; b < 32; ++b) acc[b] = 0.f;
        const float* wp = w_ada + (size_t)(128 * c.wave) * 6144 + j;
#pragma unroll 16
        for (int k = 0; k < 128; ++k) { const float w = wp[(size_t)k * 6144]; const LAS f32x4* cr = (const LAS f32x4*)(cs + (128 * c.wave + k) * 32);
#pragma unroll
            for (int q = 0; q < 8; ++q) { const f32x4 cv = cr[q]; acc[4 * q] += w * cv[0]; acc[4 * q + 1] += w * cv[1]; acc[4 * q + 2] += w * cv[2]; acc[4 * q + 3] += w * cv[3]; } }
        __syncthreads();
        LAS float* red = (LAS float*)c.lds;
#pragma unroll
        for (int b = 0; b < 32; ++b) red[(c.wave * 32 + b) * 64 + c.lane] = acc[b];
        __syncthreads();
        for (int o = c.tid; o < 2048; o += 512) { const int b = o >> 6, l = o & 63; float sacc = p.in[I_BADA][cb * 64 + l];
#pragma unroll
            for (int w = 0; w < 8; ++w) sacc += red[(w * 32 + b) * 64 + l];
            ((float*)(p.ws + WS_MOD))[b * 6144 + cb * 64 + l] = sacc; }
        __syncthreads();
        if (cb + c.G < 96) { for (int idx = c.tid; idx < 32768; idx += 512) { const int k = idx >> 5, b = idx & 31; cs[idx] = fsilu(p.in[I_C][b * 1024 + k]); } __syncthreads(); }
    }
}
#ifndef P0_PARTS
#define P0_PARTS 3
#endif
template <int PARTS>
__device__ __forceinline__ void p0_prologue(const Params& p, const Ctx& c) {
    if (PARTS & 1) {
    p0_mod(p, c);
    if (c.vcu >= c.G - 128) { const int q_ = c.G - 1 - c.vcu; p0_s5_tables(p, c, q_ >> 2, q_ & 3); }
    }
    if (PARTS & 1) {
      bf16_t* wh = (bf16_t*)(p.ws + WS_WRH); bf16_t* wl = (bf16_t*)(p.ws + WS_WRL);
      for (int idx = c.vcu * NTHREADS + c.tid; idx < 48 * 1024; idx += c.G * NTHREADS) { const int o = idx >> 10, k = idx & 1023;
          const float w = (o < 4) ? p.in[I_WRG][k * 4 + o] : (o < 36 ? p.in[I_WRE][((size_t)((o - 4) >> 3) * 1024 + k) * 8 + ((o - 4) & 7)] : 0.f);
          const unsigned hb = f2bf(w); const float hf = __uint_as_float(hb << 16); wh[idx] = (bf16_t)hb; wl[idx] = (bf16_t)f2bf(w - hf); } }
    if (PARTS & 1) {
      bf16_t* sw = (bf16_t*)(p.ws + WS_SGUW);
      for (int idx = c.vcu * NTHREADS + c.tid; idx < 8 * 128 * 128; idx += c.G * NTHREADS) { const int tt = (idx >> 7) & 127, ss = idx & 127; sw[idx] = (ss <= tt) ? (bf16_t)f2bf(p.in[I_SGUW][idx]) : (bf16_t)0; } }
    if (!(PARTS & 2)) return;
    constexpr int TW0 = (PARTS == 2) ? 4 : 0, TNW = NWAVES - TW0;
    if (c.wave < TW0) return;
    const int tw = c.wave - TW0;
    LAS float* scr = (LAS float*)(c.lds + c.wave * 16384);
    constexpr int I0 = 768, I1 = I0 + 1024, I2 = I1 + 128, I3 = I2 + 256, I4 = I3 + 256, I5 = I4 + 512, I6 = I5 + 8192, I7 = I6 + 8192, I8 = I7 + 8192;
    int it_lo = 0, it_hi = 0;
    auto decode = [&](int it) -> TItem { TItem t;
        if (it < I0) { const int nb = 1536 / 32, r = it; t = TItem{p.in[I_WIN], (bf16_t*)(p.ws + WS_W1T), 1024, 1536, 32 * (r % nb), 64 * (r / nb), 32 * (r % nb), Q8_P2 ? 32.f : 0.f, 0}; }
        else if (it < I1) { const int nb = 2048 / 32, r = it - I0; t = FP8_GATES ? TItem{p.in[I_WGATE], (bf16_t*)(p.ws + WS_WG8), 1024, 2048, MERGE_ONE ? ((((32 * (r % nb)) & 1023) >> 7) * 256 + ((32 * (r % nb)) >> 10) * 128 + ((32 * (r % nb)) & 127)) : 32 * (r % nb), 64 * (r / nb), 32 * (r % nb), 32.f, 1}
                           : TItem{p.in[I_WGATE], (bf16_t*)(p.ws + WS_W1T), 1024, 2048, 1536 + 32 * (r % nb), 64 * (r / nb), 32 * (r % nb), Q8_P2 ? 32.f : 0.f, 0}; }
        else if (it < I2) { const int nb = 512 / 32, r = it - I1; t = TItem{p.in[I_WGLU], (bf16_t*)(p.ws + WS_WGLUT), 512, 512, 32 * (r % nb), 64 * (r / nb), 32 * (r % nb), 0.f, 0}; }
        else if (it < I3) { const int nb = 1024 / 32, r = it - I2; t = TItem{p.in[I_WBA], (bf16_t*)(p.ws + WS_WBAT), 512, 1024, 32 * (r % nb), 64 * (r / nb), 32 * (r % nb), (FP8_MERGE || Q8_P8) ? 16.f : 0.f, FP8_MERGE}; }
        else if (it < I4) { const int nb = 1024 / 32, r = it - I3; t = TItem{p.in[I_WBB], (bf16_t*)(p.ws + WS_WBBT), 512, 1024, 32 * (r % nb), 64 * (r / nb), 32 * (r % nb), (FP8_MERGE || Q8_P8) ? 16.f : 0.f, FP8_MERGE}; }
        else if (it < I5) { const int nb = 1024 / 32, r = it - I4; t = TItem{p.in[I_WOUT], (bf16_t*)(p.ws + WS_WOUTT), 1024, 1024, 32 * (r % nb), 64 * (r / nb), 32 * (r % nb), (FP8_OUT || Q8_P10) ? 32.f : 0.f, FP8_OUT}; }
        else if (it < I7) { const bool is3 = it >= I6; const int r0 = it - (is3 ? I6 : I5), e = r0 >> 8, r = r0 & 255, nb = 512 / 32, n0 = 32 * (r % nb);
            t = TItem{p.in[is3 ? I_W3 : I_W1] + (size_t)e * 1024 * 512, FP8_MOE ? (bf16_t*)(p.ws + WS_WUPT + (size_t)e * 1024 * 1024) : (bf16_t*)(p.ws + WS_WUPT) + (size_t)e * 1024 * 1024, 1024, 512, (n0 >> 7) * 256 + (is3 ? 128 : 0) + (n0 & 127), 64 * (r / nb), n0, (FP8_MOE || Q8_MOE) ? 32.f : 0.f, FP8_MOE}; }
        else { const int r0 = it - I7, e = r0 >> 8, r = r0 & 255, nb = 1024 / 32;
            t = TItem{p.in[I_W2] + (size_t)e * 512 * 1024, FP8_MOE ? (bf16_t*)(p.ws + WS_WDNT + (size_t)e * 1024 * 512) : (bf16_t*)(p.ws + WS_WDNT) + (size_t)e * 1024 * 512, 512, 1024, 32 * (r % nb), 64 * (r / nb), 32 * (r % nb), (FP8_MOE || Q8_MOE) ? 16.f : 0.f, FP8_MOE}; }
        return t; };
    (void)it_lo; (void)it_hi;
    if (PARTS == 3) {
        unsigned* ctr = (unsigned*)(p.ws + WS_CTL) + CW_P0CTR; LAS unsigned* slot = (LAS unsigned*)(c.lds + XT_OFF + 8192);
        constexpr int NCH = (I8 + NWAVES - 1) / NWAVES;
#define P0_BAR() do { LDS_WAIT(); __builtin_amdgcn_s_barrier(); asm volatile("" ::: "memory"); } while (0)
        unsigned my_next = 0;
        if (c.tid == 0) { slot[0] = __hip_atomic_fetch_add(ctr, 1u, RLX_AGENT); my_next = __hip_atomic_fetch_add(ctr, 1u, RLX_AGENT); }
        P0_BAR();
        unsigned ch = slot[0];
        P0_BAR();
        float tv[32], tn[32]; TItem cur{}; bool have = false;
        if (ch < (unsigned)NCH) { const int it = (int)ch * NWAVES + c.wave; if (it < I8) { cur = decode(it); titem_load(cur, c.lane, tn); have = true; } }
        while (ch < (unsigned)NCH) {
            if (c.tid == 0) { slot[0] = my_next; my_next = __hip_atomic_fetch_add(ctr, 1u, RLX_AGENT); }
            P0_BAR();
            const unsigned nch = slot[0];
            P0_BAR();
#pragma unroll
            for (int i = 0; i < 32; ++i) tv[i] = tn[i];
            const bool had = have; const TItem fin = cur; have = false;
            if (nch < (unsigned)NCH) { const int it = (int)nch * NWAVES + c.wave; if (it < I8) { cur = decode(it); titem_load(cur, c.lane, tn); have = true; } }
            if (had) titem_finish(fin, c.lane, tv, scr);
            ch = nch;
        }
#undef P0_BAR
    } else if (it_lo < it_hi) {
        float tv[32], tn[32];
        TItem cur = decode(it_lo); titem_load(cur, c.lane, tn);
        for (int it = it_lo; it < it_hi; it += TNW) {
#pragma unroll
            for (int i = 0; i < 32; ++i) tv[i] = tn[i];
            TItem nx = cur; if (it + TNW < it_hi) { nx = decode(it + TNW); titem_load(nx, c.lane, tn); }
            titem_finish(cur, c.lane, tv, scr);
            cur = nx;
        }
    }
}

template <int NW>
__device__ __forceinline__ void p1_xn(const Params& p, const Ctx& c) {
    if (c.wave >= NW) return;
    const float* mod = (const float*)(p.ws + WS_MOD); bf16_t* XN = (bf16_t*)(p.ws + WS_XN);
    LAS unsigned char* wl = c.lds + c.wave * 12288;
    for (int rb = c.vcu; rb < 256; rb += c.G) {
        const int b = rb >> 3;
        f32x4 A[4], Bc[4];
#pragma unroll
        for (int j = 0; j < 4; ++j) { const int k = 4 * c.lane + 256 * j; const f32x4 g = *(const f32x4*)(p.in[I_N1G] + k), sc = *(const f32x4*)(mod + b * 6144 + 1024 + k); A[j] = g * (sc + 1.0f); Bc[j] = *(const f32x4*)(mod + b * 6144 + k); }
        for (int i = 0; i < 256 / NW; i += 4) {
            const size_t row = (size_t)rb * 256 + c.wave * (256 / NW) + i;
            f32x4 v[4][4];
#pragma unroll
            for (int q = 0; q < 4; ++q) { const GAS f32x4* xr = (const GAS f32x4*)(p.in[I_X] + (row + q) * D) + c.lane;
#pragma unroll
                for (int j = 0; j < 4; ++j) v[q][j] = NTLD(xr + 64 * j); }
#pragma unroll
            for (int q = 0; q < 4; ++q) { float s = 0.f;
#pragma unroll
                for (int j = 0; j < 4; ++j) s += (v[q][j].x * v[q][j].x + v[q][j].y * v[q][j].y) + (v[q][j].z * v[q][j].z + v[q][j].w * v[q][j].w);
                const float r = 1.0f / sqrtf(wave_sum(s) * (1.0f / D) + 1e-6f);
#pragma unroll
                for (int j = 0; j < 4; ++j) { f32x4 y = v[q][j] * r * A[j] + Bc[j]; if (Q8_P2) { y.x = q8(y.x, 1.f, 1.f); y.y = q8(y.y, 1.f, 1.f); y.z = q8(y.z, 1.f, 1.f); y.w = q8(y.w, 1.f, 1.f); }
                    *(LAS u32x2*)(wl + q * 3072 + 8 * c.lane + 512 * j) = (u32x2){cvt_pk_bf16(y.x, y.y), cvt_pk_bf16(y.z, y.w)};
                    if (FP8_GATES) *(LAS unsigned*)(wl + q * 3072 + 2048 + 4 * c.lane + 256 * j) = pk4_fp8(y.x, y.y, y.z, y.w); } }
            LDS_WAIT();
#pragma unroll
            for (int q = 0; q < 4; ++q) {
                const u32x4 b0 = *(const LAS u32x4*)(wl + q * 3072 + 16 * c.lane), b1 = *(const LAS u32x4*)(wl + q * 3072 + 1024 + 16 * c.lane);
                GAS u32x4* o16 = (GAS u32x4*)(XN + (row + q) * D) + c.lane; o16[0] = b0; o16[64] = b1;
                if (FP8_GATES) { const u32x4 f0 = *(const LAS u32x4*)(wl + q * 3072 + 2048 + 16 * c.lane); ((GAS u32x4*)((unsigned char*)p.out + (row + q) * D))[c.lane] = f0; } }
            LDS_WAIT();
        }
    }
}

template <bool PERM_> struct SchedStd { static constexpr bool VOFF_CONST = true;
    const char* A; const char* B; int lda, ldb, nM, nN, nt, G, c;
    __device__ __forceinline__ bool next(int i, Unit& u) const { int pm, pn; if (!mg::static_tile(i, G, c, nM, nN, pm, pn)) return false; u.pm = pm; u.pn = pn; u.nt = nt; u.aux = 0;
        u.A0 = A + (size_t)pm * 512 * lda; u.A1 = u.A0 + (size_t)256 * lda; u.B0 = B + (size_t)pn * 512 * ldb; u.B1 = u.B0 + (size_t)256 * ldb; return true; }
    __device__ __forceinline__ void voff(const Unit&, int tid, unsigned (&va)[1][2], unsigned (&vb)[2]) const { mg::std_voff<PERM_>(tid, lda, ldb, va, vb); }
};
template <bool PERM_> struct SchedStd8 { static constexpr bool VOFF_CONST = true; static constexpr int SWZ8 = PERM_ ? SWZ_GATE : SWZ_OUT;
    const char* A; const char* B; int ldaB, ldbB, nM, nN, nt, G, c;
    __device__ __forceinline__ bool next(int i, Unit& u) const { int pm, pn; if (!mg::static_tile(i, G, c, nM, nN, pm, pn)) return false; u.pm = pm; u.pn = pn; u.nt = nt; u.aux = 0;
        u.A0 = A + (size_t)pm * 256 * ldaB; u.A1 = u.A0 + (size_t)128 * ldaB; u.B0 = B + (size_t)pn * 256 * ldbB; u.B1 = u.B0 + (size_t)128 * ldbB; return true; }
    __device__ __forceinline__ void voff(const Unit&, int tid, unsigned (&va)[1][2], unsigned (&vb)[2]) const { mg::std_voff8<PERM_, SWZ8>(tid, ldaB, ldbB, va, vb); }
};
struct NoPre {};
#define NO_PREFETCH typedef NoPre Pre; __device__ __forceinline__ void prefetch(Pre&, const Unit&, int, int, int, int) const {}
#define EPI_ARGS const f32x4 (&acc)[2][2][4][2], const Unit& u, int wr, int wc, int fr, int fq, const Pre& pre
struct EpiNull { static constexpr bool PERM = true; NO_PREFETCH
    __device__ __forceinline__ void operator()(EPI_ARGS) const {
#pragma unroll
        for (int ai = 0; ai < 2; ++ai)
#pragma unroll
            for (int bj = 0; bj < 2; ++bj)
#pragma unroll
                for (int m = 0; m < 4; ++m) { asm volatile("" :: "v"(acc[ai][bj][m][0]), "v"(acc[ai][bj][m][1])); }
    }
};
struct Epi1 { static constexpr bool PERM = true; NO_PREFETCH bf16_t* ZA; bf16_t* U; bf16_t* GV; bf16_t* GATES; const LAS float* b_gate;
    __device__ __forceinline__ void operator()(EPI_ARGS) const {
        const int pn = u.pn;
#pragma unroll
        for (int bj = 0; bj < 2; ++bj) {
            const int col0 = pn * 256 + bj * 128 + wc * 32 + 8 * fq;
            f32x4 b0 = (f32x4){0.f, 0.f, 0.f, 0.f}, b1 = b0;
            if (pn >= 6) { b0 = *(const LAS f32x4*)(b_gate + col0 - 1536); b1 = *(const LAS f32x4*)(b_gate + col0 - 1536 + 4); }
#pragma unroll
            for (int ai = 0; ai < 2; ++ai)
#pragma unroll
                for (int m = 0; m < 4; ++m) {
                    const int t = u.pm * 256 + ai * 128 + wr * 64 + m * 16 + fr;
                    f32x4 v0 = acc[ai][bj][m][0], v1 = acc[ai][bj][m][1];
                    if (pn < 2) { const int g = col0 >> 4, half = (col0 >> 3) & 1, bb = t >> 11, pp = t & 2047, cc = pp >> 6, sp = 63 - (pp & 63);
                        st16((void*)(ZA + ((size_t)(g * 1024 + bb * 32 + cc) * 1024 + sp * 16 + half * 8)), pack8(v0, v1)); }
                    else if (pn < 6) {
#pragma unroll
                        for (int j = 0; j < 4; ++j) { v0[j] = fgelu(v0[j]); v1[j] = fgelu(v1[j]); }
                        bf16_t* dst = (pn < 4) ? (U + (size_t)t * 512 + (col0 - 512)) : (GV + (size_t)t * 512 + (col0 - 1024));
                        *(u32x4*)dst = pack8(v0, v1); }
                    else {
#pragma unroll
                        for (int j = 0; j < 4; ++j) { v0[j] = fsigmoid(v0[j] + b0[j]); v1[j] = fsigmoid(v1[j] + b1[j]); }
                        st16((void*)(GATES + (size_t)t * 2048 + (col0 - 1536)), pack8(v0, v1)); }
                }
        }
    }
};
#if MERGE_ONE
constexpr size_t TILED2_HALF = (size_t)256 * 8 * 8 * 8 * 64 * 8;
struct Epi1g { static constexpr bool PERM = true; NO_PREFETCH bf16_t* GATES; const LAS float* b_gate; bf16_t* GB2;
    __device__ __forceinline__ void operator()(EPI_ARGS) const {
        const int j0 = u.pn * 128 + wc * 32 + 8 * fq;
        const f32x4 ba0 = *(const LAS f32x4*)(b_gate + j0), ba1 = *(const LAS f32x4*)(b_gate + j0 + 4), bb0 = *(const LAS f32x4*)(b_gate + 1024 + j0), bb1 = *(const LAS f32x4*)(b_gate + 1024 + j0 + 4);
#pragma unroll
        for (int ai = 0; ai < 2; ++ai)
#pragma unroll
            for (int m = 0; m < 4; ++m) { f32x4 r0, r1, g0, g1;
#pragma unroll
                for (int q = 0; q < 4; ++q) {
                    const float ea0 = __builtin_amdgcn_exp2f(__builtin_amdgcn_fmed3f(-1.4426950408889634f * (acc[ai][0][m][0][q] + ba0[q]), -57.0f, 57.0f)), eb0 = __builtin_amdgcn_exp2f(__builtin_amdgcn_fmed3f(-1.4426950408889634f * (acc[ai][1][m][0][q] + bb0[q]), -57.0f, 57.0f));
                    const float ea1 = __builtin_amdgcn_exp2f(__builtin_amdgcn_fmed3f(-1.4426950408889634f * (acc[ai][0][m][1][q] + ba1[q]), -57.0f, 57.0f)), eb1 = __builtin_amdgcn_exp2f(__builtin_amdgcn_fmed3f(-1.4426950408889634f * (acc[ai][1][m][1][q] + bb1[q]), -57.0f, 57.0f));
                    if (GATE8) { r0[q] = __builtin_amdgcn_rcpf(1.0f + ea0); r1[q] = __builtin_amdgcn_rcpf(1.0f + ea1); g0[q] = __builtin_amdgcn_rcpf(1.0f + eb0); g1[q] = __builtin_amdgcn_rcpf(1.0f + eb1); }
                    else { r0[q] = (1.0f + eb0) * __builtin_amdgcn_rcpf(1.0f + ea0); g0[q] = __builtin_amdgcn_rcpf(1.0f + eb0);
                        r1[q] = (1.0f + eb1) * __builtin_amdgcn_rcpf(1.0f + ea1); g1[q] = __builtin_amdgcn_rcpf(1.0f + eb1); } }
                bf16_t* d = GATES + ((((size_t)(u.pm * 8 + u.pn) * 8 + (ai * 4 + m)) * 8 + (wr * 4 + wc)) * 64 + (fq * 16 + fr)) * 8;
                if (GATE8) { u32x4 w8 = (u32x4){0u, 0u, 0u, 0u};
#pragma unroll
                    for (int q = 0; q < 4; ++q) { w8.x = __builtin_amdgcn_cvt_pk_u8_f32(r0[q] * 256.0f - 0.5f, q, w8.x); w8.y = __builtin_amdgcn_cvt_pk_u8_f32(r1[q] * 256.0f - 0.5f, q, w8.y);
                        w8.z = __builtin_amdgcn_cvt_pk_u8_f32(g0[q] * 256.0f - 0.5f, q, w8.z); w8.w = __builtin_amdgcn_cvt_pk_u8_f32(g1[q] * 256.0f - 0.5f, q, w8.w); }
                    st16((void*)d, w8); }
                else { const u32x4 rw = pack8(r0, r1), gw2 = pack8(g0, g1);
                    st16((void*)d, rw); asm volatile("" ::: "memory"); st16((void*)(GB2 + (size_t)(d - GATES)), gw2); } }
    }
};
#else
struct Epi1g { static constexpr bool PERM = true; NO_PREFETCH bf16_t* GATES; const LAS float* b_gate;
    __device__ __forceinline__ void operator()(EPI_ARGS) const {
#pragma unroll
        for (int bj = 0; bj < 2; ++bj) { const int col0 = u.pn * 256 + bj * 128 + wc * 32 + 8 * fq;
            const f32x4 b0 = *(const LAS f32x4*)(b_gate + col0), b1 = *(const LAS f32x4*)(b_gate + col0 + 4);
#pragma unroll
            for (int ai = 0; ai < 2; ++ai)
#pragma unroll
                for (int m = 0; m < 4; ++m) { const size_t t = (size_t)u.pm * 256 + ai * 128 + wr * 64 + m * 16 + fr; f32x4 v0 = acc[ai][bj][m][0], v1 = acc[ai][bj][m][1];
#pragma unroll
                    for (int j = 0; j < 4; ++j) { v0[j] = fsigmoid(v0[j] + b0[j]); v1[j] = fsigmoid(v1[j] + b1[j]); }
                    if (TILED_GATES) st16((void*)(GATES + ((((size_t)(u.pm * 8 + u.pn) * 16 + (ai * 8 + m * 2 + bj)) * 8 + (wr * 4 + wc)) * 64 + (fq * 16 + fr)) * 8), pack8(v0, v1));
                    else st16((void*)(GATES + t * 2048 + col0), pack8(v0, v1)); }
        }
    }
};
#endif
struct SchedS5a { const char* ZA; const char* TZ; const char* WS; int G, c;
    __device__ __forceinline__ void fill(int v, int k, Unit& u) const {
        const int pair = v >> 1, g = pair >> 2, rt = pair & 3;
        const int j = (v & 1) ? (k == 0 ? 1 : (k == 1 ? 0 : 4)) : (k == 0 ? 3 : 2);
        const int kt0 = (j < 4) ? 12 - 4 * j : 0;
        u.A0 = ZA + ((size_t)(g * 1024 + rt * 256) * 1024 + kt0 * 64) * 2; u.A1 = u.A0 + 128 * 2048;
        if (j < 4) { u.B0 = TZ + ((size_t)g * 32768 + 16 * j * 16 + kt0 * 64) * 2; u.B1 = u.B0 + 256; }
        else { u.B0 = WS + (size_t)g * 131072 * 2; u.B1 = u.B0; }
        u.nt = 16 - kt0; u.pm = g * 4 + rt; u.pn = j; u.aux = 0;
    }
    __device__ __forceinline__ bool next(int i, Unit& u) const { int k = i; for (int v = c; v < 256; v += G) { const int n = (v & 1) ? 3 : 2; if (k < n) { fill(v, k, u); return true; } k -= n; } return false; }
    __device__ __forceinline__ void voff(const Unit& u, int tid, unsigned (&va)[1][2], unsigned (&vb)[2]) const {
#pragma unroll
        for (int i = 0; i < 2; ++i) { int R, C; mg::stage_rc(tid * 16 + i * 8192, R, C); const int Rb = (R & ~31) + mg::perm32(R & 31);
            va[0][i] = (unsigned)(R * 1024 + C) * 2u; vb[i] = (u.pn < 4) ? (unsigned)((Rb & 15) * 2048 + (Rb >> 4) * 16 + C) * 2u : (unsigned)(Rb * 1024 + C) * 2u; }
    }
};
struct EpiS5a { static constexpr bool PERM = true; NO_PREFETCH bf16_t* YI; float* SST;
    __device__ __forceinline__ void operator()(EPI_ARGS) const {
        const int j = u.pn;
#pragma unroll
        for (int ai = 0; ai < 2; ++ai)
#pragma unroll
            for (int m = 0; m < 4; ++m) { const size_t row = (size_t)u.pm * 256 + ai * 128 + wr * 64 + m * 16 + fr;
                if (j < 4) {
#pragma unroll
                    for (int bj = 0; bj < 2; ++bj) st16((void*)(YI + row * 1024 + j * 256 + bj * 128 + wc * 32 + 8 * fq), pack8(acc[ai][bj][m][0], acc[ai][bj][m][1]));
                } else { float* d = SST + row * 128 + wc * 32 + 8 * fq; st16f(d, acc[ai][0][m][0]); st16f(d + 4, acc[ai][0][m][1]); }
            }
    }
};
struct SchedS5b { const char* HP; const char* WO; int G, c;
    __device__ __forceinline__ bool next(int i, Unit& u) const { const long L = (long)i * G + c; if (L >= 512) return false; const int g = (int)L >> 4, rt = ((int)L >> 2) & 3, j = (int)L & 3;
        u.A0 = HP + (size_t)(g * 1024 + rt * 256) * 512; u.A1 = u.A0 + 128 * 512; u.B0 = WO + (size_t)(g * 1024 + j * 256) * 512; u.B1 = u.B0 + 128 * 512; u.nt = 4; u.pm = g * 4 + rt; u.pn = j; u.aux = 0; return true; }
    __device__ __forceinline__ void voff(const Unit&, int tid, unsigned (&va)[1][2], unsigned (&vb)[2]) const { mg::std_voff<true>(tid, 256, 256, va, vb); }
};
struct EpiS5b { static constexpr bool PERM = true; const bf16_t* YI; bf16_t* YG;
    struct Pre { u32x4 yq[4]; };
#define ES_OFF(s_) (base + (size_t)(((s_) >> 3) * 128 + (((s_) >> 1) & 3) * 16) * 1024 + ((s_) & 1) * 128)
    __device__ __forceinline__ void prefetch(Pre& pre, const Unit& u, int wr, int wc, int fr, int fq) const {
        const size_t base = ((size_t)u.pm * 256 + wr * 64 + fr) * 1024 + u.pn * 256 + wc * 32 + 8 * fq;
#pragma unroll
        for (int s_ = 0; s_ < 4; ++s_) pre.yq[s_] = *(const u32x4*)(YI + ES_OFF(s_));
    }
    __device__ __forceinline__ void operator()(EPI_ARGS) const {
        const size_t base = ((size_t)u.pm * 256 + wr * 64 + fr) * 1024 + u.pn * 256 + wc * 32 + 8 * fq;
        u32x4 yq[4]; u32x2 pke = (u32x2){0u, 0u}; (void)pke;
#pragma unroll
        for (int s_ = 0; s_ < 4; ++s_) yq[s_] = pre.yq[s_];
#pragma unroll
        for (int s_ = 0; s_ < 16; ++s_) { const int ai = s_ >> 3, m = (s_ >> 1) & 3, bj = s_ & 1;
            const u32x4 yw = yq[s_ & 3];
            if (s_ + 4 < 16) yq[s_ & 3] = *(const u32x4*)(YI + ES_OFF(s_ + 4));
            f32x4 y0, y1; unpack8(yw, y0, y1); y0 += acc[ai][bj][m][0]; y1 += acc[ai][bj][m][1];
#pragma unroll
            for (int q = 0; q < 4; ++q) { y0[q] = fgelu(y0[q]); y1[q] = fgelu(y1[q]); }
            st16((void*)(YG + ES_OFF(s_)), pack8(y0, y1)); }
    }
#undef ES_OFF
};
struct SchedGlu { static constexpr bool VOFF_CONST = true; const char* YG; const char* B; int G, c;
    __device__ __forceinline__ bool next(int i, Unit& u) const { int pm, pn; if (!mg::static_tile(i, G, c, 256, 2, pm, pn)) return false; u.pm = pm; u.pn = pn; u.nt = 8; u.aux = 0;
        u.A0 = YG + (size_t)pm * 256 * 32; u.A1 = u.A0 + 128 * 32; u.B0 = B + (size_t)pn * 512 * 512; u.B1 = u.B0 + (size_t)256 * 512; return true; }
    __device__ __forceinline__ void voff(const Unit&, int tid, unsigned (&va)[1][2], unsigned (&vb)[2]) const {
#pragma unroll
        for (int i = 0; i < 2; ++i) { int R, C; mg::stage_rc(tid * 16 + i * 8192, R, C); const int Rb = (R & ~31) + mg::perm32(R & 31);
            va[0][i] = (unsigned)((C >> 4) * 1048576 + R * 16 + (C & 15)) * 2u; vb[i] = (unsigned)(Rb * 512 + C) * 2u; }
    }
};
struct EpiGlu { static constexpr bool PERM = true; const bf16_t* YG; bf16_t* YA; const float* b_glu;
    struct Pre { u32x4 yq[4]; };
#define EG_T(s_) (trow + ((s_) >> 3) * 128 + (((s_) >> 1) & 3) * 16)
#define EG_C(s_) (colb + ((s_) & 1) * 128)
#define EG_Y(s_) (YG + ((size_t)(EG_C(s_) >> 4) * 65536 + EG_T(s_)) * 16 + (EG_C(s_) & 15))
    __device__ __forceinline__ void prefetch(Pre& pre, const Unit& u, int wr, int wc, int fr, int fq) const {
        const size_t trow = (size_t)u.pm * 256 + wr * 64 + fr; const int colb = u.pn * 256 + wc * 32 + 8 * fq;
#pragma unroll
        for (int s_ = 0; s_ < 4; ++s_) pre.yq[s_] = *(const u32x4*)EG_Y(s_);
    }
    __device__ __forceinline__ void operator()(EPI_ARGS) const {
        const size_t trow = (size_t)u.pm * 256 + wr * 64 + fr; const int colb = u.pn * 256 + wc * 32 + 8 * fq;
        f32x4 bq[2][2];
#pragma unroll
        for (int bj = 0; bj < 2; ++bj) { bq[bj][0] = *(const f32x4*)(b_glu + colb + bj * 128); bq[bj][1] = *(const f32x4*)(b_glu + colb + bj * 128 + 4); }
        u32x4 yq[4]; u32x2 pke = (u32x2){0u, 0u}; (void)pke;
#pragma unroll
        for (int s_ = 0; s_ < 4; ++s_) yq[s_] = pre.yq[s_];
#pragma unroll
        for (int s_ = 0; s_ < 16; ++s_) { const int ai = s_ >> 3, m = (s_ >> 1) & 3, bj = s_ & 1;
            const u32x4 yw = yq[s_ & 3];
            if (s_ + 4 < 16) yq[s_ & 3] = *(const u32x4*)EG_Y(s_ + 4);
            f32x4 y0, y1; unpack8(yw, y0, y1);
            f32x4 v0 = acc[ai][bj][m][0] + bq[bj][0], v1 = acc[ai][bj][m][1] + bq[bj][1];
#pragma unroll
            for (int q = 0; q < 4; ++q) { v0[q] = y0[q] * fsigmoid(v0[q]); v1[q] = y1[q] * fsigmoid(v1[q]); if (Q8_P8) { v0[q] = q8(v0[q], 8.f, 0.125f); v1[q] = q8(v1[q], 8.f, 0.125f); } }
            if (FP8_MERGE) { v0 *= 8.0f; v1 *= 8.0f; const u32x2 pk = (u32x2){pk4_fp8(v0[0], v0[1], v0[2], v0[3]), pk4_fp8(v1[0], v1[1], v1[2], v1[3])};
                if (WIDE8) { if (bj == 0) pke = pk; else { const u32x4 w16 = widen8(pke, pk);
                        st16((void*)((unsigned char*)YA + EG_T(s_) * 512 + (colb - 8 * fq) + ((fq & 1) ? 128 + 8 * (fq - 1) : 8 * fq)), w16); } }
                else st8((void*)((unsigned char*)YA + EG_T(s_) * 512 + EG_C(s_)), pk); }
            else st16((void*)(YA + EG_T(s_) * 512 + EG_C(s_)), pack8(v0, v1)); }
    }
#undef EG_T
#undef EG_C
#undef EG_Y
};
template <int SECOND> struct EpiMerge { static constexpr bool PERM = true; const bf16_t* GATES; bf16_t* P1; bf16_t* MERGED;
    static constexpr int PD = SECOND ? 4 : 8;
    struct Pre { u32x4 gq[PD]; u32x4 pq[SECOND ? 4 : 1]; };
#define EM_GT(s_) (GATES + ((((size_t)(u.pm * 8 + SECOND * 4 + u.pn) * 16 + (s_)) * 8 + (wr * 4 + wc)) * 64 + (fq * 16 + fr)) * 8)
#define EM_PT(s_) (P1 + ((((size_t)(u.pm * 4 + u.pn) * 16 + (s_)) * 8 + (wr * 4 + wc)) * 64 + (fq * 16 + fr)) * 8)
#define EM_T(s_) (trow + ((s_) >> 3) * 128 + (((s_) >> 1) & 3) * 16)
#define EM_C(s_) (colb + ((s_) & 1) * 128)
    __device__ __forceinline__ void prefetch(Pre& pre, const Unit& u, int wr, int wc, int fr, int fq) const {
        const size_t trow = (size_t)u.pm * 256 + wr * 64 + fr; const int colb = u.pn * 256 + wc * 32 + 8 * fq;
#pragma unroll
        for (int s_ = 0; s_ < PD; ++s_) { pre.gq[s_] = TILED_GATES ? *(const u32x4*)EM_GT(s_) : *(const u32x4*)(GATES + EM_T(s_) * 2048 + SECOND * 1024 + EM_C(s_)); if (SECOND) pre.pq[s_] = TILED_GATES ? *(const u32x4*)EM_PT(s_) : *(const u32x4*)(P1 + EM_T(s_) * 1024 + EM_C(s_)); }
    }
    __device__ __forceinline__ void operator()(EPI_ARGS) const {
        const size_t trow = (size_t)u.pm * 256 + wr * 64 + fr; const int colb = u.pn * 256 + wc * 32 + 8 * fq;
        u32x4 gq[PD], pq[4];
#pragma unroll
        for (int s_ = 0; s_ < PD; ++s_) { gq[s_] = pre.gq[s_]; if (SECOND) pq[s_] = pre.pq[s_ & 3]; }
#pragma unroll
        for (int s_ = 0; s_ < 16; ++s_) { const int ai = s_ >> 3, m = (s_ >> 1) & 3, bj = s_ & 1;
            const u32x4 gw = gq[s_ % PD]; u32x4 pw; if (SECOND) pw = pq[s_ & 3];
            if (s_ + PD < 16) { gq[s_ % PD] = TILED_GATES ? *(const u32x4*)EM_GT(s_ + PD) : *(const u32x4*)(GATES + EM_T(s_ + PD) * 2048 + SECOND * 1024 + EM_C(s_ + PD)); if (SECOND) pq[s_ & 3] = TILED_GATES ? *(const u32x4*)EM_PT(s_ + 4) : *(const u32x4*)(P1 + EM_T(s_ + 4) * 1024 + EM_C(s_ + 4)); }
            f32x4 g0, g1; unpack8(gw, g0, g1);
            f32x4 v0 = acc[ai][bj][m][0] * g0, v1 = acc[ai][bj][m][1] * g1;
            if (SECOND) { f32x4 q0, q1; unpack8(pw, q0, q1); v0 += q0; v1 += q1;
                if (Q8_P10) { for (int q = 0; q < 4; ++q) { v0[q] = q8(v0[q], 4.f, 0.25f); v1[q] = q8(v1[q], 4.f, 0.25f); } }
                if (FP8_OUT) { v0 *= 4.0f; v1 *= 4.0f; st8((void*)((unsigned char*)MERGED + EM_T(s_) * 1024 + EM_C(s_)), (u32x2){pk4_fp8(v0[0], v0[1], v0[2], v0[3]), pk4_fp8(v1[0], v1[1], v1[2], v1[3])}); }
                else st16((void*)(MERGED + EM_T(s_) * 1024 + EM_C(s_)), pack8(v0, v1)); }
            else { if (TILED_GATES) st16((void*)EM_PT(s_), pack8(v0, v1)); else st16((void*)(P1 + EM_T(s_) * 1024 + EM_C(s_)), pack8(v0, v1)); } }
    }
#undef EM_T
#undef EM_C
#undef EM_GT
#undef EM_PT
};
struct SchedMerge { static constexpr bool VOFF_CONST = true; static constexpr int SWZ8 = 4; const char* YA; const char* YB; const char* WA; const char* WB; int G, c;
    __device__ __forceinline__ bool next(int i, Unit& u) const { int pm, pn; if (!mg::static_tile(i >> 1, G, c, 256, 4, pm, pn)) return false; const int seg = i & 1; u.pm = pm; u.pn = pn; u.nt = FP8_MERGE ? 4 : 8; u.aux = seg ? 0 : mg::KEEP_ACC;
        const char* A = seg ? YB : YA; const char* B = seg ? WB : WA; constexpr int EB = FP8_MERGE ? 1 : 2;
        u.A0 = A + (size_t)pm * 256 * 512 * EB; u.A1 = u.A0 + (size_t)128 * 512 * EB; u.B0 = B + (size_t)pn * 256 * 512 * EB; u.B1 = u.B0 + (size_t)128 * 512 * EB; return true; }
    __device__ __forceinline__ void voff(const Unit&, int tid, unsigned (&va)[1][2], unsigned (&vb)[2]) const { if (FP8_MERGE) mg::std_voff8<true, SWZ8>(tid, 512, 512, va, vb); else mg::std_voff<true>(tid, 512, 512, va, vb); }
};
struct EpiMergeOne { static constexpr bool PERM = true; const bf16_t* GATES; bf16_t* MERGED;
    static constexpr int PD = GATE8 ? 3 : 4;
    struct Pre { u32x4 gq[PD]; };
#define EM1_G(s_) (gbase + ((((size_t)(u.pm * 8 + 2 * u.pn + ((s_) & 1)) * 8 + (((s_) >> 3) * 4 + (((s_) >> 1) & 3))) * 8 + (wr * 4 + wc)) * 64 + (fq * 16 + fr)) * 8)
    __device__ __forceinline__ void prefetch(Pre& pre, const Unit& u, int wr, int wc, int fr, int fq) const {
        const bf16_t* gbase = GATES + ((GATE8 || (u.aux & mg::KEEP_ACC)) ? (size_t)0 : TILED2_HALF);
#pragma unroll
        for (int s_ = 0; s_ < PD; ++s_) pre.gq[s_] = *(const u32x4*)EM1_G(s_);
    }
    __device__ __forceinline__ void operator()(f32x4 (&acc)[2][2][4][2], const Unit& u, int wr, int wc, int fr, int fq, const Pre& pre) const {
        const bool first = (u.aux & mg::KEEP_ACC) != 0;
        const bf16_t* gbase = GATES + ((GATE8 || first) ? (size_t)0 : TILED2_HALF);
        const size_t trow = (size_t)u.pm * 256 + wr * 64 + fr; const int colm = u.pn * 256 + wc * 32 + 8 * fq;
        u32x4 gq[PD]; u32x2 pke = (u32x2){0u, 0u}; (void)pke;
#pragma unroll
        for (int s_ = 0; s_ < PD; ++s_) gq[s_] = pre.gq[s_];
#pragma unroll
        for (int s_ = 0; s_ < 16; ++s_) { const int ai = s_ >> 3, m = (s_ >> 1) & 3, bj = s_ & 1;
            const u32x4 gw = gq[s_ % PD];
            if (s_ + PD < 16) gq[s_ % PD] = *(const u32x4*)EM1_G(s_ + PD);
            f32x4 g0, g1;
            if (GATE8) {
                const unsigned na0 = first ? gw.x : 0x80808080u, na1 = first ? gw.y : 0x80808080u;
#pragma unroll
                for (int e = 0; e < 4; ++e) { const float kb0 = (float)((gw.z >> (8 * e)) & 0xffu) + 0.5f, kb1 = (float)((gw.w >> (8 * e)) & 0xffu) + 0.5f;
                    const float ka0 = (float)((na0 >> (8 * e)) & 0xffu) + 0.5f, ka1 = (float)((na1 >> (8 * e)) & 0xffu) + 0.5f;
                    g0[e] = first ? ka0 * __builtin_amdgcn_rcpf(kb0) : kb0 * 0.00390625f; g1[e] = first ? ka1 * __builtin_amdgcn_rcpf(kb1) : kb1 * 0.00390625f; } }
            else unpack8(gw, g0, g1);
            if (first) { acc[ai][bj][m][0] *= g0; acc[ai][bj][m][1] *= g1; }
            else { f32x4 v0 = acc[ai][bj][m][0] * g0, v1 = acc[ai][bj][m][1] * g1; const size_t mo = (trow + ai * 128 + m * 16) * 1024 + colm + bj * 128;
                if (FP8_OUT) { v0 *= 4.0f; v1 *= 4.0f; const u32x2 pk = (u32x2){pk4_fp8(v0[0], v0[1], v0[2], v0[3]), pk4_fp8(v1[0], v1[1], v1[2], v1[3])};
                    if (WIDE8) { if (bj == 0) pke = pk; else { const u32x4 w16 = widen8(pke, pk);
                            st16((void*)((unsigned char*)MERGED + (trow + ai * 128 + m * 16) * 1024 + (colm - 8 * fq) + ((fq & 1) ? 128 + 8 * (fq - 1) : 8 * fq)), w16); } }
                    else st8((void*)((unsigned char*)MERGED + mo), pk); }
                else st16((void*)(MERGED + mo), pack8(v0, v1)); } }
    }
#undef EM1_G
};
#ifndef EO_FULL
#define EO_FULL 1
#endif
struct EpiOut { static constexpr bool PERM = false; const float* x; const float* mod; float* H1;
    struct Pre { f32x4 xq[8]; };
#define EO_OFF(s_) (rowb + (size_t)(((s_) >> 4) * 128 + (((s_) >> 2) & 3) * 16 + (EO_FULL ? ((s_) & 1) * 8 : 0)) * 1024 + (((s_) >> 1) & 1) * 128 + (EO_FULL ? 0 : ((s_) & 1) * 16))
    __device__ __forceinline__ void prefetch(Pre& pre, const Unit& u, int wr, int wc, int fr, int fq) const {
        const size_t rowb = EO_FULL ? ((size_t)u.pm * 256 + wr * 64 + (fr & 7)) * 1024 + u.pn * 256 + wc * 32 + (fr >> 3) * 16 + 4 * fq : ((size_t)u.pm * 256 + wr * 64 + fr) * 1024 + u.pn * 256 + wc * 32 + 4 * fq;
#pragma unroll
        for (int s_ = 0; s_ < 8; ++s_) pre.xq[s_] = NTLD((const f32x4*)(x + EO_OFF(s_)));
    }
    __device__ __forceinline__ void operator()(EPI_ARGS) const {
        const int bb = (u.pm * 256) >> 11; const bool lo8 = fr < 8;
        const size_t rowb = EO_FULL ? ((size_t)u.pm * 256 + wr * 64 + (fr & 7)) * 1024 + u.pn * 256 + wc * 32 + (fr >> 3) * 16 + 4 * fq : ((size_t)u.pm * 256 + wr * 64 + fr) * 1024 + u.pn * 256 + wc * 32 + 4 * fq;
        f32x4 gt[4];
#pragma unroll
        for (int q = 0; q < 4; ++q) gt[q] = *(const f32x4*)(mod + bb * 6144 + 2048 + u.pn * 256 + wc * 32 + 4 * fq + (q >> 1) * 128 + (q & 1) * 16);
        if (EO_FULL) {
#pragma unroll
            for (int b2 = 0; b2 < 2; ++b2)
#pragma unroll
                for (int e = 0; e < 4; ++e) { const float g_ = lo8 ? gt[b2 * 2][e] : gt[b2 * 2 + 1][e]; gt[b2 * 2][e] = g_; gt[b2 * 2 + 1][e] = g_; } }
        f32x4 xq[8];
#pragma unroll
        for (int s_ = 0; s_ < 8; ++s_) xq[s_] = pre.xq[s_];
        f32x4 aA = (f32x4){0.f, 0.f, 0.f, 0.f}, aB = aA;
#pragma unroll
        for (int s_ = 0; s_ < 32; ++s_) { const int ai = s_ >> 4, m = (s_ >> 2) & 3, bj = (s_ >> 1) & 1, n = s_ & 1;
            const f32x4 xv = xq[s_ & 7];
            if (s_ + 8 < 32) xq[s_ & 7] = NTLD((const f32x4*)(x + EO_OFF(s_ + 8)));
            f32x4 av = acc[ai][bj][m][n];
            if (EO_FULL) {
                if (n == 0) {
#pragma unroll
                    for (int e = 0; e < 4; ++e) { const float mine0 = acc[ai][bj][m][0][e], mine1 = acc[ai][bj][m][1][e]; const float give = lo8 ? mine1 : mine0;
                        const float got = __builtin_bit_cast(float, __builtin_amdgcn_update_dpp(0, __builtin_bit_cast(int, give), 0x128, 0xf, 0xf, false));
                        aA[e] = lo8 ? mine0 : got; aB[e] = lo8 ? got : mine1; } }
                av = (n == 0) ? aA : aB; }
            f32x4 hv_ = xv + gt[bj * 2 + n] * av;
#ifdef H1_BF16_EMU
            { const unsigned w0 = cvt_pk_bf16(hv_[0], hv_[1]), w1 = cvt_pk_bf16(hv_[2], hv_[3]); hv_ = (f32x4){bf_lo(w0), bf_hi(w0), bf_lo(w1), bf_hi(w1)}; }
#endif
            st16f((void*)(H1 + EO_OFF(s_)), hv_); }
    }
#undef EO_OFF
};
struct EpiOutB { static constexpr bool PERM = true; const float* x; const float* mod; bf16_t* H1B;
    struct Pre { f32x4 xq[8]; };
#define EO_OFF(s_) (rowb + (size_t)(((s_) >> 3) * 128 + (((s_) >> 1) & 3) * 16) * 1024 + ((s_) & 1) * 128)
    __device__ __forceinline__ void prefetch(Pre& pre, const Unit& u, int wr, int wc, int fr, int fq) const {
        const size_t rowb = ((size_t)u.pm * 256 + wr * 64 + fr) * 1024 + u.pn * 256 + wc * 32 + 8 * fq;
#pragma unroll
        for (int s_ = 0; s_ < 4; ++s_) { pre.xq[2 * s_] = *(const f32x4*)(x + EO_OFF(s_)); pre.xq[2 * s_ + 1] = *(const f32x4*)(x + EO_OFF(s_) + 4); }
    }
    __device__ __forceinline__ void operator()(EPI_ARGS) const {
        const int bb = (u.pm * 256) >> 11;
        const size_t rowb = ((size_t)u.pm * 256 + wr * 64 + fr) * 1024 + u.pn * 256 + wc * 32 + 8 * fq;
        f32x4 gt[2][2];
#pragma unroll
        for (int bj = 0; bj < 2; ++bj) { const float* gp = mod + bb * 6144 + 2048 + u.pn * 256 + wc * 32 + 8 * fq + bj * 128; gt[bj][0] = *(const f32x4*)gp; gt[bj][1] = *(const f32x4*)(gp + 4); }
        f32x4 xq[8];
#pragma unroll
        for (int s_ = 0; s_ < 8; ++s_) xq[s_] = pre.xq[s_];
#pragma unroll
        for (int s_ = 0; s_ < 16; ++s_) { const int ai = s_ >> 3, m = (s_ >> 1) & 3, bj = s_ & 1;
            const f32x4 x0 = xq[2 * (s_ & 3)], x1 = xq[2 * (s_ & 3) + 1];
            if (s_ + 4 < 16) { xq[2 * (s_ & 3)] = *(const f32x4*)(x + EO_OFF(s_ + 4)); xq[2 * (s_ & 3) + 1] = *(const f32x4*)(x + EO_OFF(s_ + 4) + 4); }
            st16((void*)(H1B + EO_OFF(s_)), pack8(x0 + gt[bj][0] * acc[ai][bj][m][0], x1 + gt[bj][1] * acc[ai][bj][m][1])); }
    }
#undef EO_OFF
};
struct MoeTab { const LAS int* cnt; const LAS int* tstart; LAS int* lists; const LAS int* segp; };
__device__ __forceinline__ void moe_find(const MoeTab& mt, int rt, int& e, int& lt) { int ee = 0; for (int q = 1; q < 32; ++q) if (mt.tstart[q] <= rt) ee = q; e = __builtin_amdgcn_readfirstlane(ee); lt = __builtin_amdgcn_readfirstlane(rt - mt.tstart[ee]); }
__device__ __forceinline__ void moe_unit(long L, int nt_total, int& rt, int& pn) {
    const int ntf = (nt_total >> 3) << 3;
    if (L < 4l * ntf) { const int x = (int)(L & 7), y = (int)(L >> 3); rt = (y >> 2) * 8 + x; pn = y & 3; }
    else { const int l2 = (int)(L - 4l * ntf); rt = ntf + (l2 >> 2); pn = l2 & 3; }
}
__device__ __forceinline__ int moe_phys(const MoeTab& mt, int e, int ri) { const int p1 = mt.segp[e * 4 + 1], p2 = mt.segp[e * 4 + 2], p3 = mt.segp[e * 4 + 3];
    const int sg = (ri >= p1) + (ri >= p2) + (ri >= p3); const int pb = sg == 0 ? 0 : (sg == 1 ? p1 : (sg == 2 ? p2 : p3)); return sg * (ECAP / 4) + (ri - pb); }
#define MOE_E(a_) ((a_) & 255)
#define MOE_LT(a_) (((a_) >> 8) & 0xfffff)
#define MOE_BUF(a_) (((a_) >> 28) & 3)
struct SchedUp { static constexpr bool LISTS = true; static constexpr int SWZ8 = SWZ_UP; const char* XN2; const char* WUPT; const int* rowtok; MoeTab mt; int G, c; const float* roww;
    __device__ __forceinline__ bool next(int i, Unit& u) const { const long L = (long)i * G + c; const int ntt = __builtin_amdgcn_readfirstlane(mt.tstart[32]); if (L >= 4l * ntt) return false; int rt, pn; moe_unit(L, ntt, rt, pn); int e, lt; moe_find(mt, rt, e, lt);
        constexpr int EB = FP8_MOE ? 1 : 2;
        u.A0 = XN2; u.A1 = XN2; u.B0 = WUPT + ((size_t)(e * 1024 + pn * 256) * 1024) * EB; u.B1 = u.B0 + 128 * 1024 * EB; u.nt = FP8_MOE ? 8 : 16; u.pm = rt; u.pn = pn; u.aux = e | (lt << 8) | ((i % 3) << 28); return true; }
    __device__ __forceinline__ void list_dma(const Unit& u, int wid, int lane) const { const int e = MOE_E(u.aux), lt = MOE_LT(u.aux), cn = mt.cnt[e]; const int r = (wid & 3) * 64 + lane, ri = lt * 256 + r, ric = ri < cn ? ri : cn - 1;
        const int* src = ((wid < 4) ? rowtok : (const int*)roww) + (size_t)e * ECAP + moe_phys(mt, e, ric);
        __builtin_amdgcn_global_load_lds((const unsigned*)src, (LAS unsigned*)(mt.lists + MOE_BUF(u.aux) * 512 + wid * 64), 4, 0, 0); }
    __device__ __forceinline__ void voff(const Unit& u, int tid, unsigned (&va)[2][2], unsigned (&vb)[2]) const {
        asm volatile("" : "+v"(tid));
        constexpr int EB = FP8_MOE ? 1 : 2; const LAS int* tl = mt.lists + MOE_BUF(u.aux) * 512;
#pragma unroll
        for (int i = 0; i < 2; ++i) { int R, C; mg::stage_rc<FP8_MOE ? SWZ8 : 5>(tid * 16 + i * 8192, R, C); const int Rb = (R & ~31) + mg::perm32(R & 31); vb[i] = (unsigned)(Rb * 1024 * EB + C * 2);
#pragma unroll
            for (int h = 0; h < 2; ++h) { const int tok = tl[h * 128 + R] >> 1; va[h][i] = (unsigned)tok * (1024u * EB) + (unsigned)C * 2u; } }
    }
};
struct EpiUp { static constexpr bool PERM = true; bf16_t* HID; const float* roww; MoeTab mt;
    struct Pre { float w[8]; };
    __device__ __forceinline__ void prefetch(Pre& pre, const Unit& u, int wr, int wc, int fr, int fq) const {
        const int e = MOE_E(u.aux), lt = MOE_LT(u.aux), cn = mt.cnt[e]; const LAS float* wl_ = (const LAS float*)(mt.lists + MOE_BUF(u.aux) * 512 + 256);
#pragma unroll
        for (int q = 0; q < 8; ++q) { const int r = (q >> 2) * 128 + wr * 64 + (q & 3) * 16 + fr; const float wv = wl_[r]; pre.w[q] = (lt * 256 + r < cn) ? wv : 0.f; }
    }
    __device__ __forceinline__ void operator()(EPI_ARGS) const {
        u32x2 pke = (u32x2){0u, 0u}; (void)pke;
#pragma unroll
        for (int ai = 0; ai < 2; ++ai)
#pragma unroll
            for (int m = 0; m < 4; ++m) { const int r = ai * 128 + wr * 64 + m * 16 + fr; const float w = pre.w[ai * 4 + m];
                f32x4 h0, h1;
#pragma unroll
                for (int q = 0; q < 4; ++q) { h0[q] = fsilu(acc[ai][0][m][0][q]) * acc[ai][1][m][0][q] * w; h1[q] = fsilu(acc[ai][0][m][1][q]) * acc[ai][1][m][1][q] * w; if (Q8_MOE) { h0[q] = q8(h0[q], 8.f, 0.125f); h1[q] = q8(h1[q], 8.f, 0.125f); } }
                if (FP8_MOE) { h0 *= 8.0f; h1 *= 8.0f; const u32x2 pk = (u32x2){pk4_fp8(h0[0], h0[1], h0[2], h0[3]), pk4_fp8(h1[0], h1[1], h1[2], h1[3])};
                    if (WIDE8) { if ((m & 1) == 0) pke = pk; else { const u32x4 w16 = widen8(pke, pk);
                            const int rr = (fq & 1) ? r : r - 16; const int cb = (fq & 1) ? 8 * (fq - 1) : 8 * fq;
                            st16((void*)((unsigned char*)HID + ((size_t)u.pm * 256 + rr) * 512 + u.pn * 128 + wc * 32 + cb), w16); } }
                    else st8((void*)((unsigned char*)HID + ((size_t)u.pm * 256 + r) * 512 + u.pn * 128 + wc * 32 + 8 * fq), pk); }
                else st16((void*)(HID + ((size_t)u.pm * 256 + r) * 512 + u.pn * 128 + wc * 32 + 8 * fq), pack8(h0, h1)); }
    }
};
struct EpiUpMath { static constexpr bool PERM = true; NO_PREFETCH const float* roww; MoeTab mt;
    __device__ __forceinline__ void operator()(EPI_ARGS) const {
        const int e = MOE_E(u.aux), lt = MOE_LT(u.aux), cn = mt.cnt[e];
#pragma unroll
        for (int ai = 0; ai < 2; ++ai)
#pragma unroll
            for (int m = 0; m < 4; ++m) { const int r = ai * 128 + wr * 64 + m * 16 + fr, ri = lt * 256 + r; const float w = (ri < cn) ? roww[(size_t)e * ECAP + ri] : 0.f;
                f32x4 h0, h1;
#pragma unroll
                for (int q = 0; q < 4; ++q) { h0[q] = fsilu(acc[ai][0][m][0][q]) * acc[ai][1][m][0][q] * w * 8.0f; h1[q] = fsilu(acc[ai][0][m][1][q]) * acc[ai][1][m][1][q] * w * 8.0f; }
                const u32x2 o = (u32x2){pk4_fp8(h0[0], h0[1], h0[2], h0[3]), pk4_fp8(h1[0], h1[1], h1[2], h1[3])}; asm volatile("" :: "v"(o)); }
    }
};
struct SchedDn { static constexpr bool LISTS = true; static constexpr bool VOFF_CONST = true; static constexpr int SWZ8 = SWZ_DN; const char* HID; const char* WDNT; MoeTab mt; int G, c; const int* rowtok;
    __device__ __forceinline__ bool next(int i, Unit& u) const { const long L = (long)i * G + c; const int ntt = __builtin_amdgcn_readfirstlane(mt.tstart[32]); if (L >= 4l * ntt) return false; int rt, pn; moe_unit(L, ntt, rt, pn); int e, lt; moe_find(mt, rt, e, lt);
        constexpr int EB = FP8_MOE ? 1 : 2;
        u.A0 = HID + (size_t)rt * 256 * 512 * EB; u.A1 = u.A0 + 128 * 512 * EB; u.B0 = WDNT + ((size_t)(e * 1024 + pn * 256) * 512) * EB; u.B1 = u.B0 + 128 * 512 * EB; u.nt = FP8_MOE ? 4 : 8; u.pm = rt; u.pn = pn; u.aux = e | (lt << 8) | ((i % 3) << 28); return true; }
    __device__ __forceinline__ void list_dma(const Unit& u, int wid, int lane) const { if (wid >= 4) return; const int e = MOE_E(u.aux), lt = MOE_LT(u.aux), cn = mt.cnt[e]; const int ri = lt * 256 + wid * 64 + lane, ric = ri < cn ? ri : cn - 1;
        __builtin_amdgcn_global_load_lds((const unsigned*)(rowtok + (size_t)e * ECAP + moe_phys(mt, e, ric)), (LAS unsigned*)(mt.lists + MOE_BUF(u.aux) * 512 + wid * 64), 4, 0, 0); }
    __device__ __forceinline__ void voff(const Unit&, int tid, unsigned (&va)[1][2], unsigned (&vb)[2]) const { if (FP8_MOE) mg::std_voff8<true, SWZ8>(tid, 512, 512, va, vb); else mg::std_voff<true>(tid, 512, 512, va, vb); }
};
struct EpiDn { static constexpr bool PERM = true; bf16_t* SLOT; const int* rowtok; MoeTab mt;
    struct Pre { int slot[8]; };
    __device__ __forceinline__ void prefetch(Pre& pre, const Unit& u, int wr, int wc, int fr, int fq) const {
        const int e = MOE_E(u.aux), lt = MOE_LT(u.aux), cn = mt.cnt[e]; const LAS int* sl_ = mt.lists + MOE_BUF(u.aux) * 512;
#pragma unroll
        for (int q = 0; q < 8; ++q) { const int r = (q >> 2) * 128 + wr * 64 + (q & 3) * 16 + fr; const int sv = sl_[r]; pre.slot[q] = (lt * 256 + r < cn) ? sv : -1; }
    }
    __device__ __forceinline__ void operator()(EPI_ARGS) const {
#pragma unroll
        for (int ai = 0; ai < 2; ++ai)
#pragma unroll
            for (int m = 0; m < 4; ++m) { const int sl = pre.slot[ai * 4 + m];
                if (FP8_SLOT && WIDE8) {
                    const f32x4 a0 = acc[ai][0][m][0] * 16.0f, a1 = acc[ai][0][m][1] * 16.0f, b0 = acc[ai][1][m][0] * 16.0f, b1 = acc[ai][1][m][1] * 16.0f;
                    const u32x4 w16 = widen8((u32x2){pk4_fp8(a0[0], a0[1], a0[2], a0[3]), pk4_fp8(a1[0], a1[1], a1[2], a1[3])}, (u32x2){pk4_fp8(b0[0], b0[1], b0[2], b0[3]), pk4_fp8(b1[0], b1[1], b1[2], b1[3])});
                    if (sl >= 0) st16((void*)((unsigned char*)SLOT + (size_t)sl * 1024 + u.pn * 256 + wc * 32 + ((fq & 1) ? 128 + 8 * (fq - 1) : 8 * fq)), w16);
                } else if (sl >= 0) { const size_t slot = (size_t)sl;
#pragma unroll
                    for (int bj = 0; bj < 2; ++bj) {
                        if (FP8_SLOT) { const f32x4 a0 = acc[ai][bj][m][0] * 16.0f, a1 = acc[ai][bj][m][1] * 16.0f;
                            st8((void*)((unsigned char*)SLOT + slot * 1024 + u.pn * 256 + bj * 128 + wc * 32 + 8 * fq), (u32x2){pk4_fp8(a0[0], a0[1], a0[2], a0[3]), pk4_fp8(a1[0], a1[1], a1[2], a1[3])}); }
                        else st16((void*)(SLOT + slot * 1024 + u.pn * 256 + bj * 128 + wc * 32 + 8 * fq), pack8(acc[ai][bj][m][0], acc[ai][bj][m][1])); } }
            }
    }
};
__device__ __forceinline__ MoeTab moe_table(const Params& p, const Ctx& c) {
    LAS int* cnt = (LAS int*)(c.lds + XT_OFF); LAS int* ts = (LAS int*)(c.lds + XT_OFF + 256);
    LAS int* sp = (LAS int*)(c.lds + XT_OFF + 512);
    if (c.tid < 32) { int a = 0;
#pragma unroll
        for (int sg = 0; sg < 4; ++sg) { sp[c.tid * 4 + sg] = a; a += (int)__hip_atomic_load((unsigned*)(p.ws + WS_CTL) + CW_CURSOR + 64 * (c.tid * 4 + sg), RLX_AGENT); }
        cnt[c.tid] = a; }
    __syncthreads();
    if (c.tid == 0) { int s = 0; for (int e = 0; e < 32; ++e) { ts[e] = s; s += (cnt[e] + 255) >> 8; } ts[32] = s; }
    __syncthreads();
    MoeTab mt; mt.cnt = cnt; mt.tstart = ts; mt.lists = (LAS int*)(c.lds + XT_OFF + 1024); mt.segp = (const LAS int*)(c.lds + XT_OFF + 512); return mt;
}

__device__ __forceinline__ void p4_scan(const Params& p, const Ctx& c) {
    typedef float f2 __attribute__((ext_vector_type(2)));
    const float* SST = (const float*)(p.ws + WS_SST); bf16_t* HP = (bf16_t*)(p.ws + WS_HP);
    for (int gid = c.vcu * NTHREADS + c.tid; gid < 65536; gid += c.G * NTHREADS) {
        const int g = gid >> 11, b = (gid >> 6) & 31, n = gid & 63;
        const f2 al = ((const f2*)(p.ws + WS_AL))[g * 64 + n];
        float hr = 0.f, hi = 0.f;
        for (int cc = 0; cc < 32; ++cc) { const size_t row = (size_t)g * 1024 + b * 32 + cc;
            HP[row * 256 + n] = (bf16_t)f2bf(hr); HP[row * 256 + 64 + n] = (bf16_t)f2bf(hi); HP[row * 256 + 128 + n] = 0; HP[row * 256 + 192 + n] = 0;
            const float sr = SST[row * 128 + n], si = SST[row * 128 + 64 + n];
            const float nr = al.x * hr - al.y * hi + sr, ni = al.x * hi + al.y * hr + si; hr = nr; hi = ni; }
    }
}

__device__ __forceinline__ void p7_sgu(const Params& p, const Ctx& c) {
    typedef float f32x16 __attribute__((ext_vector_type(16)));
    constexpr int VS = 136;
    LAS bf16_t* VT = (LAS bf16_t*)c.lds;
    const bf16_t* GV = (const bf16_t*)(p.ws + WS_GV); const bf16_t* U = (const bf16_t*)(p.ws + WS_U); bf16_t* YB = (bf16_t*)(p.ws + WS_YB);
    const bf16_t* SW = (const bf16_t*)(p.ws + WS_SGUW);
    const int lane = c.lane, w = c.wave;
    f32x4 lg0 = *(const f32x4*)(p.in[I_LNG] + 8 * lane), lg1 = *(const f32x4*)(p.in[I_LNG] + 8 * lane + 4), lb0 = *(const f32x4*)(p.in[I_LNB] + 8 * lane), lb1 = *(const f32x4*)(p.in[I_LNB] + 8 * lane + 4);
    for (int un = c.vcu; un < 512; un += c.G) {
        const size_t t0 = (size_t)un * 128;
        unsigned pk[8][8];
#pragma unroll
        for (int rr = 0; rr < 16; ++rr) {
            f32x4 a, b; unpack8(*(const u32x4*)(GV + (t0 + 16 * w + rr) * 512 + 8 * lane), a, b);
            const float mu = wave_sum((a[0] + a[1]) + (a[2] + a[3]) + (b[0] + b[1]) + (b[2] + b[3])) * (1.0f / 512.0f);
            a -= mu; b -= mu;
            const float var = wave_sum((a[0] * a[0] + a[1] * a[1]) + (a[2] * a[2] + a[3] * a[3]) + (b[0] * b[0] + b[1] * b[1]) + (b[2] * b[2] + b[3] * b[3])) * (1.0f / 512.0f);
            const float rs = 1.0f / sqrtf(var + 1e-5f);
            a = a * rs * lg0 + lb0; b = b * rs * lg1 + lb1;
#pragma unroll
            for (int j = 0; j < 4; ++j) {
                if (rr & 1) { pk[j][rr >> 1] |= f2bf(a[j]) << 16; pk[4 + j][rr >> 1] |= f2bf(b[j]) << 16; }
                else { pk[j][rr >> 1] = f2bf(a[j]); pk[4 + j][rr >> 1] = f2bf(b[j]); }
            }
        }
#pragma unroll
        for (int j = 0; j < 8; ++j) { LAS bf16_t* d = VT + (8 * lane + j) * VS + 16 * w;
            *(LAS u32x4*)d = (u32x4){pk[j][0], pk[j][1], pk[j][2], pk[j][3]}; *(LAS u32x4*)(d + 8) = (u32x4){pk[j][4], pk[j][5], pk[j][6], pk[j][7]}; }
        __syncthreads();
        const int tb = w & 3, db = w >> 2, l31 = lane & 31, hi = lane >> 5;
        LAS unsigned char* wu = c.lds + 139264 + w * 2560;
        const int lr = lane >> 2, lp = lane & 3;
        const size_t gbase = (t0 + tb * 32 + lr) * 512 + db * 32 + lp * 8;
        u32x4 un0 = *(const u32x4*)(U + gbase), un1 = *(const u32x4*)(U + gbase + 16 * 512);
        for (int h = 0; h < 8; ++h) {
            *(LAS u32x4*)(wu + lr * 80 + lp * 16) = un0; *(LAS u32x4*)(wu + (lr + 16) * 80 + lp * 16) = un1;
            if (h < 7) { un0 = *(const u32x4*)(U + gbase + (h + 1) * 64); un1 = *(const u32x4*)(U + gbase + 16 * 512 + (h + 1) * 64); }
            f32x16 acc;
#pragma unroll
            for (int q = 0; q < 16; ++q) acc[q] = 0.f;
            const LAS bf16_t* arow = VT + (h * 64 + db * 32 + l31) * VS + 8 * hi;
            const bf16_t* brow = SW + ((size_t)(h * 128 + tb * 32 + l31)) * 128 + 8 * hi;
            const int nks = 2 * tb + 2;
            bf16x8 bq[8];
            (void)nks;
#pragma unroll
            for (int ks = 0; ks < 8; ++ks) bq[ks] = *(const bf16x8*)(brow + 16 * ks);
#pragma unroll
            for (int ks = 0; ks < 8; ++ks) { const bf16x8 af = *(const LAS bf16x8*)(arow + 16 * ks); acc = __builtin_amdgcn_mfma_f32_32x32x16_bf16(af, bq[ks], acc, 0, 0, 0); }
            const int tt = tb * 32 + l31; const float bs = p.in[I_SGUB][h * 128 + tt];
#pragma unroll
            for (int q = 0; q < 4; ++q) {
                LAS u32x2* up = (LAS u32x2*)(wu + l31 * 80 + 16 * q + 8 * hi);
                const u32x2 uu = *up;
                float y0 = bf_lo(uu.x) * (acc[4 * q] + bs), y1 = bf_hi(uu.x) * (acc[4 * q + 1] + bs), y2 = bf_lo(uu.y) * (acc[4 * q + 2] + bs), y3 = bf_hi(uu.y) * (acc[4 * q + 3] + bs);
                if (Q8_P8) { y0 = q8(y0, 8.f, 0.125f); y1 = q8(y1, 8.f, 0.125f); y2 = q8(y2, 8.f, 0.125f); y3 = q8(y3, 8.f, 0.125f); }
                if (FP8_MERGE) *(LAS unsigned*)(wu + l31 * 80 + 8 * q + 4 * hi) = pk4_fp8(y0 * 8.0f, y1 * 8.0f, y2 * 8.0f, y3 * 8.0f);
                else *up = (u32x2){cvt_pk_bf16(y0, y1), cvt_pk_bf16(y2, y3)};
            }
            if (FP8_MERGE) { const u32x4 yo = *(const LAS u32x4*)(wu + (lane >> 1) * 80 + (lane & 1) * 16);
                *(u32x4*)((unsigned char*)YB + (t0 + tb * 32 + (lane >> 1)) * 512 + h * 64 + db * 32 + (lane & 1) * 16) = yo; }
            else { const u32x4 yo0 = *(const LAS u32x4*)(wu + lr * 80 + lp * 16), yo1 = *(const LAS u32x4*)(wu + (lr + 16) * 80 + lp * 16);
                *(u32x4*)(YB + gbase + h * 64) = yo0; *(u32x4*)(YB + gbase + 16 * 512 + h * 64) = yo1; }
            LDS_WAIT();
        }
        __syncthreads();
    }
}

__device__ __forceinline__ void p10_norm_router(const Params& p, const Ctx& c, const bool probe = false) {
    LAS f32x4* WR = (LAS f32x4*)c.lds;
    LAS int* RT = (LAS int*)(c.lds + 147456);
    LAS int* hist = (LAS int*)(c.lds + 147456 + 4096);
    const float* mod = (const float*)(p.ws + WS_MOD); const float* H1 = p.out; bf16_t* XN2 = (bf16_t*)(p.ws + (probe ? WS_GATES : WS_XN));
    int* rowtok = (int*)(p.ws + (probe ? WS_SLOT : WS_ROWTOK)); float* roww = (float*)(p.ws + (probe ? WS_SLOT + 32 * MiB : WS_ROWW)); unsigned* cursor = (unsigned*)(p.ws + WS_CTL) + CW_CURSOR + (probe ? 64 * 64 : 0);
    for (int idx = c.tid; idx < 16 * 9 * 64; idx += NTHREADS) { const int l = idx & 63, q = (idx >> 6) % 9, ji = idx / 576, k = 4 * l + (ji & 3) + 256 * (ji >> 2);
        WR[idx] = (q == 0) ? *(const f32x4*)(p.in[I_WRG] + k * 4) : *(const f32x4*)(p.in[I_WRE] + ((size_t)((q - 1) >> 1) * 1024 + k) * 8 + ((q - 1) & 1) * 4); }
    LAS float* BRE = (LAS float*)(c.lds + 147456 + 4096 + 512);
    if (c.tid < 64) hist[c.tid] = 0;
    if (c.tid < 32) BRE[c.tid] = p.in[I_BRE2][c.tid];
    const float brg[4] = {p.in[I_BRG][0], p.in[I_BRG][1], p.in[I_BRG][2], p.in[I_BRG][3]};
    __syncthreads();
    for (int rb = c.vcu; rb < 256; rb += c.G) {
        const int b = rb >> 3;
        f32x4 vn[2][4];
#pragma unroll
        for (int u2 = 0; u2 < 2; ++u2) { const GAS f32x4* xr0 = (const GAS f32x4*)(H1 + ((size_t)rb * 256 + c.wave * 32 + u2) * D) + c.lane;
#pragma unroll
          for (int j = 0; j < 4; ++j) vn[u2][j] = xr0[64 * j]; }
        for (int i = 0; i < 32; i += 2) {
            const LAS f32x4* WRl = WR + c.lane; asm volatile("" : "+v"(WRl));
            f32x4 v[2][4]; float rr[2];
#pragma unroll
            for (int u2 = 0; u2 < 2; ++u2) { float s = 0.f;
#pragma unroll
                for (int j = 0; j < 4; ++j) { v[u2][j] = vn[u2][j]; s += (v[u2][j].x * v[u2][j].x + v[u2][j].y * v[u2][j].y) + (v[u2][j].z * v[u2][j].z + v[u2][j].w * v[u2][j].w); }
                rr[u2] = s; }
            { const int inx = (i < 30) ? i + 2 : i;
#pragma unroll
              for (int u2 = 0; u2 < 2; ++u2) { const GAS f32x4* xrn = (const GAS f32x4*)(H1 + ((size_t)rb * 256 + c.wave * 32 + inx + u2) * D) + c.lane;
#pragma unroll
                for (int j = 0; j < 4; ++j) vn[u2][j] = xrn[64 * j]; } }
            f32x4 lg[2];
#pragma unroll
            for (int u2 = 0; u2 < 2; ++u2) { const size_t row = (size_t)rb * 256 + c.wave * 32 + i + u2;
                const float r = 1.0f / sqrtf(wave_sum(rr[u2]) * (1.0f / D) + 1e-6f);
                GAS unsigned long long* o8 = (GAS unsigned long long*)(XN2 + row * D) + c.lane;
                lg[u2] = (f32x4){0.f, 0.f, 0.f, 0.f};
#pragma unroll
                for (int j = 0; j < 4; ++j) { const int k = 4 * c.lane + 256 * j;
                    const f32x4 g_ = *(const f32x4*)(p.in[I_N2G] + k), sc_ = *(const f32x4*)(mod + b * 6144 + 4096 + k), sh_ = *(const f32x4*)(mod + b * 6144 + 3072 + k);
                    v[u2][j] = v[u2][j] * r * (g_ * (sc_ + 1.0f)) + sh_; { f32x4 y = v[u2][j]; if (Q8_MOE) { y.x = q8(y.x, 1.f, 1.f); y.y = q8(y.y, 1.f, 1.f); y.z = q8(y.z, 1.f, 1.f); y.w = q8(y.w, 1.f, 1.f); }
                      if (FP8_MOE) ((GAS unsigned*)((unsigned char*)XN2 + row * D) + c.lane)[64 * j] = pk4_fp8(y.x, y.y, y.z, y.w);
                      else o8[64 * j] = (unsigned long long)pk2(y.x, y.y) | ((unsigned long long)pk2(y.z, y.w) << 32); } } }
#pragma unroll
            for (int j = 0; j < 4; ++j) {
#pragma unroll
                for (int ii = 0; ii < 4; ++ii) { const f32x4 w = WRl[((j * 4 + ii) * 9 + 0) * 64]; lg[0] += w * v[0][j][ii]; lg[1] += w * v[1][j][ii]; }
                if (j & 1) __builtin_amdgcn_sched_barrier(0); }
            int grp[2]; float pg[2];
#pragma unroll
            for (int u2 = 0; u2 < 2; ++u2) { float l4[4];
#pragma unroll
                for (int q = 0; q < 4; ++q) l4[q] = wave_sum(lg[u2][q]) + brg[q];
                int g_ = 0; float mx = l4[0];
#pragma unroll
                for (int q = 1; q < 4; ++q) if (l4[q] > mx) { mx = l4[q]; g_ = q; }
                float se = 0.f;
#pragma unroll
                for (int q = 0; q < 4; ++q) se += __expf(l4[q] - mx);
                pg[u2] = 1.0f / se; grp[u2] = __builtin_amdgcn_readfirstlane(g_); }
            f32x4 ex0[2], ex1[2];
#pragma unroll
            for (int u2 = 0; u2 < 2; ++u2) { ex0[u2] = (f32x4){0.f, 0.f, 0.f, 0.f}; ex1[u2] = ex0[u2]; }
#pragma unroll
            for (int j = 0; j < 4; ++j) {
#pragma unroll
                for (int ii = 0; ii < 4; ++ii)
#pragma unroll
                    for (int u2 = 0; u2 < 2; ++u2) { const LAS f32x4* wp = WRl + ((j * 4 + ii) * 9 + 1 + 2 * grp[u2]) * 64; ex0[u2] += wp[0] * v[u2][j][ii]; ex1[u2] += wp[64] * v[u2][j][ii]; }
                __builtin_amdgcn_sched_barrier(0); }
#pragma unroll
            for (int u2 = 0; u2 < 2; ++u2) { const int rl = c.wave * 32 + i + u2; float le[8];
#pragma unroll
                for (int q = 0; q < 4; ++q) { le[q] = wave_sum(ex0[u2][q]) + BRE[grp[u2] * 8 + q]; le[4 + q] = wave_sum(ex1[u2][q]) + BRE[grp[u2] * 8 + 4 + q]; }
                int i0 = 0; float v0 = le[0];
#pragma unroll
                for (int q = 1; q < 8; ++q) if (le[q] > v0) { v0 = le[q]; i0 = q; }
                int i1 = -1; float v1 = -3.0e38f;
#pragma unroll
                for (int q = 0; q < 8; ++q) if (q != i0 && le[q] > v1) { v1 = le[q]; i1 = q; }
                const float ex = __expf(v1 - v0), p0 = 1.0f / (1.0f + ex), p1 = ex / (1.0f + ex);
                if (c.lane == 0) { RT[rl * 4 + 0] = grp[u2] * 8 + i0; RT[rl * 4 + 1] = grp[u2] * 8 + i1; RT[rl * 4 + 2] = (int)__float_as_uint(pg[u2] * p0); RT[rl * 4 + 3] = (int)__float_as_uint(pg[u2] * p1); } }
        }
        __syncthreads();
        int e0 = 0, e1 = 0, r0 = 0, r1 = 0;
        if (c.tid < 256) { e0 = RT[c.tid * 4]; e1 = RT[c.tid * 4 + 1]; r0 = __hip_atomic_fetch_add(&hist[e0], 1, __ATOMIC_RELAXED, __HIP_MEMORY_SCOPE_WORKGROUP); r1 = __hip_atomic_fetch_add(&hist[e1], 1, __ATOMIC_RELAXED, __HIP_MEMORY_SCOPE_WORKGROUP); }
        __syncthreads();
        if (c.tid < 32) hist[32 + c.tid] = (int)__hip_atomic_fetch_add(cursor + 64 * c.tid, (unsigned)hist[c.tid], RLX_AGENT);
        __syncthreads();
        if (c.tid < 256) { const int tok = rb * 256 + c.tid; const int p0 = hist[32 + e0] + r0, p1 = hist[32 + e1] + r1;
            rowtok[(size_t)e0 * ECAP + p0] = tok * 2; roww[(size_t)e0 * ECAP + p0] = __uint_as_float((unsigned)RT[c.tid * 4 + 2]);
            rowtok[(size_t)e1 * ECAP + p1] = tok * 2 + 1; roww[(size_t)e1 * ECAP + p1] = __uint_as_float((unsigned)RT[c.tid * 4 + 3]); }
        __syncthreads();
        if (c.tid < 32) hist[c.tid] = 0;
        __syncthreads();
    }
}

__device__ __forceinline__ void p11_router_mfma(const Params& p, const Ctx& c, const bool probe = false) {
    constexpr int TS = 1032;
    LAS bf16_t* TH = (LAS bf16_t*)c.lds; LAS bf16_t* TL = TH + 16 * TS;
    LAS float* PART = (LAS float*)(c.lds + 2 * 16 * TS * 2);
    LAS float* LGA = (LAS float*)(c.lds + 114688);
    LAS int* RT = (LAS int*)(c.lds + 147456); LAS int* hist = (LAS int*)(c.lds + 147456 + 4096);
    LAS unsigned char* wl8 = c.lds + 98304 + c.wave * 2048;
    const float* mod = (const float*)(p.ws + WS_MOD); const float* H1 = p.out; const size_t dmul = (HOT11 && probe) ? (size_t)0 : (size_t)D; const bf16_t* H1B = (const bf16_t*)(p.ws + WS_H1B); unsigned char* XN2 = p.ws + (probe ? WS_GATES : WS_XN);
    int* rowtok = (int*)(p.ws + (probe ? WS_SLOT : WS_ROWTOK)); float* roww = (float*)(p.ws + (probe ? WS_SLOT + 32 * MiB : WS_ROWW)); unsigned* cursor = (unsigned*)(p.ws + WS_CTL) + CW_CURSOR + (probe ? 64 * 256 : 0);
    const int lane = c.lane, w = c.wave, l15 = lane & 15, lq = lane >> 4;
    bf16x8 bh[4][3], bl[4][3];
#pragma unroll
    for (int ks = 0; ks < 4; ++ks)
#pragma unroll
        for (int cb = 0; cb < 3; ++cb) { const size_t o = (size_t)(cb * 16 + l15) * 1024 + 128 * w + 32 * ks + 8 * lq; bh[ks][cb] = *(const bf16x8*)((const bf16_t*)(p.ws + WS_WRH) + o); bl[ks][cb] = *(const bf16x8*)((const bf16_t*)(p.ws + WS_WRL) + o); }
    LAS float* BIAS = (LAS float*)(c.lds + 147456 + 4096 + 512);
    if (c.tid < 64) hist[c.tid] = 0;
    if (c.tid < 4) BIAS[c.tid] = p.in[I_BRG][c.tid]; else if (c.tid < 36) BIAS[c.tid] = p.in[I_BRE2][c.tid - 4];
    __syncthreads();
    for (int rb = c.vcu; rb < 256; rb += c.G) {
        const int b = rb >> 3;
        f32x4 A[4], Bc[4];
#pragma unroll
        for (int j = 0; j < 4; ++j) { const int k = 4 * lane + 256 * j; const f32x4 g_ = *(const f32x4*)(p.in[I_N2G] + k), sc_ = *(const f32x4*)(mod + b * 6144 + 4096 + k); A[j] = g_ * (sc_ + 1.0f); Bc[j] = *(const f32x4*)(mod + b * 6144 + 3072 + k); }
        f32x4 vn[2][4], vm[2][4];
#pragma unroll
        for (int u2 = 0; u2 < 2; ++u2) { const size_t r0_ = (size_t)rb * 256 + 2 * w + u2;
#pragma unroll
            for (int j = 0; j < 4; ++j) { vn[u2][j] = ((const GAS f32x4*)(H1 + r0_ * dmul) + lane)[64 * j]; vm[u2][j] = ((const GAS f32x4*)(H1 + (r0_ + 16) * dmul) + lane)[64 * j]; } }
        auto chunk = [&](const int ch, f32x4 (&vq)[2][4]) __attribute__((always_inline)) {
#pragma unroll
            for (int u2 = 0; u2 < 2; ++u2) { const int rl = 2 * w + u2; const size_t row = (size_t)rb * 256 + ch * 16 + rl;
                f32x4 v[4]; float s = 0.f;
#pragma unroll
                for (int j = 0; j < 4; ++j) { v[j] = vq[u2][j]; s += (v[j].x * v[j].x + v[j].y * v[j].y) + (v[j].z * v[j].z + v[j].w * v[j].w); }
                if (ch < 14) {
#pragma unroll
                    for (int j = 0; j < 4; ++j) vq[u2][j] = ((const GAS f32x4*)(H1 + (row + 32) * dmul) + lane)[64 * j]; }
                const float r = 1.0f / sqrtf(wave_sum(s) * (1.0f / D) + 1e-6f);
#pragma unroll
                for (int j = 0; j < 4; ++j) { const int k = 4 * lane + 256 * j;
                    const f32x4 y = v[j] * r * A[j] + Bc[j];
                    *(LAS unsigned*)(wl8 + u2 * 1024 + 4 * lane + 256 * j) = pk4_fp8(y.x, y.y, y.z, y.w);
                    const unsigned h0 = cvt_pk_bf16(y.x, y.y), h1 = cvt_pk_bf16(y.z, y.w);
                    const unsigned l0 = cvt_pk_bf16(y.x - bf_lo(h0), y.y - bf_hi(h0)), l1 = cvt_pk_bf16(y.z - bf_lo(h1), y.w - bf_hi(h1));
                    *(LAS u32x2*)(TH + rl * TS + k) = (u32x2){h0, h1}; *(LAS u32x2*)(TL + rl * TS + k) = (u32x2){l0, l1}; }
            }
            LDS_WAIT();
#pragma unroll
            for (int u2 = 0; u2 < 2; ++u2) ((GAS u32x4*)(XN2 + ((size_t)rb * 256 + ch * 16 + 2 * w + u2) * D))[lane] = *(const LAS u32x4*)(wl8 + u2 * 1024 + 16 * lane);
            __syncthreads();
            f32x4 acc[3];
#pragma unroll
            for (int cb = 0; cb < 3; ++cb) acc[cb] = (f32x4){0.f, 0.f, 0.f, 0.f};
#pragma unroll
            for (int ks = 0; ks < 4; ++ks) { const int ko = l15 * TS + 128 * w + 32 * ks + 8 * lq;
                const bf16x8 ah = *(const LAS bf16x8*)(TH + ko), al = *(const LAS bf16x8*)(TL + ko);
#pragma unroll
                for (int cb = 0; cb < 3; ++cb) { acc[cb] = __builtin_amdgcn_mfma_f32_16x16x32_bf16(ah, bh[ks][cb], acc[cb], 0, 0, 0); acc[cb] = __builtin_amdgcn_mfma_f32_16x16x32_bf16(ah, bl[ks][cb], acc[cb], 0, 0, 0); acc[cb] = __builtin_amdgcn_mfma_f32_16x16x32_bf16(al, bh[ks][cb], acc[cb], 0, 0, 0); } }
#pragma unroll
            for (int cb = 0; cb < 3; ++cb)
#pragma unroll
                for (int q = 0; q < 4; ++q) PART[(w * 16 + lq * 4 + q) * 48 + cb * 16 + l15] = acc[cb][q];
            __syncthreads();
            for (int o = c.tid; o < 768; o += NTHREADS) { const int rr_ = o / 48, cc_ = o - rr_ * 48; float sacc = 0.f;
#pragma unroll
                for (int ww = 0; ww < 8; ++ww) sacc += PART[ww * 768 + o];
                if (cc_ < 36) LGA[(ch * 16 + rr_) * 36 + cc_] = sacc; }
        };
        for (int ch = 0; ch < 16; ch += 2) { chunk(ch, vn); chunk(ch + 1, vm); }
        __syncthreads();
        float rw0 = 0.f, rw1 = 0.f; int re0 = 0, re1 = 0;
        if (c.tid < 256) { const LAS float* lgp = LGA + c.tid * 36; float l4[4];
#pragma unroll
            for (int q = 0; q < 4; ++q) l4[q] = lgp[q] + BIAS[q];
            int grp = 0; float mx = l4[0];
#pragma unroll
            for (int q = 1; q < 4; ++q) if (l4[q] > mx) { mx = l4[q]; grp = q; }
            float se = 0.f;
#pragma unroll
            for (int q = 0; q < 4; ++q) se += __expf(l4[q] - mx);
            const float pg = 1.0f / se;
            float le[8];
#pragma unroll
            for (int q = 0; q < 8; ++q) le[q] = lgp[4 + grp * 8 + q] + BIAS[4 + grp * 8 + q];
            int i0 = 0; float v0 = le[0];
#pragma unroll
            for (int q = 1; q < 8; ++q) if (le[q] > v0) { v0 = le[q]; i0 = q; }
            int i1 = -1; float v1 = -3.0e38f;
#pragma unroll
            for (int q = 0; q < 8; ++q) if (q != i0 && le[q] > v1) { v1 = le[q]; i1 = q; }
            const float ex = __expf(v1 - v0), p0 = 1.0f / (1.0f + ex), p1 = ex / (1.0f + ex);
            re0 = grp * 8 + i0; re1 = grp * 8 + i1; rw0 = pg * p0; rw1 = pg * p1; }
        __syncthreads();
        if (c.tid < 256) { RT[c.tid * 4 + 0] = re0; RT[c.tid * 4 + 1] = re1; RT[c.tid * 4 + 2] = (int)__float_as_uint(rw0); RT[c.tid * 4 + 3] = (int)__float_as_uint(rw1); }
        __syncthreads();
        int e0 = 0, e1 = 0, r0 = 0, r1 = 0;
        if (c.tid < 256) { e0 = RT[c.tid * 4]; e1 = RT[c.tid * 4 + 1]; r0 = __hip_atomic_fetch_add(&hist[e0], 1, __ATOMIC_RELAXED, __HIP_MEMORY_SCOPE_WORKGROUP); r1 = __hip_atomic_fetch_add(&hist[e1], 1, __ATOMIC_RELAXED, __HIP_MEMORY_SCOPE_WORKGROUP); }
        __syncthreads();
        const int seg = rb & 3;
        if (c.tid < 32) hist[32 + c.tid] = seg * (ECAP / 4) + (int)__hip_atomic_fetch_add(cursor + 64 * (c.tid * 4 + seg), (unsigned)hist[c.tid], RLX_AGENT);
        __syncthreads();
        if (c.tid < 256) { const int tok = rb * 256 + c.tid; const int q0 = hist[32 + e0] + r0, q1 = hist[32 + e1] + r1;
            rowtok[(size_t)e0 * ECAP + q0] = tok * 2; roww[(size_t)e0 * ECAP + q0] = __uint_as_float((unsigned)RT[c.tid * 4 + 2]);
            rowtok[(size_t)e1 * ECAP + q1] = tok * 2 + 1; roww[(size_t)e1 * ECAP + q1] = __uint_as_float((unsigned)RT[c.tid * 4 + 3]); }
        __syncthreads();
        if (c.tid < 32) hist[c.tid] = 0;
        __syncthreads();
    }
}

__device__ __forceinline__ void p14_final(const Params& p, const Ctx& c, float* dst = nullptr) {
    const float* mod = (const float*)(p.ws + WS_MOD); const unsigned char* SLOT8 = (const unsigned char*)(p.ws + WS_SLOT); const float* out = p.out; float* wout = dst ? dst : p.out;
    static_assert(FP8_SLOT == 1 && H1_BF16 == 0, "p14_final: fp8 slots, f32 h1");
    LAS unsigned char* wl = c.lds + c.wave * 4096;
    for (int rb = c.vcu; rb < 256; rb += c.G) {
        const int b = rb >> 3;
        f32x4 gt[4], gf[4];
#pragma unroll
        for (int j = 0; j < 4; ++j) { const int k = 4 * c.lane + 256 * j; gt[j] = *(const f32x4*)(mod + b * 6144 + 5120 + k) * (1.0f / 16.0f); gf[j] = *(const f32x4*)(p.in[I_NFG] + k); }
        auto ld = [&](const size_t row, f32x4 (&hv)[2][4], u32x4 (&sl)[2][2]) __attribute__((always_inline)) {
#pragma unroll
            for (int q = 0; q < 2; ++q) { const GAS f32x4* xr = (const GAS f32x4*)(out + (row + q) * D) + c.lane;
#pragma unroll
                for (int j = 0; j < 4; ++j) hv[q][j] = xr[64 * j];
                sl[q][0] = ((const GAS u32x4*)(SLOT8 + ((row + q) * 2) * D))[c.lane]; sl[q][1] = ((const GAS u32x4*)(SLOT8 + ((row + q) * 2 + 1) * D))[c.lane]; }
        };
        auto proc = [&](const size_t row, f32x4 (&hv)[2][4], u32x4 (&sl)[2][2]) __attribute__((always_inline)) {
#pragma unroll
            for (int q = 0; q < 2; ++q) { *(LAS u32x4*)(wl + (q * 2) * 1024 + 16 * c.lane) = sl[q][0]; *(LAS u32x4*)(wl + (q * 2 + 1) * 1024 + 16 * c.lane) = sl[q][1]; }
            LDS_WAIT();
#pragma unroll
            for (int q = 0; q < 2; ++q) { float s = 0.f; f32x4 v[4];
#pragma unroll
                for (int j = 0; j < 4; ++j) { const int sa = *(const LAS int*)(wl + (q * 2) * 1024 + 4 * c.lane + 256 * j), sb = *(const LAS int*)(wl + (q * 2 + 1) * 1024 + 4 * c.lane + 256 * j);
                    const f32x2 a0 = __builtin_amdgcn_cvt_pk_f32_fp8(sa, false), a1 = __builtin_amdgcn_cvt_pk_f32_fp8(sa, true), b0 = __builtin_amdgcn_cvt_pk_f32_fp8(sb, false), b1 = __builtin_amdgcn_cvt_pk_f32_fp8(sb, true);
                    const f32x4 y = (f32x4){a0.x + b0.x, a0.y + b0.y, a1.x + b1.x, a1.y + b1.y};
                    v[j] = hv[q][j] + gt[j] * y; s += (v[j].x * v[j].x + v[j].y * v[j].y) + (v[j].z * v[j].z + v[j].w * v[j].w); }
                const float r = 1.0f / sqrtf(wave_sum(s) * (1.0f / D) + 1e-6f);
                GAS f32x4* xo = (GAS f32x4*)(wout + (row + q) * D) + c.lane;
#pragma unroll
                for (int j = 0; j < 4; ++j) xo[64 * j] = v[j] * r * gf[j]; }
            LDS_WAIT();
        };
        const size_t row0 = (size_t)rb * 256 + c.wave * 32;
        f32x4 hA[2][4], hB[2][4]; u32x4 sA[2][2], sB[2][2];
        ld(row0, hA, sA);
        for (int i = 0; i < 32; i += 4) {
            ld(row0 + i + 2, hB, sB);
            proc(row0 + i, hA, sA);
            if (i + 4 < 32) ld(row0 + i + 4, hA, sA);
            proc(row0 + i + 2, hB, sB);
        }
    }
}
}
namespace fx {
constexpr int N_PHASES = 15;
struct KArgs { Params p; int region, pad; };
__global__ void __launch_bounds__(NTHREADS, 2) fwd(KArgs ka) {
    extern __shared__ __attribute__((aligned(16))) unsigned char lds_[];
    const Params& p = ka.p;
    Ctx c0; c0.lds = (LAS unsigned char*)lds_; c0.wave = __builtin_amdgcn_readfirstlane((int)threadIdx.x >> 6); c0.lane = 0; c0.tid = 0;
    c0.G = gridDim.x; { const int bx = blockIdx.x; c0.vcu = (c0.G % 8 == 0) ? (bx % 8) * (c0.G / 8) + bx / 8 : bx; }
#define CTX Ctx c = c0; c.lane = mg::lane_id(); c.tid = c.wave * 64 + c.lane;
    CTX
    volatile LAS unsigned* MISC = (volatile LAS unsigned*)(c.lds + MISC_OFF);
    if (c.tid < 64) MISC[c.tid] = 0u;
    __syncthreads();
    unsigned* ctl = (unsigned*)(p.ws + WS_CTL);
    const int lo = p.ph_lo, hi = p.ph_hi;
    XcdBarrier bar; bar.bar = ctl + CW_BAR + ka.region * XCD_BAR_WORDS; bar.x = 0; bar.st = nullptr; bar.wave = c0.wave;
    if (hi - lo > 1) bar = xcd_barrier_post(ctl + CW_BAR + ka.region * XCD_BAR_WORDS, MISC + 8, c0.wave);
#ifndef PHASE_MASK
#define PHASE_MASK 0x7fff
#endif
#define IN(k) ((((PHASE_MASK) >> (k)) & 1) && lo <= (k) && (k) < hi)
#ifndef REPEAT_MASK
#define REPEAT_MASK 0
#endif
#ifndef REPEAT_N
#define REPEAT_N 1
#endif

#ifdef TSTAMP
#define STAMP(k) do { if (blockIdx.x == 0 && c.tid == 0) ((unsigned long long*)(p.ws + (size_t)972 * MiB))[(k)] = __builtin_amdgcn_s_memrealtime(); } while (0)
#else
#define STAMP(k) do { } while (0)
#endif
#define SEAM(k) do { if (IN(k) && IN((k) + 1)) xcd_barrier(bar); STAMP((k) + 1); } while (0)
    LAS unsigned char* ring = c0.lds;
    const int G = c0.G, bx = (int)blockIdx.x;
    const char* ws = (const char*)p.ws;
#ifndef SPLIT_P0
#define SPLIT_P0 0
#endif
#if SPLIT_P0
#define PH0 { CTX p0_prologue<1>(p, c); }
#else
#define PH0 { CTX p0_prologue<3>(p, c); }
#endif
#define PH0B { CTX p0_prologue<P0_PARTS>(p, c); }
#if SPLIT_P0
#define PH1 { CTX p1_xn<4>(p, c); p0_prologue<2>(p, c); }
#else
#define PH1 { CTX p1_xn<8>(p, c); }
#endif
#if MERGE_ONE
#define E1G_EXTRA , (bf16_t*)(p.ws + WS_GATES) + TILED2_HALF
#else
#define E1G_EXTRA
#endif
#ifndef LATE_GATES
#define LATE_GATES 0
#endif
#if FP8_GATES
#define PH2A { CTX LAS float* bgl = (LAS float*)(c.lds + XT_OFF); (void)bgl; \
        { SchedStd<true> S{ws + WS_XN, ws + WS_W1T, 1024, 1024, 256, 6, 16, G, bx}; \
          Epi1 E{(bf16_t*)(p.ws + WS_ZA), (bf16_t*)(p.ws + WS_U), (bf16_t*)(p.ws + WS_GV), (bf16_t*)(p.ws + WS_GATES), bgl}; \
          mg::gemm_phase<Epi1, SchedStd<true>, false, true>(c.wave, ring, S, E, 128, 128); } }
#define PH2B { CTX LAS float* bgl = (LAS float*)(c.lds + XT_OFF); for (int q_ = c.tid; q_ < 2048; q_ += NTHREADS) bgl[q_] = p.in[I_BGATE][q_]; __syncthreads(); \
        { SchedStd8<true> S{(const char*)p.out, ws + WS_WG8, 1024, 1024, 256, 8, 8, G, bx}; Epi1g E{(bf16_t*)(p.ws + WS_GATES), bgl E1G_EXTRA}; \
          mg::gemm_phase<Epi1g, SchedStd8<true>, false, true, true>(c.wave, ring, S, E, 128, 128, 127, 122); } }
#if LATE_GATES
#define PH2 PH2A
#define PH6X PH2B
#else
#define PH2 { PH2A PH2B }
#define PH6X { }
#endif
#else
#define PH2 { CTX LAS float* bgl = (LAS float*)(c.lds + XT_OFF); for (int q_ = c.tid; q_ < 2048; q_ += NTHREADS) bgl[q_] = p.in[I_BGATE][q_]; __syncthreads(); \
        SchedStd<true> S{ws + WS_XN, ws + WS_W1T, 1024, 1024, 256, 14, 16, G, bx}; \
        Epi1 E{(bf16_t*)(p.ws + WS_ZA), (bf16_t*)(p.ws + WS_U), (bf16_t*)(p.ws + WS_GV), (bf16_t*)(p.ws + WS_GATES), bgl}; \
        mg::gemm_phase<Epi1, SchedStd<true>, false, true>(c.wave, ring, S, E, 128, 128); }
#endif
#define PH2N { CTX { SchedStd<true> S{ws + WS_XN, ws + WS_W1T, 1024, 1024, 256, 6, 16, G, bx}; EpiNull E{}; mg::gemm_phase<EpiNull, SchedStd<true>, false, true>(c.wave, ring, S, E, 128, 128); } \
        { SchedStd8<true> S{(const char*)p.out, ws + WS_WG8, 1024, 1024, 256, 8, 8, G, bx}; EpiNull E{}; mg::gemm_phase<EpiNull, SchedStd8<true>, false, true, true>(c.wave, ring, S, E, 128, 128, 127, 122); } }
#define PH8N { CTX SchedStd<true> S{ws + WS_YA, ws + WS_WBAT, 512, 512, 256, 4, 8, G, bx}; EpiNull E{}; mg::gemm_phase<EpiNull, SchedStd<true>, false, true>(c.wave, ring, S, E, 128, 128); }
#define PH10N { CTX SchedStd8<true> S{ws + WS_MERGED, ws + WS_WOUTT, 1024, 1024, 256, 4, 8, G, bx}; EpiNull E{}; mg::gemm_phase<EpiNull, SchedStd8<true>, false, true, true>(c.wave, ring, S, E, 128, 128, 125, 122); }
#define PH12N { CTX const MoeTab mt = moe_table(p, c); SchedUp S{ws + WS_XN, ws + WS_WUPT, (const int*)(p.ws + WS_ROWTOK), mt, G, bx, (const float*)(p.ws + WS_ROWW)}; EpiNull E{}; mg::gemm_phase<EpiNull, SchedUp, true, true, FP8_MOE>(c.wave, ring, S, E, 128, 128, 127, 122); }
#define PH12M { CTX const MoeTab mt = moe_table(p, c); SchedUp S{ws + WS_XN, ws + WS_WUPT, (const int*)(p.ws + WS_ROWTOK), mt, G, bx, (const float*)(p.ws + WS_ROWW)}; EpiUpMath E{(const float*)(p.ws + WS_ROWW), mt}; mg::gemm_phase<EpiUpMath, SchedUp, true, true, FP8_MOE>(c.wave, ring, S, E, 128, 128, 127, 122); }
#ifndef NOEPI_MASK
#define NOEPI_MASK 0
#endif
#ifndef STAG10
#define STAG10 0
#endif
#ifndef STAG8
#define STAG8 0
#endif
#ifndef STAG2
#define STAG2 0
#endif
#define STAGGER(us) do { if ((us) > 0 && (c0.vcu & 1)) { const unsigned long long t0_ = __builtin_amdgcn_s_memrealtime(); while (__builtin_amdgcn_s_memrealtime() - t0_ < (unsigned long long)(us) * 100ull) __builtin_amdgcn_s_sleep(8); } } while (0)
#define PH3 { CTX SchedS5a S{ws + WS_ZA, ws + WS_TZ, ws + WS_WS, G, c.vcu}; EpiS5a E{(bf16_t*)(p.ws + WS_YI), (float*)(p.ws + WS_SST)}; \
        mg::gemm_phase<EpiS5a, SchedS5a, false, true>(c.wave, ring, S, E, 128, 128); }
#define PH4 { CTX p4_scan(p, c); }
#define PH5 { CTX SchedS5b S{ws + WS_HP, ws + WS_WO, G, bx}; EpiS5b E{(const bf16_t*)(p.ws + WS_YI), (bf16_t*)(p.ws + WS_YG)}; \
        mg::gemm_phase<EpiS5b, SchedS5b, false, true>(c.wave, ring, S, E, 128, 128); }
#define PH6 { CTX SchedGlu S{ws + WS_YG, ws + WS_WGLUT, G, bx}; EpiGlu E{(const bf16_t*)(p.ws + WS_YG), (bf16_t*)(p.ws + WS_YA), p.in[I_BGLU]}; \
        mg::gemm_phase<EpiGlu, SchedGlu, false, true, false, false>(c.wave, ring, S, E, (size_t)8388608, 128); }
#define PH7 { CTX p7_sgu(p, c); }
#define PH8 { CTX SchedStd<true> S{ws + WS_YA, ws + WS_WBAT, 512, 512, 256, 4, 8, G, bx}; EpiMerge<0> E{(const bf16_t*)(p.ws + WS_GATES), (bf16_t*)(p.ws + WS_P1), (bf16_t*)(p.ws + WS_MERGED)}; \
        mg::gemm_phase<EpiMerge<0>, SchedStd<true>, false, true>(c.wave, ring, S, E, 128, 128); }
#define PH9 { CTX SchedStd<true> S{ws + WS_YB, ws + WS_WBBT, 512, 512, 256, 4, 8, G, bx}; EpiMerge<1> E{(const bf16_t*)(p.ws + WS_GATES), (bf16_t*)(p.ws + WS_P1), (bf16_t*)(p.ws + WS_MERGED)}; \
        mg::gemm_phase<EpiMerge<1>, SchedStd<true>, false, true>(c.wave, ring, S, E, 128, 128); }
#if FP8_OUT
#define PH89 { CTX SchedMerge S{ws + WS_YA, ws + WS_YB, ws + WS_WBAT, ws + WS_WBBT, G, bx}; EpiMergeOne E{(const bf16_t*)(p.ws + WS_GATES), (bf16_t*)(p.ws + WS_MERGED)}; \
        mg::gemm_phase<EpiMergeOne, SchedMerge, false, true, (FP8_MERGE != 0)>(c.wave, ring, S, E, 128, 128, FP8_MERGE ? 124 : 127, FP8_MERGE ? 123 : 127); }
#if H1_BF16
#define PH10 { CTX SchedStd8<true> S{ws + WS_MERGED, ws + WS_WOUTT, 1024, 1024, 256, 4, 8, G, bx}; EpiOutB E{p.in[I_X], (const float*)(p.ws + WS_MOD), (bf16_t*)(p.ws + WS_H1B)}; \
        mg::gemm_phase<EpiOutB, SchedStd8<true>, false, true, true>(c.wave, ring, S, E, 128, 128, 125, 122); }
#else
#define PH10 { CTX SchedStd8<false> S{ws + WS_MERGED, ws + WS_WOUTT, 1024, 1024, 256, 4, 8, G, bx}; EpiOut E{p.in[I_X], (const float*)(p.ws + WS_MOD), p.out}; \
        mg::gemm_phase<EpiOut, SchedStd8<false>, false, true, true>(c.wave, ring, S, E, 128, 128, 125, 122); }
#endif
#else
#define PH10 { CTX SchedStd<false> S{ws + WS_MERGED, ws + WS_WOUTT, 1024, 1024, 256, 4, 16, G, bx}; EpiOut E{p.in[I_X], (const float*)(p.ws + WS_MOD), p.out}; \
        mg::gemm_phase<EpiOut, SchedStd<false>, false, true>(c.wave, ring, S, E, 128, 128); }
#endif
#ifndef ROUTER_MFMA
#define ROUTER_MFMA 1
#endif
#if ROUTER_MFMA
#define PH11 { CTX p11_router_mfma(p, c); }
#else
#define PH11 { CTX p10_norm_router(p, c); }
#endif
#define PH12 { CTX const MoeTab mt = moe_table(p, c); SchedUp S{ws + WS_XN, ws + WS_WUPT, (const int*)(p.ws + WS_ROWTOK), mt, G, bx, (const float*)(p.ws + WS_ROWW)}; EpiUp E{(bf16_t*)(p.ws + WS_HID), (const float*)(p.ws + WS_ROWW), mt}; \
        mg::gemm_phase<EpiUp, SchedUp, true, true, FP8_MOE>(c.wave, ring, S, E, 128, 128, 127, 122); }
#define PH13 { CTX const MoeTab mt = moe_table(p, c); SchedDn S{ws + WS_HID, ws + WS_WDNT, mt, G, bx, (const int*)(p.ws + WS_ROWTOK)}; EpiDn E{(bf16_t*)(p.ws + WS_SLOT), (const int*)(p.ws + WS_ROWTOK), mt}; \
        mg::gemm_phase<EpiDn, SchedDn, false, true, FP8_MOE>(c.wave, ring, S, E, 128, 128, 124, 123); }
#define PH14 { CTX p14_final(p, c); }
#define RUN(k, BODY) do { if (IN((k) & 15)) { BODY if constexpr (((REPEAT_MASK) >> (k)) & 1) { xcd_barrier(bar); BODY } } } while (0)
    const bool one = (hi - lo > 1);
#define GBAR do { if (one) xcd_barrier(bar); } while (0)
    do { if (IN(0)) { PH0 if constexpr ((REPEAT_MASK) & 1) { xcd_barrier(bar); PH0B } } } while (0); GBAR;
    RUN(1, PH1); GBAR;
    if constexpr ((NOEPI_MASK >> 2) & 1) { PH2N xcd_barrier(bar); }
    STAGGER(STAG2); RUN(2, PH2); GBAR;
    RUN(3, PH3); GBAR;
    RUN(4, PH4); if (one) { RUN(7, PH7); } GBAR;
    RUN(5, PH5); GBAR;
    RUN(6, PH6); if (IN(6)) { PH6X } GBAR;
    if (!one) { RUN(7, PH7); }
#if MERGE_ONE
    RUN(8, PH89); GBAR;
#else
    if constexpr ((NOEPI_MASK >> 8) & 1) { PH8N xcd_barrier(bar); }
    STAGGER(STAG8); RUN(8, PH8);
    if (one) { asm volatile("s_waitcnt vmcnt(0)" ::: "memory"); __syncthreads();
        if (c0.wave == 0 && mg::lane_id() == 0) { __builtin_amdgcn_fence(__ATOMIC_ACQUIRE, "agent"); asm volatile("s_waitcnt vmcnt(0)" ::: "memory"); }
        __syncthreads(); }
    RUN(9, PH9); GBAR;
#endif
    if constexpr ((NOEPI_MASK >> 10) & 1) { PH10N xcd_barrier(bar); }
    STAGGER(STAG10); RUN(10, PH10); GBAR;
    if constexpr (((REPEAT_MASK) >> 11) & 1) { if (IN(11)) { { CTX if (ROUTER_MFMA) p11_router_mfma(p, c, true); else p10_norm_router(p, c, true); } xcd_barrier(bar); } }
    RUN(11 + 16, PH11); GBAR;
    if constexpr ((NOEPI_MASK >> 12) & 1) { PH12N xcd_barrier(bar); }
    if constexpr ((NOEPI_MASK >> 20) & 1) { PH12M xcd_barrier(bar); }
    RUN(12, PH12); GBAR;
    RUN(13, PH13); GBAR;
    if constexpr (((REPEAT_MASK) >> 14) & 1) { if (IN(14)) { { CTX p14_final(p, c, (float*)(p.ws + WS_GATES)); } xcd_barrier(bar); } }
    RUN(14 + 16, PH14);
#undef IN
#undef SEAM
}
static int g_grid = 0;
static bool fast_setup() {
    if (g_grid != 0) return g_grid > 0;
    int dev = 0, cus = 0, per_cu = 0;
    if (hipGetDevice(&dev) != hipSuccess || hipDeviceGetAttribute(&cus, hipDeviceAttributeMultiprocessorCount, dev) != hipSuccess) { g_grid = -1; return false; }
    if (hipFuncSetAttribute((const void*)fwd, hipFuncAttributeMaxDynamicSharedMemorySize, LDS_BYTES) != hipSuccess) { fprintf(stderr, "hipFuncSetAttribute failed\n"); g_grid = -1; return false; }
    if (hipOccupancyMaxActiveBlocksPerMultiprocessor(&per_cu, (const void*)fwd, NTHREADS, LDS_BYTES) != hipSuccess || per_cu < 1) fprintf(stderr, "occupancy query: %d\n", per_cu);
    (void)hipGetLastError();
    g_grid = cus;
    return true;
}
static void fast_forward(void* const* d_in, float* out, unsigned char* ws, hipStream_t st, int lo, int hi, bool split, int region) {
    if (!fast_setup()) return;
    KArgs a{};
    for (int i = 0; i < 34; ++i) a.p.in[i] = (const float*)d_in[i];
    a.p.out = out; a.p.ws = ws; a.region = region; a.pad = 0;
    if (split) { for (int k = lo; k < hi; ++k) { a.p.ph_lo = k; a.p.ph_hi = k + 1; hipLaunchKernelGGL(fwd, dim3(g_grid), dim3(NTHREADS), LDS_BYTES, st, a); } }
    else { a.p.ph_lo = lo; a.p.ph_hi = hi; hipLaunchKernelGGL(fwd, dim3(g_grid), dim3(NTHREADS), LDS_BYTES, st, a); }
}
}
extern "C" void kernel_launch(void* const* d_in, const int* in_sizes, int n_in, void* d_out, int out_size, void* d_ws, size_t ws_size, hipStream_t stream) {
    (void)in_sizes; (void)n_in; (void)out_size; (void)ws_size;
    (void)hipMemsetAsync((char*)d_ws + fx::WS_CTL, 0, fx::CTL_ZERO_BYTES, stream);
    fx::fast_forward(d_in, (float*)d_out, (unsigned char*)d_ws, stream, 0, fx::N_PHASES, FAST_SPLIT, 0);
}
```

```cpp
#include <hip/hip_runtime.h>
#include <cstdint>
#include <cstdio>
#define FAST_SPLIT false
namespace mg {
#define MG_LAS __attribute__((address_space(3)))
typedef unsigned short bf16_t;
typedef short bf16x8 __attribute__((ext_vector_type(8)));
typedef float f32x4 __attribute__((ext_vector_type(4)));
typedef float f32x2 __attribute__((ext_vector_type(2)));
typedef unsigned u32x4 __attribute__((ext_vector_type(4)));
typedef unsigned u32x2 __attribute__((ext_vector_type(2)));
typedef int i32x8 __attribute__((ext_vector_type(8)));
typedef int i32x4 __attribute__((ext_vector_type(4)));
template <bool C, class A, class B> struct cond_t { typedef A type; };
template <class A, class B> struct cond_t<false, A, B> { typedef B type; };
constexpr int BM = 256, BK = 64, HALF = 128, HTB = HALF * BK * 2, STAGE_BYTES = 8 * HTB;

template <int SW = 5> __host__ __device__ __forceinline__ int lds_byte(int r, int c) { const int st = (r >> 4) * 2 + (c >> 5), rr = r & 15, cc = c & 31, ob = rr * 64 + cc * 2; return st * 1024 + (ob ^ (((ob >> 9) & 1) << SW)); }
template <int SW = 5> __host__ __device__ __forceinline__ void stage_rc(int b, int& R, int& C) { const int st = b / 1024, sb = b % 1024, swz = sb ^ (((sb >> 9) & 1) << SW); R = (st >> 1) * 16 + swz / 64; C = (st & 1) * 32 + (swz % 64) / 2; }
template <class S_, class = void> struct vconst_t { static constexpr bool v = false; };
template <class S_> struct vconst_t<S_, decltype((void)S_::VOFF_CONST)> { static constexpr bool v = S_::VOFF_CONST; };
template <class S_, class = void> struct lists_t { static constexpr bool v = false; };
template <class S_> struct lists_t<S_, decltype((void)S_::LISTS)> { static constexpr bool v = S_::LISTS; };
template <class S_, class = void> struct swz8_t { static constexpr int v = 5; };
template <class S_> struct swz8_t<S_, decltype((void)S_::SWZ8)> { static constexpr int v = S_::SWZ8; };
__host__ __device__ __forceinline__ int perm32(int rho) { const int n = rho >> 4, i = rho & 15; return 8 * (i >> 2) + 4 * n + (i & 3); }

constexpr int KEEP_ACC = 1 << 30;
struct Unit { const char* A0; const char* A1; const char* B0; const char* B1; int nt, pm, pn, aux; };

__device__ __forceinline__ unsigned cvt_pk_bf16(float lo, float hi) { unsigned r; asm volatile("v_cvt_pk_bf16_f32 %0, %1, %2" : "=v"(r) : "v"(lo), "v"(hi)); return r; }
__device__ __forceinline__ float bf_lo(unsigned w) { return __uint_as_float(w << 16); }
__device__ __forceinline__ float bf_hi(unsigned w) { return __uint_as_float(w & 0xffff0000u); }
__device__ __forceinline__ float fsigmoid(float x) { return __builtin_amdgcn_rcpf(1.0f + __builtin_amdgcn_exp2f(-1.4426950408889634f * x)); }
__device__ __forceinline__ float q8(float x, float s, float is) { const int v = __builtin_amdgcn_cvt_pk_fp8_f32(x * s, 0.f, 0, false); return __builtin_amdgcn_cvt_f32_fp8(v, 0) * is; }
__device__ __forceinline__ float fsilu(float x) { return x * fsigmoid(x); }
__device__ __forceinline__ float fgelu(float x) { const float u = x * (1.5957691216057308f + 0.07135481627260025f * x * x); return x * fsigmoid(u); }

__device__ __forceinline__ f32x4 mfma_bf16(const bf16x8& a, const bf16x8& b, const f32x4& c) { return __builtin_amdgcn_mfma_f32_16x16x32_bf16(a, b, c, 0, 0, 0); }
__device__ __forceinline__ f32x4 mfma_bf16(const i32x8&, const i32x8&, const f32x4& c) { return c; }
#define st16(p, ...) (*(u32x4*)(p) = (__VA_ARGS__))
#define st16f(p, ...) (*(f32x4*)(p) = (__VA_ARGS__))
#define st8(p, ...) (*(u32x2*)(p) = (__VA_ARGS__))
__device__ __forceinline__ int lane_id() { int l; asm volatile("v_mbcnt_lo_u32_b32 %0, -1, 0\n\tv_mbcnt_hi_u32_b32 %0, -1, %0" : "=v"(l)); return l; }
template <class Epi, class Sched, bool GATHER, bool ALIGN_EPI, bool FP8 = false, bool KA128 = true>
__device__ __forceinline__ void gemm_phase(const int wid, MG_LAS unsigned char* lds, const Sched& S, const Epi& E, const size_t kstepA, const size_t kstepB, const int sclA = 127, const int sclB = 127) {
    const int lane = lane_id(), tid = wid * 64 + lane, wr = wid >> 2, wc = wid & 3, fr = lane & 15, fq = lane >> 4;
    constexpr int NH = GATHER ? 2 : 1, H1 = GATHER ? 1 : 0;
    unsigned vA[NH][2], vB[2];
    const unsigned ldsw = (unsigned)wid * 1024u;
#ifndef DMA_AUX
#define DMA_AUX 0
#endif
#define MG_SA(b, h) (((b) * 2 + (h)) * HTB)
#define MG_SB(b, h) ((4 + (b) * 2 + (h)) * HTB)
#define MG_STAGE(bufoff, gbase, voff, IMM) do { _Pragma("unroll") for (int _i = 0; _i < 2; ++_i) { unsigned vo_ = (voff)[_i]; asm volatile("" : "+v"(vo_));     \
        __builtin_amdgcn_global_load_lds((const unsigned*)((const char*)(gbase) + vo_), (MG_LAS unsigned*)(lds + (bufoff) + ldsw + _i * 8192 - (IMM)), 16, IMM, DMA_AUX); } } while (0)
#define MG_STAGE_AK(bufoff, gbase, voff) do { if constexpr (KA128) MG_STAGE(bufoff, gbase, voff, 128); else MG_STAGE(bufoff, (gbase) + kstepA, voff, 0); } while (0)
#define MG_STAGE_BK(bufoff, gbase, voff) MG_STAGE(bufoff, gbase, voff, 128)
#define MG_LDA(dst, b, h) do { if constexpr (FP8) { _Pragma("unroll") for (int m = 0; m < 4; ++m) { const i32x4 lo_ = *(const MG_LAS i32x4*)(pA + MG_SA(b, h) + m * 2048), hi_ = *(const MG_LAS i32x4*)(((SW == 4) ? pAx : pA + 16) + MG_SA(b, h) + m * 2048); dst[m][0] = __builtin_shufflevector(lo_, hi_, 0, 1, 2, 3, 4, 5, 6, 7); } } \
        else { _Pragma("unroll") for (int m = 0; m < 4; ++m) _Pragma("unroll") for (int k = 0; k < 2; ++k) dst[m][k] = *(const MG_LAS FragT*)(pA + MG_SA(b, h) + m * 2048 + k * 1024); } } while (0)
#define MG_LDB(dst, b, h) do { if constexpr (FP8) { _Pragma("unroll") for (int n = 0; n < 2; ++n) { const i32x4 lo_ = *(const MG_LAS i32x4*)(pB + (MG_SB(b, h) - 4 * HTB) + n * 2048), hi_ = *(const MG_LAS i32x4*)(((SW == 4) ? pBx : pB + 16) + (MG_SB(b, h) - 4 * HTB) + n * 2048); dst[n][0] = __builtin_shufflevector(lo_, hi_, 0, 1, 2, 3, 4, 5, 6, 7); } } \
        else { _Pragma("unroll") for (int n = 0; n < 2; ++n) _Pragma("unroll") for (int k = 0; k < 2; ++k) dst[n][k] = *(const MG_LAS FragT*)(pB + (MG_SB(b, h) - 4 * HTB) + n * 2048 + k * 1024); } } while (0)
#define MG_MMA(ai, bj, At, Bt) do { __builtin_amdgcn_s_setprio(1); _Pragma("unroll") for (int m = 0; m < 4; ++m) _Pragma("unroll") for (int n = 0; n < 2; ++n) { \
        if constexpr (FP8) acc[ai][bj][m][n] = __builtin_amdgcn_mfma_scale_f32_16x16x128_f8f6f4(Bt[n][0], At[m][0], acc[ai][bj][m][n], 0, 0, 0, sclB, 0, sclA); \
        else { _Pragma("unroll") for (int k = 0; k < 2; ++k) acc[ai][bj][m][n] = mfma_bf16(Bt[n][k], At[m][k], acc[ai][bj][m][n]); } } __builtin_amdgcn_s_setprio(0); } while (0)
#define MG_WAIT_V(n) asm volatile("s_waitcnt vmcnt(" #n ")" ::: "memory")
#define MG_WAIT_L(n) asm volatile("s_waitcnt lgkmcnt(" #n ")" ::: "memory")
#define MG_BAR __builtin_amdgcn_s_barrier()
#define MG_SCHED __builtin_amdgcn_sched_barrier(0)
    Unit cur, nxt; int ui = 0;
    if (!S.next(0, cur)) return;
    if constexpr (lists_t<Sched>::v) { S.list_dma(cur, wid, lane_id()); asm volatile("s_waitcnt vmcnt(0)" ::: "memory"); __builtin_amdgcn_s_barrier(); asm volatile("" ::: "memory"); }
    typename Epi::Pre pre;
    f32x4 acc[2][2][4][2];
#pragma unroll
    for (int a = 0; a < 2; ++a)
#pragma unroll
        for (int b = 0; b < 2; ++b)
#pragma unroll
            for (int m = 0; m < 4; ++m)
#pragma unroll
                for (int n = 0; n < 2; ++n) acc[a][b][m][n] = (f32x4){0.f, 0.f, 0.f, 0.f};
    typedef typename cond_t<FP8, i32x8, bf16x8>::type FragT; constexpr int NK = FP8 ? 1 : 2;
    FragT At[4][NK], B0[2][NK], B1[2][NK];
    S.voff(cur, tid, vA, vB);
    MG_STAGE(MG_SB(0, 0), cur.B0, vB, 0); MG_STAGE(MG_SB(0, 1), cur.B1, vB, 0); MG_STAGE(MG_SA(0, 0), cur.A0, vA[0], 0); MG_STAGE(MG_SA(0, 1), cur.A1, vA[H1], 0);
    if (wr == 1) MG_BAR;
    MG_WAIT_V(2); MG_BAR;
    MG_STAGE_BK(MG_SB(1, 0), cur.B0, vB); MG_STAGE_AK(MG_SA(1, 0), cur.A0, vA[0]); MG_STAGE_BK(MG_SB(1, 1), cur.B1, vB);
    MG_WAIT_V(6); MG_BAR;
    constexpr int SW = FP8 ? swz8_t<Sched>::v : 5;
    const int l2_ = lane_id(), fr2_ = l2_ & 15, fq2_ = l2_ >> 4;
    const int aoff = lds_byte<SW>(wr * 64 + fr2_, FP8 ? fq2_ * 16 : fq2_ * 8), boff = lds_byte<SW>(wc * 32 + fr2_, FP8 ? fq2_ * 16 : fq2_ * 8);
    const MG_LAS unsigned char* pA = lds + aoff; const MG_LAS unsigned char* pB = lds + 4 * HTB + boff;
    const MG_LAS unsigned char* pAx = lds + ((SW == 4) ? (aoff ^ 16) : aoff + 16); const MG_LAS unsigned char* pBx = lds + 4 * HTB + ((SW == 4) ? (boff ^ 16) : boff + 16);
    asm volatile("" : "+v"(pA), "+v"(pB)); if constexpr (FP8 && SW == 4) asm volatile("" : "+v"(pAx), "+v"(pBx)); (void)pAx; (void)pBx;
    for (;;) {
        const bool has_next = S.next(ui + 1, nxt);
        if constexpr (lists_t<Sched>::v) { if (has_next) S.list_dma(nxt, wid, lane_id()); }
        if (!has_next) nxt = cur;
        const int nt = cur.nt;
        for (int t = 0; t < nt; t += 2) {
            const bool last = (t == nt - 2);
            const char* a1h = cur.A1 + (size_t)t * kstepA;
            const char* a20 = last ? nxt.A0 : cur.A0 + (size_t)(t + 2) * kstepA; const char* a21 = last ? nxt.A1 : cur.A1 + (size_t)(t + 2) * kstepA;
            const char* b20 = last ? nxt.B0 : cur.B0 + (size_t)(t + 2) * kstepB; const char* b21 = last ? nxt.B1 : cur.B1 + (size_t)(t + 2) * kstepB;
            MG_LDB(B0, 0, 0); MG_LDB(B1, 0, 1); MG_SCHED; MG_LDA(At, 0, 0); MG_STAGE_AK(MG_SA(1, 1), a1h, vA[H1]);
            if constexpr (!vconst_t<Sched>::v) { if (last && has_next) S.voff(nxt, tid, vA, vB); }
            MG_WAIT_V(8); MG_WAIT_L(0); MG_BAR; MG_MMA(0, 0, At, B0); MG_MMA(0, 1, At, B1); MG_BAR; MG_SCHED;
            MG_LDA(At, 0, 1); MG_STAGE(MG_SB(0, 0), b20, vB, 0); MG_STAGE(MG_SB(0, 1), b21, vB, 0); MG_STAGE(MG_SA(0, 0), a20, vA[0], 0);
            MG_WAIT_V(8); MG_WAIT_L(0); MG_BAR; MG_MMA(1, 0, At, B0); MG_MMA(1, 1, At, B1); MG_BAR; MG_SCHED;
            MG_LDB(B0, 1, 0); MG_LDB(B1, 1, 1); MG_SCHED; MG_LDA(At, 1, 0); MG_STAGE(MG_SA(0, 1), a21, vA[H1], 0);
            MG_WAIT_V(8); MG_WAIT_L(0); MG_BAR; MG_MMA(0, 0, At, B0); MG_MMA(0, 1, At, B1); MG_BAR; MG_SCHED;
            MG_LDA(At, 1, 1); MG_STAGE_BK(MG_SB(1, 0), b20, vB); MG_STAGE_BK(MG_SB(1, 1), b21, vB); MG_STAGE_AK(MG_SA(1, 0), a20, vA[0]);
            MG_WAIT_V(8); MG_WAIT_L(0); MG_BAR; MG_MMA(1, 0, At, B0); MG_MMA(1, 1, At, B1); MG_BAR; MG_SCHED;
        }
        if constexpr (ALIGN_EPI) { if (wr == 0) MG_BAR; }
        { const int l_ = lane_id(); int fr_ = l_ & 15, fq_ = l_ >> 4; asm volatile("" : "+v"(fr_), "+v"(fq_));
          E.prefetch(pre, cur, wr, wc, fr_, fq_);
          E(acc, cur, wr, wc, fr_, fq_, pre); }
        if (!has_next) break;
        if (!(cur.aux & KEEP_ACC)) {
#pragma unroll
        for (int a = 0; a < 2; ++a)
#pragma unroll
            for (int b = 0; b < 2; ++b)
#pragma unroll
                for (int m = 0; m < 4; ++m)
#pragma unroll
                    for (int n = 0; n < 2; ++n) acc[a][b][m][n] = (f32x4){0.f, 0.f, 0.f, 0.f};
        }
        cur = nxt; ++ui;
        if constexpr (ALIGN_EPI) { if (wr == 1) MG_BAR; }
    }
    MG_WAIT_V(0);
    if constexpr (!ALIGN_EPI) { if (wr == 0) MG_BAR; }
    MG_BAR;
#undef MG_SA
#undef MG_SB
#undef MG_STAGE
#undef MG_STAGE_AK
#undef MG_STAGE_BK
#undef MG_LDA
#undef MG_LDB
#undef MG_MMA
#undef MG_WAIT_V
#undef MG_WAIT_L
#undef MG_BAR
#undef MG_SCHED
}
template <bool PERM>
__device__ __forceinline__ void std_voff(int tid, int lda, int ldb, unsigned (&va)[1][2], unsigned (&vb)[2]) {
#pragma unroll
    for (int i = 0; i < 2; ++i) { int R, C; stage_rc(tid * 16 + i * 8192, R, C); const int Rb = PERM ? ((R & ~31) + perm32(R & 31)) : R;
        va[0][i] = (unsigned)(R * lda + C) * 2u; vb[i] = (unsigned)(Rb * ldb + C) * 2u; }
}
template <bool PERM, int SW = 5>
__device__ __forceinline__ void std_voff8(int tid, int ldaB, int ldbB, unsigned (&va)[1][2], unsigned (&vb)[2]) {
#pragma unroll
    for (int i = 0; i < 2; ++i) { int R, C; stage_rc<SW>(tid * 16 + i * 8192, R, C); const int Rb = PERM ? ((R & ~31) + perm32(R & 31)) : R;
        va[0][i] = (unsigned)(R * ldaB + C * 2); vb[i] = (unsigned)(Rb * ldbB + C * 2); }
}
__device__ __forceinline__ unsigned pk4_fp8(float a, float b, float c, float d) { int w = __builtin_amdgcn_cvt_pk_fp8_f32(a, b, 0, false); w = __builtin_amdgcn_cvt_pk_fp8_f32(c, d, w, true); return (unsigned)w; }
__device__ __forceinline__ bool static_tile(int i, int G, int c, int nM, int nN, int& pm, int& pn) {
    const int nwg = nM * nN; const long L = (long)i * G + c; if (L >= nwg) return false;
    int wgid = (int)L; { const int q = nwg / 8, r = nwg % 8, xcd = wgid % 8, off = wgid / 8; wgid = (xcd < r ? xcd * (q + 1) : r * (q + 1) + (xcd - r) * q) + off; }
    const int nig = 8 * nN, gid = wgid / nig, fm = gid * 8, gsz = (nM - fm) < 8 ? (nM - fm) : 8;
    pm = fm + ((wgid % nig) % gsz); pn = (wgid % nig) / gsz; return true;
}
}
namespace fx {
using mg::bf16_t; using mg::bf16x8; using mg::f32x4; using mg::f32x2; using mg::u32x4; using mg::u32x2; using mg::Unit;
#define GAS __attribute__((address_space(1)))
#define LAS __attribute__((address_space(3)))
typedef GAS unsigned gu32;
#define RLX_AGENT __ATOMIC_RELAXED, __HIP_MEMORY_SCOPE_AGENT
#define LDS_WAIT() asm volatile("s_waitcnt lgkmcnt(0)" ::: "memory")
#define VM_WAIT() asm volatile("s_waitcnt vmcnt(0)" ::: "memory")
constexpr int NWAVES = 8, NTHREADS = 512;
constexpr int T = 65536, D = 1024, SEQ = 2048, NB = 32;
constexpr int ECAP = 131072;
constexpr size_t MiB = 1u << 20;
constexpr size_t WS_CTL = 0, CTL_ZERO_BYTES = 384 * 1024;
constexpr size_t WS_MOD = 1 * MiB;
constexpr size_t WS_SGUW = 2 * MiB;
constexpr size_t WS_AL = 2 * MiB + 512 * 1024;
constexpr size_t WS_WRH = 3 * MiB, WS_WRL = 3 * MiB + 128 * 1024;
constexpr size_t WS_TZ = 4 * MiB;
constexpr size_t WS_WS = 6 * MiB;
constexpr size_t WS_WO = 14 * MiB;
constexpr size_t WS_W1T = 30 * MiB;
constexpr size_t WS_WGLUT = 37 * MiB;
constexpr size_t WS_WBAT = 38 * MiB, WS_WBBT = 39 * MiB;
constexpr size_t WS_WOUTT = 40 * MiB;
constexpr size_t WS_WUPT = 42 * MiB;
constexpr size_t WS_WDNT = 106 * MiB;
constexpr size_t WS_ROWTOK = 139 * MiB;
constexpr size_t WS_ROWW = 155 * MiB;
constexpr size_t WS_XN = 172 * MiB;
constexpr size_t WS_GATES = 300 * MiB;
constexpr size_t WS_ZA = 556 * MiB;
constexpr size_t WS_YG = WS_ZA;
constexpr size_t WS_U = 620 * MiB, WS_GV = 684 * MiB;
constexpr size_t WS_YI = 748 * MiB;
constexpr size_t WS_SST = 812 * MiB;
constexpr size_t WS_HP = 828 * MiB;
constexpr size_t WS_YA = 844 * MiB, WS_YB = 908 * MiB;
constexpr size_t WS_P1 = 620 * MiB;
constexpr size_t WS_MERGED = 748 * MiB;
constexpr size_t WS_HID = 300 * MiB;
constexpr size_t WS_SLOT = 556 * MiB;
constexpr size_t WS_H1B = 844 * MiB;
constexpr size_t WS_END = 972 * MiB;
constexpr size_t WS_WG8 = 972 * MiB;
constexpr int CW_TMO = 0, CW_P0CTR = 1024, CW_MODRDY = 2048, CW_BAR = 4096, CW_CURSOR = 65536;
constexpr int RING_BYTES = 131072;
constexpr int LDS_BYTES = 163840;
constexpr int MISC_OFF = LDS_BYTES - 256;
constexpr int XT_OFF = RING_BYTES;

__device__ __forceinline__ unsigned f2bf(float f) { unsigned u = __builtin_bit_cast(unsigned, f); return (u + 0x7fffu + ((u >> 16) & 1u)) >> 16; }
__device__ __forceinline__ unsigned pk2(float lo, float hi) { return f2bf(lo) | (f2bf(hi) << 16); }
__device__ __forceinline__ float wave_sum(float v) {
    v += __builtin_bit_cast(float, __builtin_amdgcn_update_dpp(0, __builtin_bit_cast(int, v), 0xB1, 0xf, 0xf, false));
    v += __builtin_bit_cast(float, __builtin_amdgcn_update_dpp(0, __builtin_bit_cast(int, v), 0x4E, 0xf, 0xf, false));
    v += __builtin_bit_cast(float, __builtin_amdgcn_update_dpp(0, __builtin_bit_cast(int, v), 0x141, 0xf, 0xf, false));
    v += __builtin_bit_cast(float, __builtin_amdgcn_update_dpp(0, __builtin_bit_cast(int, v), 0x140, 0xf, 0xf, false));
    const int iv = __builtin_bit_cast(int, v);
    const float r0 = __builtin_bit_cast(float, __builtin_amdgcn_readlane(iv, 0)), r1 = __builtin_bit_cast(float, __builtin_amdgcn_readlane(iv, 16)),
                r2 = __builtin_bit_cast(float, __builtin_amdgcn_readlane(iv, 32)), r3 = __builtin_bit_cast(float, __builtin_amdgcn_readlane(iv, 48));
    return (r0 + r1) + (r2 + r3);
}
#define XB_TMO      128
#define XB_XCNT(j)  (256  + 64 * (j))
#define XB_XSUB(j)  (1280 + 64 * (j))
#define XB_XGEN(j)  (2304 + 64 * (j))
#define XB_TOP      3328
#define XB_TOPGEN   3392
#define XCD_BAR_WORDS 3456
#define XB_SPIN_CAP (1u << 18)
__device__ __forceinline__ unsigned xb_ld(unsigned* p)              { return __hip_atomic_load(p, __ATOMIC_RELAXED, __HIP_MEMORY_SCOPE_AGENT); }
__device__ __forceinline__ unsigned xb_add(unsigned* p, unsigned v) { return __hip_atomic_fetch_add(p, v, __ATOMIC_RELAXED, __HIP_MEMORY_SCOPE_AGENT); }
__device__ __forceinline__ unsigned xb_xcc_id() { return (unsigned)__builtin_amdgcn_s_getreg((3 << 11) | 20) & 0xFu; }
#define XB_SPIN(cond, bar) do { unsigned _sp = 0; while (cond) { __builtin_amdgcn_s_sleep(1); \
    if ((++_sp & 255u) == 0u) { if (xb_ld(&(bar)[XB_TMO])) break; if (_sp > XB_SPIN_CAP) { atomicAdd(&(bar)[XB_TMO], 1u); break; } } } } while (0)
struct XcdBarrier { unsigned* bar; unsigned x; volatile LAS unsigned* st; int wave; };
__device__ __forceinline__ XcdBarrier xcd_barrier_post(unsigned* bar, volatile LAS unsigned* st, int wave) {
    XcdBarrier b; b.bar = bar; b.x = xb_xcc_id(); b.st = st; b.wave = wave;
    if (wave == 0 && mg::lane_id() == 0) (void)xb_add(&bar[XB_XCNT(b.x)], 1u);
    return b;
}
__device__ __forceinline__ void xcd_barrier_complete(unsigned* bar, unsigned x, unsigned& nloc, unsigned& nx) {
    const unsigned G = gridDim.x * gridDim.y * gridDim.z;
    unsigned sum, cnt, mine, sp = 0u;
    for (;;) {
        sum = 0u; cnt = 0u; mine = 0u;
#pragma unroll
        for (unsigned j = 0; j < 16; ++j) { const unsigned c = xb_ld(&bar[XB_XCNT(j)]); sum += c; cnt += (c > 0u) ? 1u : 0u; mine = (j == x) ? c : mine; }
        if (sum == G) break;
        __builtin_amdgcn_s_sleep(1);
        if ((++sp & 255u) == 0u) { if (xb_ld(&bar[XB_TMO])) break; if (sp > XB_SPIN_CAP) { atomicAdd(&bar[XB_TMO], 1u); break; } }
    }
    nloc = mine > 0u ? mine : 1u; nx = cnt > 0u ? cnt : 1u;
}
#ifndef DIRECT_REL
#define DIRECT_REL 1
#endif
#ifndef EARLY_INV
#define EARLY_INV 1
#endif
__device__ __forceinline__ void xcd_barrier(const XcdBarrier& b) {
    asm volatile("s_waitcnt vmcnt(0)" ::: "memory");
    __syncthreads();
    if (b.wave == 0 && mg::lane_id() == 0) {
        unsigned* bar = b.bar;
        __builtin_amdgcn_s_waitcnt(0);
        unsigned nloc = b.st[0], nx = b.st[1];
        if (nloc == 0u) { xcd_barrier_complete(bar, b.x, nloc, nx); b.st[0] = nloc; b.st[1] = nx; }
#if EARLY_INV
        unsigned old; { unsigned* pa_ = &bar[XB_XSUB(b.x)]; const unsigned one_ = 1u;
            asm volatile("global_atomic_add %0, %1, %2, off sc0\n\tbuffer_inv sc1\n\ts_waitcnt vmcnt(1)" : "=&v"(old) : "v"(pa_), "v"(one_) : "memory"); }
#else
        const unsigned old = xb_add(&bar[XB_XSUB(b.x)], 1u);
#endif
        const unsigned gen = old / nloc;
        if (old + 1u == (gen + 1u) * nloc) {
            __builtin_amdgcn_fence(__ATOMIC_RELEASE, "agent");
            asm volatile("s_waitcnt vmcnt(0)" ::: "memory");
            const unsigned og = xb_add(&bar[XB_TOP], 1u);
            const unsigned tg = og / nx;
#if DIRECT_REL
            if (og + 1u == (tg + 1u) * nx) {
#pragma unroll
                for (unsigned j = 0; j < 16; ++j) xb_add(&bar[XB_XGEN((b.x + j) & 15u)], 1u); }
            else { XB_SPIN(xb_ld(&bar[XB_XGEN(b.x)]) == gen, bar); asm volatile("s_waitcnt vmcnt(0)" ::: "memory"); }
            asm volatile("" ::: "memory");
#else
            if (og + 1u == (tg + 1u) * nx) xb_add(&bar[XB_TOPGEN], 1u);
            else XB_SPIN(xb_ld(&bar[XB_TOPGEN]) == tg, bar);
            if (!EARLY_INV) __builtin_amdgcn_fence(__ATOMIC_ACQUIRE, "agent"); else asm volatile("" ::: "memory");
            xb_add(&bar[XB_XGEN(b.x)], 1u);
#endif
            if (!DIRECT_REL) asm volatile("s_waitcnt vmcnt(0)" ::: "memory");
        } else {
            XB_SPIN(xb_ld(&bar[XB_XGEN(b.x)]) == gen, bar);
            if (!EARLY_INV) __builtin_amdgcn_fence(__ATOMIC_ACQUIRE, "agent"); else asm volatile("" ::: "memory");
            asm volatile("s_waitcnt vmcnt(0)" ::: "memory");
        }
    }
    __syncthreads();
}

struct Params { const float* in[34]; float* out; unsigned char* ws; int ph_lo, ph_hi; };
enum { I_X = 0, I_C, I_WADA, I_BADA, I_N1G, I_WIN, I_WGATE, I_BGATE, I_ARE, I_AIM, I_BRE, I_BIM, I_CRE, I_CIM, I_DSK, I_LSTEP, I_WGLU, I_BGLU, I_LNG, I_LNB,
       I_SGUW, I_SGUB, I_WBA, I_WBB, I_WOUT, I_N2G, I_WRG, I_BRG, I_WRE, I_BRE2, I_W1, I_W3, I_W2, I_NFG };
}
namespace fx {
#ifndef Q8_P2
#define Q8_P2 0
#endif
#ifndef Q8_P10
#define Q8_P10 0
#endif
#ifndef Q8_MOE
#define Q8_MOE 0
#endif
#ifndef Q8_P8
#define Q8_P8 0
#endif
#ifndef HOT11
#define HOT11 0
#endif
#ifndef SWZ_GATE
#define SWZ_GATE 4
#endif
#ifndef SWZ_OUT
#define SWZ_OUT 4
#endif
#ifndef SWZ_UP
#define SWZ_UP 4
#endif
#ifndef SWZ_DN
#define SWZ_DN 4
#endif
#ifndef GATE8
#define GATE8 1
#endif
#ifndef NT_LD
#define NT_LD 1
#endif
#define NTLD(p_) (NT_LD ? __builtin_nontemporal_load(p_) : *(p_))
#ifndef FUSE45
#define FUSE45 1
#endif
#ifndef FP8_S5A
#define FP8_S5A 1
#endif
__device__ __forceinline__ int s5_ks(float log_step) { const int k = (int)floorf(6.0f - log_step * 1.4426950408889634f); return k < 0 ? 0 : (k > 24 ? 24 : k); }
#ifndef ZA_FP8GEMM
#define ZA_FP8GEMM 1
#endif
#ifndef DELTA_H1
#define DELTA_H1 1
#endif
#ifndef FP8_MERGE
#define FP8_MERGE 1
#endif
#ifndef FP8_MOE
#define FP8_MOE 1
#endif
#ifndef FP8_OUT
#define FP8_OUT 1
#endif
#ifndef MERGE_ONE
#define MERGE_ONE 1
#endif
#ifndef H1_BF16
#define H1_BF16 0
#endif
#ifndef TILED_GATES
#define TILED_GATES 1
#endif
#ifndef FP8_SLOT
#define FP8_SLOT 1
#endif
#ifndef FP8_GATES
#define FP8_GATES 1
#endif
using mg::q8; using mg::pk4_fp8; using mg::cvt_pk_bf16; using mg::fsigmoid; using mg::fsilu; using mg::fgelu; using mg::bf_lo; using mg::bf_hi;
struct Ctx { LAS unsigned char* lds; int tid, lane, wave, vcu, G; };

__device__ __forceinline__ u32x4 pack8(const f32x4& a, const f32x4& b) { u32x4 w; w.x = cvt_pk_bf16(a[0], a[1]); w.y = cvt_pk_bf16(a[2], a[3]); w.z = cvt_pk_bf16(b[0], b[1]); w.w = cvt_pk_bf16(b[2], b[3]); return w; }
#ifndef WIDE8
#define WIDE8 1
#endif
__device__ __forceinline__ u32x4 widen8(const u32x2 a, const u32x2 b) {
    const auto r0 = __builtin_amdgcn_permlane16_swap(a.x, b.x, false, false); const auto r1 = __builtin_amdgcn_permlane16_swap(a.y, b.y, false, false);
    return (u32x4){r0[0], r1[0], r0[1], r1[1]}; }
__device__ __forceinline__ void unpack8(const u32x4& w, f32x4& a, f32x4& b) { a = (f32x4){bf_lo(w.x), bf_hi(w.x), bf_lo(w.y), bf_hi(w.y)}; b = (f32x4){bf_lo(w.z), bf_hi(w.z), bf_lo(w.w), bf_hi(w.w)}; }

struct TItem { const float* W; bf16_t* WT; int K, N, dest_row0, k0, n0; float qs; int fp8; };
__device__ __forceinline__ void titem_load(const TItem& t, int lane, float (&tv)[32]) {
#pragma unroll
    for (int i = 0; i < 8; ++i) { const f32x4 v = NTLD((const f32x4*)(t.W + (size_t)(t.k0 + 8 * i + (lane >> 3)) * t.N + t.n0 + 4 * (lane & 7))); tv[4 * i] = v[0]; tv[4 * i + 1] = v[1]; tv[4 * i + 2] = v[2]; tv[4 * i + 3] = v[3]; }
}
__device__ __forceinline__ void titem_finish(const TItem& t, int lane, const float (&tv)[32], LAS float* scr) {
#pragma unroll
    for (int i = 0; i < 8; ++i)
#pragma unroll
        for (int e = 0; e < 4; ++e) scr[(8 * i + (lane >> 3)) * 33 + 4 * (lane & 7) + e] = (t.qs > 0.f && !t.fp8) ? q8(tv[4 * i + e], t.qs, 1.0f / t.qs) : tv[4 * i + e];
    LDS_WAIT(); asm volatile("" ::: "memory");
    if (t.fp8) {
        const int c4 = lane & 3; const float q = t.qs;
#pragma unroll
        for (int j = 0; j < 2; ++j) { const int n = (lane >> 2) + 16 * j; const LAS float* sp = scr + (16 * c4) * 33 + n;
            u32x4 o; o.x = pk4_fp8(sp[0 * 33] * q, sp[1 * 33] * q, sp[2 * 33] * q, sp[3 * 33] * q); o.y = pk4_fp8(sp[4 * 33] * q, sp[5 * 33] * q, sp[6 * 33] * q, sp[7 * 33] * q);
            o.z = pk4_fp8(sp[8 * 33] * q, sp[9 * 33] * q, sp[10 * 33] * q, sp[11 * 33] * q); o.w = pk4_fp8(sp[12 * 33] * q, sp[13 * 33] * q, sp[14 * 33] * q, sp[15 * 33] * q);
            *(GAS u32x4*)((unsigned char*)t.WT + (size_t)(t.dest_row0 + n) * t.K + t.k0 + 16 * c4) = o; }
    } else {
        const int c = lane & 7;
#pragma unroll
    for (int j = 0; j < 4; ++j) { const int n = (lane >> 3) + 8 * j; const LAS float* sp = scr + (8 * c) * 33 + n;
        u32x4 o; o.x = cvt_pk_bf16(sp[0 * 33], sp[1 * 33]); o.y = cvt_pk_bf16(sp[2 * 33], sp[3 * 33]); o.z = cvt_pk_bf16(sp[4 * 33], sp[5 * 33]); o.w = cvt_pk_bf16(sp[6 * 33], sp[7 * 33]);
        *(GAS u32x4*)(t.WT + (size_t)(t.dest_row0 + n) * t.K + t.k0 + 8 * c) = o; }
    }
    LDS_WAIT(); asm volatile("" ::: "memory");
}
__device__ __forceinline__ void p0_s5_tables(const Params& p, const Ctx& c, int g, int part) {
    typedef float f2 __attribute__((ext_vector_type(2)));
    LAS f2* P = (LAS f2*)c.lds;
    LAS f2* BT = P + 64 * 66;
    LAS f2* CC = BT + 1024;
    LAS f2* FF = CC + 1024;
    const int tid = c.tid;
    LAS double* TR = (LAS double*)(c.lds + 61440);
    if (tid < 192) { const int n = tid & 63, wq = tid >> 6;
        const double lr = fmin((double)p.in[I_ARE][g * 64 + n], -1e-4), li = (double)p.in[I_AIM][g * 64 + n], dt = exp((double)p.in[I_LSTEP][g]);
        TR[wq * 64 + n] = (wq == 0) ? exp(lr * dt) : (wq == 1 ? cos(li * dt) : sin(li * dt)); }
    __syncthreads();
    if (tid < 64) { const int n = tid;
        const double lr = fmin((double)p.in[I_ARE][g * 64 + n], -1e-4), li = (double)p.in[I_AIM][g * 64 + n];
        const double mag = TR[n], abr = mag * TR[64 + n], abi = mag * TR[128 + n], den = lr * lr + li * li, nr = abr - 1.0;
        FF[n] = (f2){(float)((nr * lr + abi * li) / den), (float)((abi * lr - nr * li) / den)};
        double pr = 1.0, pi = 0.0;
        for (int tau = 0; tau <= 64; ++tau) { P[n * 66 + tau] = (f2){(float)pr, (float)pi}; const double qr = pr * abr - pi * abi, qi = pr * abi + pi * abr; pr = qr; pi = qi; } }
    __syncthreads();
    for (int idx = tid; idx < 1024; idx += 512) {
        { const int n = idx >> 4, h = idx & 15; const f2 f = FF[n]; const float br = p.in[I_BRE][(g * 64 + n) * 16 + h], bi = p.in[I_BIM][(g * 64 + n) * 16 + h];
          BT[n * 16 + h] = (f2){f.x * br - f.y * bi, f.x * bi + f.y * br}; }
        { const int h = idx >> 6, n = idx & 63; CC[h * 64 + n] = (f2){p.in[I_CRE][(g * 16 + h) * 64 + n], p.in[I_CIM][(g * 16 + h) * 64 + n]}; }
    }
    __syncthreads();
    if (part == 0 && tid < 64) ((f2*)(p.ws + WS_AL))[g * 64 + tid] = P[tid * 66 + 64];
    bf16_t* TZ = (bf16_t*)(p.ws + WS_TZ); bf16_t* WSg = (bf16_t*)(p.ws + WS_WS); bf16_t* WOg = (bf16_t*)(p.ws + WS_WO);
    { const int pr = tid & 63, h = 4 * part + (pr >> 4), hp = pr & 15, to = tid >> 6;
      float acc[8];
#pragma unroll
      for (int i = 0; i < 8; ++i) acc[i] = 0.f;
      for (int n = 0; n < 64; ++n) {
          const f2 cc = CC[h * 64 + n], bb = BT[n * 16 + hp]; const float cbr = cc.x * bb.x - cc.y * bb.y, cbi = cc.x * bb.y + cc.y * bb.x;
#pragma unroll
          for (int i = 0; i < 8; ++i) { const f2 pw = P[n * 66 + 8 * to + i]; acc[i] += cbr * pw.x - cbi * pw.y; }
      }
      const float dk = p.in[I_DSK][g * 16 + h];
      if (FP8_S5A) {
          LAS unsigned char* tl = c.lds + 65536 + ((size_t)(pr >> 4) * 128) * 16 + hp;
#pragma unroll
          for (int i = 0; i < 8; ++i) { const int tau = 8 * to + i; float v = acc[i]; if (tau == 0 && h == hp) v += dk; tl[(63 + tau) * 16] = (unsigned char)(__builtin_amdgcn_cvt_pk_fp8_f32(v * 64.0f, 0.f, 0, false) & 0xff);
              if (tau < 63) tl[tau * 16] = 0; }
          if (to == 7) tl[127 * 16] = 0;
          __syncthreads();
          ((u32x4*)((unsigned char*)TZ + (size_t)(g * 16 + 4 * part) * 2048))[tid] = ((const LAS u32x4*)(c.lds + 65536))[tid];
      }
      else { bf16_t* tz = TZ + ((size_t)(g * 16 + h) * 128) * 16 + hp;
#pragma unroll
      for (int i = 0; i < 8; ++i) { const int tau = 8 * to + i; float v = acc[i]; if (tau == 0 && h == hp) v += dk; tz[(63 + tau) * 16] = (bf16_t)f2bf(v);
          if (tau < 63) tz[tau * 16] = 0; }
      if (to == 7) tz[127 * 16] = 0; }
    }
    for (int r = 0; r < 8; ++r) { const int gi = tid + 512 * r, row = 32 * part + (gi >> 7), k8 = (gi & 127) * 8, n = row & 63, im = row >> 6, sp = k8 >> 4, hp0 = k8 & 15;
        const f2 pw = P[n * 66 + sp]; float v[8];
#pragma unroll
        for (int e = 0; e < 8; ++e) { const f2 bb = BT[n * 16 + hp0 + e]; v[e] = im ? (pw.x * bb.y + pw.y * bb.x) : (pw.x * bb.x - pw.y * bb.y); }
        if (FP8_S5A) { const float wsc = __builtin_amdgcn_ldexpf(1.0f, s5_ks(p.in[I_LSTEP][g]));
            *(u32x2*)((unsigned char*)WSg + ((size_t)g * 128 + row) * 1024 + k8) = (u32x2){pk4_fp8(v[0] * wsc, v[1] * wsc, v[2] * wsc, v[3] * wsc), pk4_fp8(v[4] * wsc, v[5] * wsc, v[6] * wsc, v[7] * wsc)}; }
        else *(u32x4*)(WSg + ((size_t)g * 128 + row) * 1024 + k8) = (u32x4){cvt_pk_bf16(v[0], v[1]), cvt_pk_bf16(v[2], v[3]), cvt_pk_bf16(v[4], v[5]), cvt_pk_bf16(v[6], v[7])}; }
    for (int r = 0; r < 8; ++r) { const int gi = tid + 512 * r, row = 256 * part + (gi >> 4), k8 = (gi & 15) * 8, t = row >> 4, h = row & 15; float v[8];
#pragma unroll
        for (int e = 0; e < 8; ++e) { const int n = (k8 & 63) + e; const f2 cc = CC[h * 64 + n], pw = P[n * 66 + t + 1]; v[e] = (k8 < 64) ? (cc.x * pw.x - cc.y * pw.y) : -(cc.x * pw.y + cc.y * pw.x); }
        *(u32x4*)(WOg + ((size_t)g * 1024 + row) * 128 + k8) = (u32x4){cvt_pk_bf16(v[0], v[1]), cvt_pk_bf16(v[2], v[3]), cvt_pk_bf16(v[4], v[5]), cvt_pk_bf16(v[6], v[7])}; }
    __syncthreads();
}
#ifndef P0P1_HANDOFF
#define P0P1_HANDOFF 1
#endif
__device__ __forceinline__ void p0_mod(const Params& p, const Ctx& c) {
    if (c.vcu >= 96) return;
    typedef float f32x16 __attribute__((ext_vector_type(16)));
    LAS float* cs = (LAS float*)c.lds;
    for (int idx = c.tid; idx < 32768; idx += 512) { const int k = idx >> 5, b = idx & 31; cs[idx] = fsilu(p.in[I_C][b * 1024 + k]); }
    __syncthreads();
    const float* w_ada = p.in[I_WADA];
    const int ch = c.wave & 1, kq = c.wave >> 1, l31 = c.lane & 31, lh = c.lane >> 5;
    for (int cb = c.vcu; cb < 96; cb += c.G) {
        f32x16 acc;
#pragma unroll
        for (int i = 0; i < 16; ++i) acc[i] = 0.f;
        const float* wp = w_ada + (size_t)(256 * kq + lh) * 6144 + cb * 64 + ch * 32 + l31;
        const LAS float* ap = cs + (256 * kq + lh) * 32 + l31;
        for (int kc = 0; kc < 128; kc += 32) {
            float bv[32];
#pragma unroll
            for (int i = 0; i < 32; ++i) bv[i] = NTLD(wp + (size_t)(2 * (kc + i)) * 6144);
#pragma unroll
            for (int i = 0; i < 32; ++i) acc = __builtin_amdgcn_mfma_f32_32x32x2f32(ap[(2 * (kc + i)) * 32], bv[i], acc, 0, 0, 0);
        }
        __syncthreads();
        LAS float* red = (LAS float*)c.lds;
#pragma unroll
        for (int i = 0; i < 16; ++i) red[(kq * 32 + (i & 3) + 8 * (i >> 2) + 4 * lh) * 64 + ch * 32 + l31] = acc[i];
        __syncthreads();
        for (int o = c.tid; o < 2048; o += 512) { const int b = o >> 6, l = o & 63; float sacc = p.in[I_BADA][cb * 64 + l];
#pragma unroll
            for (int w = 0; w < 4; ++w) sacc += red[(w * 32 + b) * 64 + l];
            ((float*)(p.ws + WS_MOD))[b * 6144 + cb * 64 + l] = sacc; }
        if (P0P1_HANDOFF) asm volatile("s_waitcnt vmcnt(0)" ::: "memory");
        __syncthreads();
        if (P0P1_HANDOFF && c.tid == 0) { __builtin_amdgcn_fence(__ATOMIC_RELEASE, "agent"); asm volatile("s_waitcnt vmcnt(0)" ::: "memory");
            (void)__hip_atomic_fetch_add((unsigned*)(p.ws + WS_CTL) + CW_MODRDY, 1u, __ATOMIC_RELAXED, __HIP_MEMORY_SCOPE_AGENT); }
        if (cb + c.G < 96) { for (int idx = c.tid; idx < 32768; idx += 512) { const int k = idx >> 5, b = idx & 31; cs[idx] = fsilu(p.in[I_C][b * 1024 + k]); } __syncthreads(); }
    }
}
#ifndef P0_PARTS
#define P0_PARTS 3
#endif
template <int PARTS>
__device__ __forceinline__ void p0_prologue(const Params& p, const Ctx& c) {
    if (PARTS & 1) {
    p0_mod(p, c);
    if (c.vcu >= c.G - 128) { const int q_ = c.G - 1 - c.vcu; p0_s5_tables(p, c, q_ >> 2, q_ & 3); }
    }
    if (PARTS & 1) {
      bf16_t* wh = (bf16_t*)(p.ws + WS_WRH); bf16_t* wl = (bf16_t*)(p.ws + WS_WRL);
      for (int idx = c.vcu * NTHREADS + c.tid; idx < 48 * 1024; idx += c.G * NTHREADS) { const int o = idx >> 10, k = idx & 1023;
          const float w = (o < 4) ? p.in[I_WRG][k * 4 + o] : (o < 36 ? p.in[I_WRE][((size_t)((o - 4) >> 3) * 1024 + k) * 8 + ((o - 4) & 7)] : 0.f);
          const unsigned hb = f2bf(w); const float hf = __uint_as_float(hb << 16); wh[idx] = (bf16_t)hb; wl[idx] = (bf16_t)f2bf(w - hf); } }
    if (PARTS & 1) {
      bf16_t* sw = (bf16_t*)(p.ws + WS_SGUW);
      for (int idx = c.vcu * NTHREADS + c.tid; idx < 8 * 128 * 128; idx += c.G * NTHREADS) { const int tt = (idx >> 7) & 127, ss = idx & 127; sw[idx] = (ss <= tt) ? (bf16_t)f2bf(p.in[I_SGUW][idx]) : (bf16_t)0; } }
    if (!(PARTS & 2)) return;
    constexpr int TW0 = (PARTS == 2) ? 4 : 0, TNW = NWAVES - TW0;
    if (c.wave < TW0) return;
    const int tw = c.wave - TW0;
    LAS float* scr = (LAS float*)(c.lds + c.wave * 16384);
    constexpr int I0 = 768, I1 = I0 + 1024, I2 = I1 + 128, I3 = I2 + 256, I4 = I3 + 256, I5 = I4 + 512, I6 = I5 + 8192, I7 = I6 + 8192, I8 = I7 + 8192;
    int it_lo = 0, it_hi = 0;
    auto decode = [&](int it) -> TItem { TItem t;
        if (it < I0) { const int nb = 1536 / 32, r = it, n0_ = 32 * (r % nb); const bool z8_ = ZA_FP8GEMM && n0_ < 512;
            t = TItem{p.in[I_WIN], z8_ ? (bf16_t*)(p.ws + WS_WG8 - 512 * 1024) : (bf16_t*)(p.ws + WS_W1T), 1024, 1536, n0_, 64 * (r / nb), n0_, (z8_ || Q8_P2) ? 32.f : 0.f, z8_ ? 1 : 0}; }
        else if (it < I1) { const int nb = 2048 / 32, r = it - I0; t = FP8_GATES ? TItem{p.in[I_WGATE], (bf16_t*)(p.ws + WS_WG8), 1024, 2048, MERGE_ONE ? ((((32 * (r % nb)) & 1023) >> 7) * 256 + ((32 * (r % nb)) >> 10) * 128 + ((32 * (r % nb)) & 127)) : 32 * (r % nb), 64 * (r / nb), 32 * (r % nb), 32.f, 1}
                           : TItem{p.in[I_WGATE], (bf16_t*)(p.ws + WS_W1T), 1024, 2048, 1536 + 32 * (r % nb), 64 * (r / nb), 32 * (r % nb), Q8_P2 ? 32.f : 0.f, 0}; }
        else if (it < I2) { const int nb = 512 / 32, r = it - I1; t = TItem{p.in[I_WGLU], (bf16_t*)(p.ws + WS_WGLUT), 512, 512, 32 * (r % nb), 64 * (r / nb), 32 * (r % nb), 0.f, 0}; }
        else if (it < I3) { const int nb = 1024 / 32, r = it - I2; t = TItem{p.in[I_WBA], (bf16_t*)(p.ws + WS_WBAT), 512, 1024, 32 * (r % nb), 64 * (r / nb), 32 * (r % nb), (FP8_MERGE || Q8_P8) ? 16.f : 0.f, FP8_MERGE}; }
        else if (it < I4) { const int nb = 1024 / 32, r = it - I3; t = TItem{p.in[I_WBB], (bf16_t*)(p.ws + WS_WBBT), 512, 1024, 32 * (r % nb), 64 * (r / nb), 32 * (r % nb), (FP8_MERGE || Q8_P8) ? 16.f : 0.f, FP8_MERGE}; }
        else if (it < I5) { const int nb = 1024 / 32, r = it - I4; t = TItem{p.in[I_WOUT], (bf16_t*)(p.ws + WS_WOUTT), 1024, 1024, 32 * (r % nb), 64 * (r / nb), 32 * (r % nb), (FP8_OUT || Q8_P10) ? 32.f : 0.f, FP8_OUT}; }
        else if (it < I7) { const bool is3 = it >= I6; const int r0 = it - (is3 ? I6 : I5), e = r0 >> 8, r = r0 & 255, nb = 512 / 32, n0 = 32 * (r % nb);
            t = TItem{p.in[is3 ? I_W3 : I_W1] + (size_t)e * 1024 * 512, FP8_MOE ? (bf16_t*)(p.ws + WS_WUPT + (size_t)e * 1024 * 1024) : (bf16_t*)(p.ws + WS_WUPT) + (size_t)e * 1024 * 1024, 1024, 512, (n0 >> 7) * 256 + (is3 ? 128 : 0) + (n0 & 127), 64 * (r / nb), n0, (FP8_MOE || Q8_MOE) ? 32.f : 0.f, FP8_MOE}; }
        else { const int r0 = it - I7, e = r0 >> 8, r = r0 & 255, nb = 1024 / 32;
            t = TItem{p.in[I_W2] + (size_t)e * 512 * 1024, FP8_MOE ? (bf16_t*)(p.ws + WS_WDNT + (size_t)e * 1024 * 512) : (bf16_t*)(p.ws + WS_WDNT) + (size_t)e * 1024 * 512, 512, 1024, 32 * (r % nb), 64 * (r / nb), 32 * (r % nb), (FP8_MOE || Q8_MOE) ? 16.f : 0.f, FP8_MOE}; }
        return t; };
    (void)it_lo; (void)it_hi;
    if (PARTS == 3) {
        unsigned* ctr = (unsigned*)(p.ws + WS_CTL) + CW_P0CTR; LAS unsigned* slot = (LAS unsigned*)(c.lds + XT_OFF + 8192);
        constexpr int NCH = (I8 + NWAVES - 1) / NWAVES;
#define P0_BAR() do { LDS_WAIT(); __builtin_amdgcn_s_barrier(); asm volatile("" ::: "memory"); } while (0)
        unsigned my_next = 0;
        if (c.tid == 0) { slot[0] = __hip_atomic_fetch_add(ctr, 1u, RLX_AGENT); my_next = __hip_atomic_fetch_add(ctr, 1u, RLX_AGENT); }
        P0_BAR();
        unsigned ch = slot[0];
        P0_BAR();
        float tv[32], tn[32]; TItem cur{}; bool have = false;
        if (ch < (unsigned)NCH) { const int it = (int)ch * NWAVES + c.wave; if (it < I8) { cur = decode(it); titem_load(cur, c.lane, tn); have = true; } }
        while (ch < (unsigned)NCH) {
            if (c.tid == 0) { slot[0] = my_next; my_next = __hip_atomic_fetch_add(ctr, 1u, RLX_AGENT); }
            P0_BAR();
            const unsigned nch = slot[0];
            P0_BAR();
#pragma unroll
            for (int i = 0; i < 32; ++i) tv[i] = tn[i];
            const bool had = have; const TItem fin = cur; have = false;
            if (nch < (unsigned)NCH) { const int it = (int)nch * NWAVES + c.wave; if (it < I8) { cur = decode(it); titem_load(cur, c.lane, tn); have = true; } }
            if (had) titem_finish(fin, c.lane, tv, scr);
            ch = nch;
        }
#undef P0_BAR
    } else if (it_lo < it_hi) {
        float tv[32], tn[32];
        TItem cur = decode(it_lo); titem_load(cur, c.lane, tn);
        for (int it = it_lo; it < it_hi; it += TNW) {
#pragma unroll
            for (int i = 0; i < 32; ++i) tv[i] = tn[i];
            TItem nx = cur; if (it + TNW < it_hi) { nx = decode(it + TNW); titem_load(nx, c.lane, tn); }
            titem_finish(cur, c.lane, tv, scr);
            cur = nx;
        }
    }
}

template <int NW>
__device__ __forceinline__ void p1_xn(const Params& p, const Ctx& c) {
    if (c.wave >= NW) return;
    const float* mod = (const float*)(p.ws + WS_MOD); bf16_t* XN = (bf16_t*)(p.ws + WS_XN);
    LAS unsigned char* wl = c.lds + c.wave * 12288;
    for (int rb = c.vcu; rb < 256; rb += c.G) {
        const int b = rb >> 3;
        f32x4 A[4], Bc[4];
#pragma unroll
        for (int j = 0; j < 4; ++j) { const int k = 4 * c.lane + 256 * j; const f32x4 g = *(const f32x4*)(p.in[I_N1G] + k), sc = *(const f32x4*)(mod + b * 6144 + 1024 + k); A[j] = g * (sc + 1.0f); Bc[j] = *(const f32x4*)(mod + b * 6144 + k); }
        for (int i = 0; i < 256 / NW; i += 4) {
            const size_t row = (size_t)rb * 256 + c.wave * (256 / NW) + i;
            f32x4 v[4][4];
#pragma unroll
            for (int q = 0; q < 4; ++q) { const GAS f32x4* xr = (const GAS f32x4*)(p.in[I_X] + (row + q) * D) + c.lane;
#pragma unroll
                for (int j = 0; j < 4; ++j) v[q][j] = NTLD(xr + 64 * j); }
#pragma unroll
            for (int q = 0; q < 4; ++q) { float s = 0.f;
#pragma unroll
                for (int j = 0; j < 4; ++j) s += (v[q][j].x * v[q][j].x + v[q][j].y * v[q][j].y) + (v[q][j].z * v[q][j].z + v[q][j].w * v[q][j].w);
                const float r = 1.0f / sqrtf(wave_sum(s) * (1.0f / D) + 1e-6f);
#pragma unroll
                for (int j = 0; j < 4; ++j) { f32x4 y = v[q][j] * r * A[j] + Bc[j]; if (Q8_P2) { y.x = q8(y.x, 1.f, 1.f); y.y = q8(y.y, 1.f, 1.f); y.z = q8(y.z, 1.f, 1.f); y.w = q8(y.w, 1.f, 1.f); }
                    *(LAS u32x2*)(wl + q * 3072 + 8 * c.lane + 512 * j) = (u32x2){cvt_pk_bf16(y.x, y.y), cvt_pk_bf16(y.z, y.w)};
                    if (FP8_GATES) *(LAS unsigned*)(wl + q * 3072 + 2048 + 4 * c.lane + 256 * j) = pk4_fp8(y.x, y.y, y.z, y.w); } }
            LDS_WAIT();
#pragma unroll
            for (int q = 0; q < 4; ++q) {
                const u32x4 b0 = *(const LAS u32x4*)(wl + q * 3072 + 16 * c.lane), b1 = *(const LAS u32x4*)(wl + q * 3072 + 1024 + 16 * c.lane);
                GAS u32x4* o16 = (GAS u32x4*)(XN + (row + q) * D) + c.lane; o16[0] = b0; o16[64] = b1;
                if (FP8_GATES) { const u32x4 f0 = *(const LAS u32x4*)(wl + q * 3072 + 2048 + 16 * c.lane); ((GAS u32x4*)((unsigned char*)p.out + (row + q) * D))[c.lane] = f0; } }
            LDS_WAIT();
        }
    }
}

template <bool PERM_> struct SchedStd { static constexpr bool VOFF_CONST = true;
    const char* A; const char* B; int lda, ldb, nM, nN, nt, G, c, pn0;
    __device__ __forceinline__ bool next(int i, Unit& u) const { int pm, pn; if (!mg::static_tile(i, G, c, nM, nN, pm, pn)) return false; pn += pn0; u.pm = pm; u.pn = pn; u.nt = nt; u.aux = 0;
        u.A0 = A + (size_t)pm * 512 * lda; u.A1 = u.A0 + (size_t)256 * lda; u.B0 = B + (size_t)pn * 512 * ldb; u.B1 = u.B0 + (size_t)256 * ldb; return true; }
    __device__ __forceinline__ void voff(const Unit&, int tid, unsigned (&va)[1][2], unsigned (&vb)[2]) const { mg::std_voff<PERM_>(tid, lda, ldb, va, vb); }
};
template <bool PERM_> struct SchedStd8 { static constexpr bool VOFF_CONST = true; static constexpr int SWZ8 = PERM_ ? SWZ_GATE : SWZ_OUT;
    const char* A; const char* B; int ldaB, ldbB, nM, nN, nt, G, c;
    __device__ __forceinline__ bool next(int i, Unit& u) const { int pm, pn; if (!mg::static_tile(i, G, c, nM, nN, pm, pn)) return false; u.pm = pm; u.pn = pn; u.nt = nt; u.aux = 0;
        u.A0 = A + (size_t)pm * 256 * ldaB; u.A1 = u.A0 + (size_t)128 * ldaB; u.B0 = B + (size_t)pn * 256 * ldbB; u.B1 = u.B0 + (size_t)128 * ldbB; return true; }
    __device__ __forceinline__ void voff(const Unit&, int tid, unsigned (&va)[1][2], unsigned (&vb)[2]) const { mg::std_voff8<PERM_, SWZ8>(tid, ldaB, ldbB, va, vb); }
};
struct NoPre {};
#define NO_PREFETCH typedef NoPre Pre; __device__ __forceinline__ void prefetch(Pre&, const Unit&, int, int, int, int) const {}
#define EPI_ARGS const f32x4 (&acc)[2][2][4][2], const Unit& u, int wr, int wc, int fr, int fq, const Pre& pre
struct EpiNull { static constexpr bool PERM = true; NO_PREFETCH
    __device__ __forceinline__ void operator()(EPI_ARGS) const {
#pragma unroll
        for (int ai = 0; ai < 2; ++ai)
#pragma unroll
            for (int bj = 0; bj < 2; ++bj)
#pragma unroll
                for (int m = 0; m < 4; ++m) { asm volatile("" :: "v"(acc[ai][bj][m][0]), "v"(acc[ai][bj][m][1])); }
    }
};
struct Epi1 { static constexpr bool PERM = true; NO_PREFETCH bf16_t* ZA; bf16_t* U; bf16_t* GV; bf16_t* GATES; const LAS float* b_gate;
    __device__ __forceinline__ void operator()(EPI_ARGS) const {
        const int pn = u.pn;
#pragma unroll
        for (int bj = 0; bj < 2; ++bj) {
            const int col0 = pn * 256 + bj * 128 + wc * 32 + 8 * fq;
            f32x4 b0 = (f32x4){0.f, 0.f, 0.f, 0.f}, b1 = b0; u32x2 pkz = (u32x2){0u, 0u}; (void)pkz;
            if (pn >= 6) { b0 = *(const LAS f32x4*)(b_gate + col0 - 1536); b1 = *(const LAS f32x4*)(b_gate + col0 - 1536 + 4); }
#pragma unroll
            for (int ai = 0; ai < 2; ++ai)
#pragma unroll
                for (int m = 0; m < 4; ++m) {
                    const int t = u.pm * 256 + ai * 128 + wr * 64 + m * 16 + fr;
                    f32x4 v0 = acc[ai][bj][m][0], v1 = acc[ai][bj][m][1];
                    if (pn < 2) { const int g = col0 >> 4, half = (col0 >> 3) & 1;
                        if (FP8_S5A) {
                            const u32x2 pk = (u32x2){pk4_fp8(v0[0] * 8.0f, v0[1] * 8.0f, v0[2] * 8.0f, v0[3] * 8.0f), pk4_fp8(v1[0] * 8.0f, v1[1] * 8.0f, v1[2] * 8.0f, v1[3] * 8.0f)};
                            if ((m & 1) == 0) pkz = pk; else { const u32x4 w16 = widen8(pkz, pk); const int tt = (fq & 1) ? t : t - 16; const int bb = tt >> 11, pp = tt & 2047, cc = pp >> 6, sp = 63 - (pp & 63);
                                st16((void*)((unsigned char*)ZA + ((size_t)(g * 1024 + bb * 32 + cc) * 1024 + sp * 16)), w16); } }
                        else { const int bb = t >> 11, pp = t & 2047, cc = pp >> 6, sp = 63 - (pp & 63);
                            st16((void*)(ZA + ((size_t)(g * 1024 + bb * 32 + cc) * 1024 + sp * 16 + half * 8)), pack8(v0, v1)); } }
                    else if (pn < 6) {
#pragma unroll
                        for (int j = 0; j < 4; ++j) { v0[j] = fgelu(v0[j]); v1[j] = fgelu(v1[j]); }
                        bf16_t* dst = (pn < 4) ? (U + (size_t)t * 512 + (col0 - 512)) : (GV + (size_t)t * 512 + (col0 - 1024));
                        *(u32x4*)dst = pack8(v0, v1); }
                    else {
#pragma unroll
                        for (int j = 0; j < 4; ++j) { v0[j] = fsigmoid(v0[j] + b0[j]); v1[j] = fsigmoid(v1[j] + b1[j]); }
                        st16((void*)(GATES + (size_t)t * 2048 + (col0 - 1536)), pack8(v0, v1)); }
                }
        }
    }
};
#if MERGE_ONE
constexpr size_t TILED2_HALF = (size_t)256 * 8 * 8 * 8 * 64 * 8;
struct Epi1g { static constexpr bool PERM = true; NO_PREFETCH bf16_t* GATES; const LAS float* b_gate; bf16_t* GB2;
    __device__ __forceinline__ void operator()(EPI_ARGS) const {
        const int j0 = u.pn * 128 + wc * 32 + 8 * fq;
        const f32x4 ba0 = *(const LAS f32x4*)(b_gate + j0), ba1 = *(const LAS f32x4*)(b_gate + j0 + 4), bb0 = *(const LAS f32x4*)(b_gate + 1024 + j0), bb1 = *(const LAS f32x4*)(b_gate + 1024 + j0 + 4);
#pragma unroll
        for (int ai = 0; ai < 2; ++ai)
#pragma unroll
            for (int m = 0; m < 4; ++m) { f32x4 r0, r1, g0, g1;
#pragma unroll
                for (int q = 0; q < 4; ++q) {
                    const float ea0 = __builtin_amdgcn_exp2f(__builtin_amdgcn_fmed3f(-1.4426950408889634f * (acc[ai][0][m][0][q] + ba0[q]), -57.0f, 57.0f)), eb0 = __builtin_amdgcn_exp2f(__builtin_amdgcn_fmed3f(-1.4426950408889634f * (acc[ai][1][m][0][q] + bb0[q]), -57.0f, 57.0f));
                    const float ea1 = __builtin_amdgcn_exp2f(__builtin_amdgcn_fmed3f(-1.4426950408889634f * (acc[ai][0][m][1][q] + ba1[q]), -57.0f, 57.0f)), eb1 = __builtin_amdgcn_exp2f(__builtin_amdgcn_fmed3f(-1.4426950408889634f * (acc[ai][1][m][1][q] + bb1[q]), -57.0f, 57.0f));
                    if (GATE8) { r0[q] = __builtin_amdgcn_rcpf(1.0f + ea0); r1[q] = __builtin_amdgcn_rcpf(1.0f + ea1); g0[q] = __builtin_amdgcn_rcpf(1.0f + eb0); g1[q] = __builtin_amdgcn_rcpf(1.0f + eb1); }
                    else { r0[q] = (1.0f + eb0) * __builtin_amdgcn_rcpf(1.0f + ea0); g0[q] = __builtin_amdgcn_rcpf(1.0f + eb0);
                        r1[q] = (1.0f + eb1) * __builtin_amdgcn_rcpf(1.0f + ea1); g1[q] = __builtin_amdgcn_rcpf(1.0f + eb1); } }
                bf16_t* d = GATES + ((((size_t)(u.pm * 8 + u.pn) * 8 + (ai * 4 + m)) * 8 + (wr * 4 + wc)) * 64 + (fq * 16 + fr)) * 8;
                if (GATE8) { u32x4 w8 = (u32x4){0u, 0u, 0u, 0u};
#pragma unroll
                    for (int q = 0; q < 4; ++q) { w8.x = __builtin_amdgcn_cvt_pk_u8_f32(r0[q] * 256.0f - 0.5f, q, w8.x); w8.y = __builtin_amdgcn_cvt_pk_u8_f32(r1[q] * 256.0f - 0.5f, q, w8.y);
                        w8.z = __builtin_amdgcn_cvt_pk_u8_f32(g0[q] * 256.0f - 0.5f, q, w8.z); w8.w = __builtin_amdgcn_cvt_pk_u8_f32(g1[q] * 256.0f - 0.5f, q, w8.w); }
                    st16((void*)d, w8); }
                else { const u32x4 rw = pack8(r0, r1), gw2 = pack8(g0, g1);
                    st16((void*)d, rw); asm volatile("" ::: "memory"); st16((void*)(GB2 + (size_t)(d - GATES)), gw2); } }
    }
};
struct EpiZG { static constexpr bool PERM = true; NO_PREFETCH Epi1 e1; Epi1g eg;
    __device__ __forceinline__ void operator()(EPI_ARGS) const { if (u.pn < 2) e1(acc, u, wr, wc, fr, fq, pre); else { Unit u2 = u; u2.pn = u.pn - 2; eg(acc, u2, wr, wc, fr, fq, pre); } }
};
#else
struct Epi1g { static constexpr bool PERM = true; NO_PREFETCH bf16_t* GATES; const LAS float* b_gate;
    __device__ __forceinline__ void operator()(EPI_ARGS) const {
#pragma unroll
        for (int bj = 0; bj < 2; ++bj) { const int col0 = u.pn * 256 + bj * 128 + wc * 32 + 8 * fq;
            const f32x4 b0 = *(const LAS f32x4*)(b_gate + col0), b1 = *(const LAS f32x4*)(b_gate + col0 + 4);
#pragma unroll
            for (int ai = 0; ai < 2; ++ai)
#pragma unroll
                for (int m = 0; m < 4; ++m) { const size_t t = (size_t)u.pm * 256 + ai * 128 + wr * 64 + m * 16 + fr; f32x4 v0 = acc[ai][bj][m][0], v1 = acc[ai][bj][m][1];
#pragma unroll
                    for (int j = 0; j < 4; ++j) { v0[j] = fsigmoid(v0[j] + b0[j]); v1[j] = fsigmoid(v1[j] + b1[j]); }
                    if (TILED_GATES) st16((void*)(GATES + ((((size_t)(u.pm * 8 + u.pn) * 16 + (ai * 8 + m * 2 + bj)) * 8 + (wr * 4 + wc)) * 64 + (fq * 16 + fr)) * 8), pack8(v0, v1));
                    else st16((void*)(GATES + t * 2048 + col0), pack8(v0, v1)); }
        }
    }
};
#endif
struct SchedS5a { static constexpr int SWZ8 = 4; const char* ZA; const char* TZ; const char* WS; int G, c;
    __device__ __forceinline__ void fill(int v, int k, Unit& u) const {
        const int pair = v >> 1, g = pair >> 2, rt = pair & 3; constexpr int EB = FP8_S5A ? 1 : 2;
        const int j = (v & 1) ? (k == 0 ? 1 : (k == 1 ? 0 : 4)) : (k == 0 ? 3 : 2);
        const int kt0 = (j < 4) ? 12 - 4 * j : 0;
        u.A0 = ZA + ((size_t)(g * 1024 + rt * 256) * 1024 + kt0 * 64) * EB; u.A1 = u.A0 + 128 * 1024 * EB;
        if (j < 4) { u.B0 = TZ + ((size_t)g * 32768 + 16 * j * 16 + kt0 * 64) * EB; u.B1 = u.B0 + 128 * EB; }
        else { u.B0 = WS + (size_t)g * 131072 * EB; u.B1 = u.B0; }
        u.nt = FP8_S5A ? (16 - kt0) / 2 : 16 - kt0; u.pm = g * 4 + rt; u.pn = j; u.aux = 0;
    }
    __device__ __forceinline__ bool next(int i, Unit& u) const { int k = i; for (int v = c; v < 256; v += G) { const int n = (v & 1) ? 3 : 2; if (k < n) { fill(v, k, u); return true; } k -= n; } return false; }
    __device__ __forceinline__ void voff(const Unit& u, int tid, unsigned (&va)[1][2], unsigned (&vb)[2]) const {
#pragma unroll
        for (int i = 0; i < 2; ++i) { int R, C; mg::stage_rc<FP8_S5A ? SWZ8 : 5>(tid * 16 + i * 8192, R, C); const int Rb = (R & ~31) + mg::perm32(R & 31);
            if (FP8_S5A) { const int Cb = C * 2; va[0][i] = (unsigned)(R * 1024 + Cb); vb[i] = (u.pn < 4) ? (unsigned)((Rb & 15) * 2048 + (Rb >> 4) * 16 + Cb) : (unsigned)(Rb * 1024 + Cb); }
            else { va[0][i] = (unsigned)(R * 1024 + C) * 2u; vb[i] = (u.pn < 4) ? (unsigned)((Rb & 15) * 2048 + (Rb >> 4) * 16 + C) * 2u : (unsigned)(Rb * 1024 + C) * 2u; } }
    }
};
struct EpiS5a { static constexpr bool PERM = true; NO_PREFETCH bf16_t* YI; float* SST; const float* lstep;
    __device__ __forceinline__ void operator()(EPI_ARGS) const {
        const int j = u.pn; const float ssc = FP8_S5A ? __builtin_amdgcn_ldexpf(1.0f, 6 - s5_ks(lstep[u.pm >> 2])) : 1.0f;
#pragma unroll
        for (int ai = 0; ai < 2; ++ai)
#pragma unroll
            for (int m = 0; m < 4; ++m) { const size_t row = (size_t)u.pm * 256 + ai * 128 + wr * 64 + m * 16 + fr;
                if (j < 4) {
#pragma unroll
                    for (int bj = 0; bj < 2; ++bj) st16((void*)(YI + row * 1024 + j * 256 + bj * 128 + wc * 32 + 8 * fq), pack8(acc[ai][bj][m][0], acc[ai][bj][m][1]));
                } else { float* d = SST + row * 128 + wc * 32 + 8 * fq; st16f(d, acc[ai][0][m][0] * ssc); st16f(d + 4, acc[ai][0][m][1] * ssc); }
            }
    }
};
struct SchedS5b { const char* HP; const char* WO; int G, c;
    __device__ __forceinline__ bool next(int i, Unit& u) const { const long L = FUSE45 ? (i < 2 ? (long)(c & 127) * 4 + (c >> 7) * 2 + i : 512l) : (long)i * G + c; if (L >= 512) return false; const int g = (int)L >> 4, rt = ((int)L >> 2) & 3, j = (int)L & 3;
        u.A0 = HP + (size_t)(g * 1024 + rt * 256) * 256; u.A1 = u.A0 + 128 * 256; u.B0 = WO + (size_t)(g * 1024 + j * 256) * 256; u.B1 = u.B0 + 128 * 256; u.nt = 2; u.pm = g * 4 + rt; u.pn = j; u.aux = 0; return true; }
    __device__ __forceinline__ void voff(const Unit&, int tid, unsigned (&va)[1][2], unsigned (&vb)[2]) const { mg::std_voff<true>(tid, 128, 128, va, vb); }
};
struct EpiS5b { static constexpr bool PERM = true; const bf16_t* YI; bf16_t* YG;
    struct Pre { u32x4 yq[4]; };
#define ES_OFF(s_) (base + (size_t)(((s_) >> 3) * 128 + (((s_) >> 1) & 3) * 16) * 1024 + ((s_) & 1) * 128)
    __device__ __forceinline__ void prefetch(Pre& pre, const Unit& u, int wr, int wc, int fr, int fq) const {
        const size_t base = ((size_t)u.pm * 256 + wr * 64 + fr) * 1024 + u.pn * 256 + wc * 32 + 8 * fq;
#pragma unroll
        for (int s_ = 0; s_ < 4; ++s_) pre.yq[s_] = *(const u32x4*)(YI + ES_OFF(s_));
    }
    __device__ __forceinline__ void operator()(EPI_ARGS) const {
        const size_t base = ((size_t)u.pm * 256 + wr * 64 + fr) * 1024 + u.pn * 256 + wc * 32 + 8 * fq;
        u32x4 yq[4]; u32x2 pke = (u32x2){0u, 0u}; (void)pke;
#pragma unroll
        for (int s_ = 0; s_ < 4; ++s_) yq[s_] = pre.yq[s_];
#pragma unroll
        for (int s_ = 0; s_ < 16; ++s_) { const int ai = s_ >> 3, m = (s_ >> 1) & 3, bj = s_ & 1;
            const u32x4 yw = yq[s_ & 3];
            if (s_ + 4 < 16) yq[s_ & 3] = *(const u32x4*)(YI + ES_OFF(s_ + 4));
            f32x4 y0, y1; unpack8(yw, y0, y1); y0 += acc[ai][bj][m][0]; y1 += acc[ai][bj][m][1];
#pragma unroll
            for (int q = 0; q < 4; ++q) { y0[q] = fgelu(y0[q]); y1[q] = fgelu(y1[q]); }
            st16((void*)(YG + ES_OFF(s_)), pack8(y0, y1)); }
    }
#undef ES_OFF
};
struct SchedGlu { static constexpr bool VOFF_CONST = true; const char* YG; const char* B; int G, c;
    __device__ __forceinline__ bool next(int i, Unit& u) const { int pm, pn; if (!mg::static_tile(i, G, c, 256, 2, pm, pn)) return false; u.pm = pm; u.pn = pn; u.nt = 8; u.aux = 0;
        u.A0 = YG + (size_t)pm * 256 * 32; u.A1 = u.A0 + 128 * 32; u.B0 = B + (size_t)pn * 512 * 512; u.B1 = u.B0 + (size_t)256 * 512; return true; }
    __device__ __forceinline__ void voff(const Unit&, int tid, unsigned (&va)[1][2], unsigned (&vb)[2]) const {
#pragma unroll
        for (int i = 0; i < 2; ++i) { int R, C; mg::stage_rc(tid * 16 + i * 8192, R, C); const int Rb = (R & ~31) + mg::perm32(R & 31);
            va[0][i] = (unsigned)((C >> 4) * 1048576 + R * 16 + (C & 15)) * 2u; vb[i] = (unsigned)(Rb * 512 + C) * 2u; }
    }
};
struct EpiGlu { static constexpr bool PERM = true; const bf16_t* YG; bf16_t* YA; const float* b_glu;
    struct Pre { u32x4 yq[4]; };
#define EG_T(s_) (trow + ((s_) >> 3) * 128 + (((s_) >> 1) & 3) * 16)
#define EG_C(s_) (colb + ((s_) & 1) * 128)
#define EG_Y(s_) (YG + ((size_t)(EG_C(s_) >> 4) * 65536 + EG_T(s_)) * 16 + (EG_C(s_) & 15))
    __device__ __forceinline__ void prefetch(Pre& pre, const Unit& u, int wr, int wc, int fr, int fq) const {
        const size_t trow = (size_t)u.pm * 256 + wr * 64 + fr; const int colb = u.pn * 256 + wc * 32 + 8 * fq;
#pragma unroll
        for (int s_ = 0; s_ < 4; ++s_) pre.yq[s_] = *(const u32x4*)EG_Y(s_);
    }
    __device__ __forceinline__ void operator()(EPI_ARGS) const {
        const size_t trow = (size_t)u.pm * 256 + wr * 64 + fr; const int colb = u.pn * 256 + wc * 32 + 8 * fq;
        f32x4 bq[2][2];
#pragma unroll
        for (int bj = 0; bj < 2; ++bj) { bq[bj][0] = *(const f32x4*)(b_glu + colb + bj * 128); bq[bj][1] = *(const f32x4*)(b_glu + colb + bj * 128 + 4); }
        u32x4 yq[4]; u32x2 pke = (u32x2){0u, 0u}; (void)pke;
#pragma unroll
        for (int s_ = 0; s_ < 4; ++s_) yq[s_] = pre.yq[s_];
#pragma unroll
        for (int s_ = 0; s_ < 16; ++s_) { const int ai = s_ >> 3, m = (s_ >> 1) & 3, bj = s_ & 1;
            const u32x4 yw = yq[s_ & 3];
            if (s_ + 4 < 16) yq[s_ & 3] = *(const u32x4*)EG_Y(s_ + 4);
            f32x4 y0, y1; unpack8(yw, y0, y1);
            f32x4 v0 = acc[ai][bj][m][0] + bq[bj][0], v1 = acc[ai][bj][m][1] + bq[bj][1];
#pragma unroll
            for (int q = 0; q < 4; ++q) { v0[q] = y0[q] * fsigmoid(v0[q]); v1[q] = y1[q] * fsigmoid(v1[q]); if (Q8_P8) { v0[q] = q8(v0[q], 8.f, 0.125f); v1[q] = q8(v1[q], 8.f, 0.125f); } }
            if (FP8_MERGE) { v0 *= 8.0f; v1 *= 8.0f; const u32x2 pk = (u32x2){pk4_fp8(v0[0], v0[1], v0[2], v0[3]), pk4_fp8(v1[0], v1[1], v1[2], v1[3])};
                if (WIDE8) { if (bj == 0) pke = pk; else { const u32x4 w16 = widen8(pke, pk);
                        st16((void*)((unsigned char*)YA + EG_T(s_) * 512 + (colb - 8 * fq) + ((fq & 1) ? 128 + 8 * (fq - 1) : 8 * fq)), w16); } }
                else st8((void*)((unsigned char*)YA + EG_T(s_) * 512 + EG_C(s_)), pk); }
            else st16((void*)(YA + EG_T(s_) * 512 + EG_C(s_)), pack8(v0, v1)); }
    }
#undef EG_T
#undef EG_C
#undef EG_Y
};
template <int SECOND> struct EpiMerge { static constexpr bool PERM = true; const bf16_t* GATES; bf16_t* P1; bf16_t* MERGED;
    static constexpr int PD = SECOND ? 4 : 8;
    struct Pre { u32x4 gq[PD]; u32x4 pq[SECOND ? 4 : 1]; };
#define EM_GT(s_) (GATES + ((((size_t)(u.pm * 8 + SECOND * 4 + u.pn) * 16 + (s_)) * 8 + (wr * 4 + wc)) * 64 + (fq * 16 + fr)) * 8)
#define EM_PT(s_) (P1 + ((((size_t)(u.pm * 4 + u.pn) * 16 + (s_)) * 8 + (wr * 4 + wc)) * 64 + (fq * 16 + fr)) * 8)
#define EM_T(s_) (trow + ((s_) >> 3) * 128 + (((s_) >> 1) & 3) * 16)
#define EM_C(s_) (colb + ((s_) & 1) * 128)
    __device__ __forceinline__ void prefetch(Pre& pre, const Unit& u, int wr, int wc, int fr, int fq) const {
        const size_t trow = (size_t)u.pm * 256 + wr * 64 + fr; const int colb = u.pn * 256 + wc * 32 + 8 * fq;
#pragma unroll
        for (int s_ = 0; s_ < PD; ++s_) { pre.gq[s_] = TILED_GATES ? *(const u32x4*)EM_GT(s_) : *(const u32x4*)(GATES + EM_T(s_) * 2048 + SECOND * 1024 + EM_C(s_)); if (SECOND) pre.pq[s_] = TILED_GATES ? *(const u32x4*)EM_PT(s_) : *(const u32x4*)(P1 + EM_T(s_) * 1024 + EM_C(s_)); }
    }
    __device__ __forceinline__ void operator()(EPI_ARGS) const {
        const size_t trow = (size_t)u.pm * 256 + wr * 64 + fr; const int colb = u.pn * 256 + wc * 32 + 8 * fq;
        u32x4 gq[PD], pq[4];
#pragma unroll
        for (int s_ = 0; s_ < PD; ++s_) { gq[s_] = pre.gq[s_]; if (SECOND) pq[s_] = pre.pq[s_ & 3]; }
#pragma unroll
        for (int s_ = 0; s_ < 16; ++s_) { const int ai = s_ >> 3, m = (s_ >> 1) & 3, bj = s_ & 1;
            const u32x4 gw = gq[s_ % PD]; u32x4 pw; if (SECOND) pw = pq[s_ & 3];
            if (s_ + PD < 16) { gq[s_ % PD] = TILED_GATES ? *(const u32x4*)EM_GT(s_ + PD) : *(const u32x4*)(GATES + EM_T(s_ + PD) * 2048 + SECOND * 1024 + EM_C(s_ + PD)); if (SECOND) pq[s_ & 3] = TILED_GATES ? *(const u32x4*)EM_PT(s_ + 4) : *(const u32x4*)(P1 + EM_T(s_ + 4) * 1024 + EM_C(s_ + 4)); }
            f32x4 g0, g1; unpack8(gw, g0, g1);
            f32x4 v0 = acc[ai][bj][m][0] * g0, v1 = acc[ai][bj][m][1] * g1;
            if (SECOND) { f32x4 q0, q1; unpack8(pw, q0, q1); v0 += q0; v1 += q1;
                if (Q8_P10) { for (int q = 0; q < 4; ++q) { v0[q] = q8(v0[q], 4.f, 0.25f); v1[q] = q8(v1[q], 4.f, 0.25f); } }
                if (FP8_OUT) { v0 *= 4.0f; v1 *= 4.0f; st8((void*)((unsigned char*)MERGED + EM_T(s_) * 1024 + EM_C(s_)), (u32x2){pk4_fp8(v0[0], v0[1], v0[2], v0[3]), pk4_fp8(v1[0], v1[1], v1[2], v1[3])}); }
                else st16((void*)(MERGED + EM_T(s_) * 1024 + EM_C(s_)), pack8(v0, v1)); }
            else { if (TILED_GATES) st16((void*)EM_PT(s_), pack8(v0, v1)); else st16((void*)(P1 + EM_T(s_) * 1024 + EM_C(s_)), pack8(v0, v1)); } }
    }
#undef EM_T
#undef EM_C
#undef EM_GT
#undef EM_PT
};
struct SchedMerge { static constexpr bool VOFF_CONST = true; static constexpr int SWZ8 = 4; const char* YA; const char* YB; const char* WA; const char* WB; int G, c;
    __device__ __forceinline__ bool next(int i, Unit& u) const { int pm, pn; if (!mg::static_tile(i >> 1, G, c, 256, 4, pm, pn)) return false; const int seg = i & 1; u.pm = pm; u.pn = pn; u.nt = FP8_MERGE ? 4 : 8; u.aux = seg ? 0 : mg::KEEP_ACC;
        const char* A = seg ? YB : YA; const char* B = seg ? WB : WA; constexpr int EB = FP8_MERGE ? 1 : 2;
        u.A0 = A + (size_t)pm * 256 * 512 * EB; u.A1 = u.A0 + (size_t)128 * 512 * EB; u.B0 = B + (size_t)pn * 256 * 512 * EB; u.B1 = u.B0 + (size_t)128 * 512 * EB; return true; }
    __device__ __forceinline__ void voff(const Unit&, int tid, unsigned (&va)[1][2], unsigned (&vb)[2]) const { if (FP8_MERGE) mg::std_voff8<true, SWZ8>(tid, 512, 512, va, vb); else mg::std_voff<true>(tid, 512, 512, va, vb); }
};
struct EpiMergeOne { static constexpr bool PERM = true; const bf16_t* GATES; bf16_t* MERGED;
    static constexpr int PD = GATE8 ? 3 : 4;
    struct Pre { u32x4 gq[PD]; };
#define EM1_G(s_) (gbase + ((((size_t)(u.pm * 8 + 2 * u.pn + ((s_) & 1)) * 8 + (((s_) >> 3) * 4 + (((s_) >> 1) & 3))) * 8 + (wr * 4 + wc)) * 64 + (fq * 16 + fr)) * 8)
    __device__ __forceinline__ void prefetch(Pre& pre, const Unit& u, int wr, int wc, int fr, int fq) const {
        const bf16_t* gbase = GATES + ((GATE8 || (u.aux & mg::KEEP_ACC)) ? (size_t)0 : TILED2_HALF);
#pragma unroll
        for (int s_ = 0; s_ < PD; ++s_) pre.gq[s_] = *(const u32x4*)EM1_G(s_);
    }
    __device__ __forceinline__ void operator()(f32x4 (&acc)[2][2][4][2], const Unit& u, int wr, int wc, int fr, int fq, const Pre& pre) const {
        const bool first = (u.aux & mg::KEEP_ACC) != 0;
        const bf16_t* gbase = GATES + ((GATE8 || first) ? (size_t)0 : TILED2_HALF);
        const size_t trow = (size_t)u.pm * 256 + wr * 64 + fr; const int colm = u.pn * 256 + wc * 32 + 8 * fq;
        u32x4 gq[PD]; u32x2 pke = (u32x2){0u, 0u}; (void)pke;
#pragma unroll
        for (int s_ = 0; s_ < PD; ++s_) gq[s_] = pre.gq[s_];
#pragma unroll
        for (int s_ = 0; s_ < 16; ++s_) { const int ai = s_ >> 3, m = (s_ >> 1) & 3, bj = s_ & 1;
            const u32x4 gw = gq[s_ % PD];
            if (s_ + PD < 16) gq[s_ % PD] = *(const u32x4*)EM1_G(s_ + PD);
            f32x4 g0, g1;
            if (GATE8) {
                const unsigned na0 = first ? gw.x : 0x80808080u, na1 = first ? gw.y : 0x80808080u;
#pragma unroll
                for (int e = 0; e < 4; ++e) { const float kb0 = (float)((gw.z >> (8 * e)) & 0xffu) + 0.5f, kb1 = (float)((gw.w >> (8 * e)) & 0xffu) + 0.5f;
                    const float ka0 = (float)((na0 >> (8 * e)) & 0xffu) + 0.5f, ka1 = (float)((na1 >> (8 * e)) & 0xffu) + 0.5f;
                    g0[e] = first ? ka0 * __builtin_amdgcn_rcpf(kb0) : kb0 * 0.00390625f; g1[e] = first ? ka1 * __builtin_amdgcn_rcpf(kb1) : kb1 * 0.00390625f; } }
            else unpack8(gw, g0, g1);
            if (first) { acc[ai][bj][m][0] *= g0; acc[ai][bj][m][1] *= g1; }
            else { f32x4 v0 = acc[ai][bj][m][0] * g0, v1 = acc[ai][bj][m][1] * g1; const size_t mo = (trow + ai * 128 + m * 16) * 1024 + colm + bj * 128;
                if (FP8_OUT) { v0 *= 4.0f; v1 *= 4.0f; const u32x2 pk = (u32x2){pk4_fp8(v0[0], v0[1], v0[2], v0[3]), pk4_fp8(v1[0], v1[1], v1[2], v1[3])};
                    if (WIDE8) { if (bj == 0) pke = pk; else { const u32x4 w16 = widen8(pke, pk);
                            st16((void*)((unsigned char*)MERGED + (trow + ai * 128 + m * 16) * 1024 + (colm - 8 * fq) + ((fq & 1) ? 128 + 8 * (fq - 1) : 8 * fq)), w16); } }
                    else st8((void*)((unsigned char*)MERGED + mo), pk); }
                else st16((void*)(MERGED + mo), pack8(v0, v1)); } }
    }
#undef EM1_G
};
#ifndef EO_FULL
#define EO_FULL 1
#endif
struct EpiOut { static constexpr bool PERM = false; const float* x; const float* mod; float* H1;
    struct Pre { f32x4 xq[8]; };
#define EO_OFF(s_) (rowb + (size_t)(((s_) >> 4) * 128 + (((s_) >> 2) & 3) * 16 + (EO_FULL ? ((s_) & 1) * 8 : 0)) * 1024 + (((s_) >> 1) & 1) * 128 + (EO_FULL ? 0 : ((s_) & 1) * 16))
    __device__ __forceinline__ void prefetch(Pre& pre, const Unit& u, int wr, int wc, int fr, int fq) const {
        const size_t rowb = EO_FULL ? ((size_t)u.pm * 256 + wr * 64 + (fr & 7)) * 1024 + u.pn * 256 + wc * 32 + (fr >> 3) * 16 + 4 * fq : ((size_t)u.pm * 256 + wr * 64 + fr) * 1024 + u.pn * 256 + wc * 32 + 4 * fq;
#pragma unroll
        for (int s_ = 0; s_ < 8; ++s_) pre.xq[s_] = NTLD((const f32x4*)(x + EO_OFF(s_)));
    }
    __device__ __forceinline__ void operator()(EPI_ARGS) const {
        const int bb = (u.pm * 256) >> 11; const bool lo8 = fr < 8;
        const size_t rowb = EO_FULL ? ((size_t)u.pm * 256 + wr * 64 + (fr & 7)) * 1024 + u.pn * 256 + wc * 32 + (fr >> 3) * 16 + 4 * fq : ((size_t)u.pm * 256 + wr * 64 + fr) * 1024 + u.pn * 256 + wc * 32 + 4 * fq;
        f32x4 gt[4];
#pragma unroll
        for (int q = 0; q < 4; ++q) gt[q] = *(const f32x4*)(mod + bb * 6144 + 2048 + u.pn * 256 + wc * 32 + 4 * fq + (q >> 1) * 128 + (q & 1) * 16);
        if (EO_FULL) {
#pragma unroll
            for (int b2 = 0; b2 < 2; ++b2)
#pragma unroll
                for (int e = 0; e < 4; ++e) { const float g_ = lo8 ? gt[b2 * 2][e] : gt[b2 * 2 + 1][e]; gt[b2 * 2][e] = g_; gt[b2 * 2 + 1][e] = g_; } }
        f32x4 xq[8];
#pragma unroll
        for (int s_ = 0; s_ < 8; ++s_) xq[s_] = pre.xq[s_];
        f32x4 aA = (f32x4){0.f, 0.f, 0.f, 0.f}, aB = aA;
#pragma unroll
        for (int s_ = 0; s_ < 32; ++s_) { const int ai = s_ >> 4, m = (s_ >> 2) & 3, bj = (s_ >> 1) & 1, n = s_ & 1;
            const f32x4 xv = xq[s_ & 7];
            if (s_ + 8 < 32) xq[s_ & 7] = NTLD((const f32x4*)(x + EO_OFF(s_ + 8)));
            f32x4 av = acc[ai][bj][m][n];
            if (EO_FULL) {
                if (n == 0) {
#pragma unroll
                    for (int e = 0; e < 4; ++e) { const float mine0 = acc[ai][bj][m][0][e], mine1 = acc[ai][bj][m][1][e]; const float give = lo8 ? mine1 : mine0;
                        const float got = __builtin_bit_cast(float, __builtin_amdgcn_update_dpp(0, __builtin_bit_cast(int, give), 0x128, 0xf, 0xf, false));
                        aA[e] = lo8 ? mine0 : got; aB[e] = lo8 ? got : mine1; } }
                av = (n == 0) ? aA : aB; }
            f32x4 hv_ = xv + gt[bj * 2 + n] * av;
#ifdef H1_BF16_EMU
            { const unsigned w0 = cvt_pk_bf16(hv_[0], hv_[1]), w1 = cvt_pk_bf16(hv_[2], hv_[3]); hv_ = (f32x4){bf_lo(w0), bf_hi(w0), bf_lo(w1), bf_hi(w1)}; }
#endif
            st16f((void*)(H1 + EO_OFF(s_)), hv_); }
    }
#undef EO_OFF
};
struct EpiDelta { static constexpr bool PERM = true; NO_PREFETCH const float* mod; bf16_t* DLT;
    __device__ __forceinline__ void operator()(EPI_ARGS) const {
        const int bb = (u.pm * 256) >> 11;
        const size_t rowb = ((size_t)u.pm * 256 + wr * 64 + fr) * 1024 + u.pn * 256 + wc * 32 + 8 * fq;
        f32x4 gt[2][2];
#pragma unroll
        for (int bj = 0; bj < 2; ++bj) { const float* gp = mod + bb * 6144 + 2048 + u.pn * 256 + wc * 32 + 8 * fq + bj * 128; gt[bj][0] = *(const f32x4*)gp; gt[bj][1] = *(const f32x4*)(gp + 4); }
#pragma unroll
        for (int s_ = 0; s_ < 16; ++s_) { const int ai = s_ >> 3, m = (s_ >> 1) & 3, bj = s_ & 1;
            st16((void*)(DLT + rowb + (size_t)(ai * 128 + m * 16) * 1024 + bj * 128), pack8(gt[bj][0] * acc[ai][bj][m][0], gt[bj][1] * acc[ai][bj][m][1])); }
    }
};
struct EpiOutB { static constexpr bool PERM = true; const float* x; const float* mod; bf16_t* H1B;
    struct Pre { f32x4 xq[8]; };
#define EO_OFF(s_) (rowb + (size_t)(((s_) >> 3) * 128 + (((s_) >> 1) & 3) * 16) * 1024 + ((s_) & 1) * 128)
    __device__ __forceinline__ void prefetch(Pre& pre, const Unit& u, int wr, int wc, int fr, int fq) const {
        const size_t rowb = ((size_t)u.pm * 256 + wr * 64 + fr) * 1024 + u.pn * 256 + wc * 32 + 8 * fq;
#pragma unroll
        for (int s_ = 0; s_ < 4; ++s_) { pre.xq[2 * s_] = *(const f32x4*)(x + EO_OFF(s_)); pre.xq[2 * s_ + 1] = *(const f32x4*)(x + EO_OFF(s_) + 4); }
    }
    __device__ __forceinline__ void operator()(EPI_ARGS) const {
        const int bb = (u.pm * 256) >> 11;
        const size_t rowb = ((size_t)u.pm * 256 + wr * 64 + fr) * 1024 + u.pn * 256 + wc * 32 + 8 * fq;
        f32x4 gt[2][2];
#pragma unroll
        for (int bj = 0; bj < 2; ++bj) { const float* gp = mod + bb * 6144 + 2048 + u.pn * 256 + wc * 32 + 8 * fq + bj * 128; gt[bj][0] = *(const f32x4*)gp; gt[bj][1] = *(const f32x4*)(gp + 4); }
        f32x4 xq[8];
#pragma unroll
        for (int s_ = 0; s_ < 8; ++s_) xq[s_] = pre.xq[s_];
#pragma unroll
        for (int s_ = 0; s_ < 16; ++s_) { const int ai = s_ >> 3, m = (s_ >> 1) & 3, bj = s_ & 1;
            const f32x4 x0 = xq[2 * (s_ & 3)], x1 = xq[2 * (s_ & 3) + 1];
            if (s_ + 4 < 16) { xq[2 * (s_ & 3)] = *(const f32x4*)(x + EO_OFF(s_ + 4)); xq[2 * (s_ & 3) + 1] = *(const f32x4*)(x + EO_OFF(s_ + 4) + 4); }
            st16((void*)(H1B + EO_OFF(s_)), pack8(x0 + gt[bj][0] * acc[ai][bj][m][0], x1 + gt[bj][1] * acc[ai][bj][m][1])); }
    }
#undef EO_OFF
};
struct MoeTab { const LAS int* cnt; const LAS int* tstart; LAS int* lists; const LAS int* segp; };
__device__ __forceinline__ void moe_find(const MoeTab& mt, int rt, int& e, int& lt) { int ee = 0; for (int q = 1; q < 32; ++q) if (mt.tstart[q] <= rt) ee = q; e = __builtin_amdgcn_readfirstlane(ee); lt = __builtin_amdgcn_readfirstlane(rt - mt.tstart[ee]); }
__device__ __forceinline__ void moe_unit(long L, int nt_total, int& rt, int& pn) {
    const int ntf = (nt_total >> 3) << 3;
    if (L < 4l * ntf) { const int x = (int)(L & 7), y = (int)(L >> 3); rt = (y >> 2) * 8 + x; pn = y & 3; }
    else { const int l2 = (int)(L - 4l * ntf); rt = ntf + (l2 >> 2); pn = l2 & 3; }
}
__device__ __forceinline__ int moe_phys(const MoeTab& mt, int e, int ri) { const int p1 = mt.segp[e * 4 + 1], p2 = mt.segp[e * 4 + 2], p3 = mt.segp[e * 4 + 3];
    const int sg = (ri >= p1) + (ri >= p2) + (ri >= p3); const int pb = sg == 0 ? 0 : (sg == 1 ? p1 : (sg == 2 ? p2 : p3)); return sg * (ECAP / 4) + (ri - pb); }
#define MOE_E(a_) ((a_) & 255)
#define MOE_LT(a_) (((a_) >> 8) & 0xfffff)
#define MOE_BUF(a_) (((a_) >> 28) & 3)
struct SchedUp { static constexpr bool LISTS = true; static constexpr int SWZ8 = SWZ_UP; const char* XN2; const char* WUPT; const int* rowtok; MoeTab mt; int G, c; const float* roww;
    __device__ __forceinline__ bool next(int i, Unit& u) const { const long L = (long)i * G + c; const int ntt = __builtin_amdgcn_readfirstlane(mt.tstart[32]); if (L >= 4l * ntt) return false; int rt, pn; moe_unit(L, ntt, rt, pn); int e, lt; moe_find(mt, rt, e, lt);
        constexpr int EB = FP8_MOE ? 1 : 2;
        u.A0 = XN2; u.A1 = XN2; u.B0 = WUPT + ((size_t)(e * 1024 + pn * 256) * 1024) * EB; u.B1 = u.B0 + 128 * 1024 * EB; u.nt = FP8_MOE ? 8 : 16; u.pm = rt; u.pn = pn; u.aux = e | (lt << 8) | ((i % 3) << 28); return true; }
    __device__ __forceinline__ void list_dma(const Unit& u, int wid, int lane) const { const int e = MOE_E(u.aux), lt = MOE_LT(u.aux), cn = mt.cnt[e]; const int r = (wid & 3) * 64 + lane, ri = lt * 256 + r, ric = ri < cn ? ri : cn - 1;
        const int* src = ((wid < 4) ? rowtok : (const int*)roww) + (size_t)e * ECAP + moe_phys(mt, e, ric);
        __builtin_amdgcn_global_load_lds((const unsigned*)src, (LAS unsigned*)(mt.lists + MOE_BUF(u.aux) * 512 + wid * 64), 4, 0, 0); }
    __device__ __forceinline__ void voff(const Unit& u, int tid, unsigned (&va)[2][2], unsigned (&vb)[2]) const {
        asm volatile("" : "+v"(tid));
        constexpr int EB = FP8_MOE ? 1 : 2; const LAS int* tl = mt.lists + MOE_BUF(u.aux) * 512;
#pragma unroll
        for (int i = 0; i < 2; ++i) { int R, C; mg::stage_rc<FP8_MOE ? SWZ8 : 5>(tid * 16 + i * 8192, R, C); const int Rb = (R & ~31) + mg::perm32(R & 31); vb[i] = (unsigned)(Rb * 1024 * EB + C * 2);
#pragma unroll
            for (int h = 0; h < 2; ++h) { const int tok = tl[h * 128 + R] >> 1; va[h][i] = (unsigned)tok * (1024u * EB) + (unsigned)C * 2u; } }
    }
};
struct EpiUp { static constexpr bool PERM = true; bf16_t* HID; const float* roww; MoeTab mt;
    struct Pre { float w[8]; };
    __device__ __forceinline__ void prefetch(Pre& pre, const Unit& u, int wr, int wc, int fr, int fq) const {
        const int e = MOE_E(u.aux), lt = MOE_LT(u.aux), cn = mt.cnt[e]; const LAS float* wl_ = (const LAS float*)(mt.lists + MOE_BUF(u.aux) * 512 + 256);
#pragma unroll
        for (int q = 0; q < 8; ++q) { const int r = (q >> 2) * 128 + wr * 64 + (q & 3) * 16 + fr; const float wv = wl_[r]; pre.w[q] = (lt * 256 + r < cn) ? wv : 0.f; }
    }
    __device__ __forceinline__ void operator()(EPI_ARGS) const {
        u32x2 pke = (u32x2){0u, 0u}; (void)pke;
#pragma unroll
        for (int ai = 0; ai < 2; ++ai)
#pragma unroll
            for (int m = 0; m < 4; ++m) { const int r = ai * 128 + wr * 64 + m * 16 + fr; const float w = pre.w[ai * 4 + m];
                f32x4 h0, h1;
#pragma unroll
                for (int q = 0; q < 4; ++q) { h0[q] = fsilu(acc[ai][0][m][0][q]) * acc[ai][1][m][0][q] * w; h1[q] = fsilu(acc[ai][0][m][1][q]) * acc[ai][1][m][1][q] * w; if (Q8_MOE) { h0[q] = q8(h0[q], 8.f, 0.125f); h1[q] = q8(h1[q], 8.f, 0.125f); } }
                if (FP8_MOE) { h0 *= 8.0f; h1 *= 8.0f; const u32x2 pk = (u32x2){pk4_fp8(h0[0], h0[1], h0[2], h0[3]), pk4_fp8(h1[0], h1[1], h1[2], h1[3])};
                    if (WIDE8) { if ((m & 1) == 0) pke = pk; else { const u32x4 w16 = widen8(pke, pk);
                            const int rr = (fq & 1) ? r : r - 16; const int cb = (fq & 1) ? 8 * (fq - 1) : 8 * fq;
                            st16((void*)((unsigned char*)HID + ((size_t)u.pm * 256 + rr) * 512 + u.pn * 128 + wc * 32 + cb), w16); } }
                    else st8((void*)((unsigned char*)HID + ((size_t)u.pm * 256 + r) * 512 + u.pn * 128 + wc * 32 + 8 * fq), pk); }
                else st16((void*)(HID + ((size_t)u.pm * 256 + r) * 512 + u.pn * 128 + wc * 32 + 8 * fq), pack8(h0, h1)); }
    }
};
struct EpiUpMath { static constexpr bool PERM = true; NO_PREFETCH const float* roww; MoeTab mt;
    __device__ __forceinline__ void operator()(EPI_ARGS) const {
        const int e = MOE_E(u.aux), lt = MOE_LT(u.aux), cn = mt.cnt[e];
#pragma unroll
        for (int ai = 0; ai < 2; ++ai)
#pragma unroll
            for (int m = 0; m < 4; ++m) { const int r = ai * 128 + wr * 64 + m * 16 + fr, ri = lt * 256 + r; const float w = (ri < cn) ? roww[(size_t)e * ECAP + ri] : 0.f;
                f32x4 h0, h1;
#pragma unroll
                for (int q = 0; q < 4; ++q) { h0[q] = fsilu(acc[ai][0][m][0][q]) * acc[ai][1][m][0][q] * w * 8.0f; h1[q] = fsilu(acc[ai][0][m][1][q]) * acc[ai][1][m][1][q] * w * 8.0f; }
                const u32x2 o = (u32x2){pk4_fp8(h0[0], h0[1], h0[2], h0[3]), pk4_fp8(h1[0], h1[1], h1[2], h1[3])}; asm volatile("" :: "v"(o)); }
    }
};
struct SchedDn { static constexpr bool LISTS = true; static constexpr bool VOFF_CONST = true; static constexpr int SWZ8 = SWZ_DN; const char* HID; const char* WDNT; MoeTab mt; int G, c; const int* rowtok;
    __device__ __forceinline__ bool next(int i, Unit& u) const { const long L = (long)i * G + c; const int ntt = __builtin_amdgcn_readfirstlane(mt.tstart[32]); if (L >= 4l * ntt) return false; int rt, pn; moe_unit(L, ntt, rt, pn); int e, lt; moe_find(mt, rt, e, lt);
        constexpr int EB = FP8_MOE ? 1 : 2;
        u.A0 = HID + (size_t)rt * 256 * 512 * EB; u.A1 = u.A0 + 128 * 512 * EB; u.B0 = WDNT + ((size_t)(e * 1024 + pn * 256) * 512) * EB; u.B1 = u.B0 + 128 * 512 * EB; u.nt = FP8_MOE ? 4 : 8; u.pm = rt; u.pn = pn; u.aux = e | (lt << 8) | ((i % 3) << 28); return true; }
    __device__ __forceinline__ void list_dma(const Unit& u, int wid, int lane) const { if (wid >= 4) return; const int e = MOE_E(u.aux), lt = MOE_LT(u.aux), cn = mt.cnt[e]; const int ri = lt * 256 + wid * 64 + lane, ric = ri < cn ? ri : cn - 1;
        __builtin_amdgcn_global_load_lds((const unsigned*)(rowtok + (size_t)e * ECAP + moe_phys(mt, e, ric)), (LAS unsigned*)(mt.lists + MOE_BUF(u.aux) * 512 + wid * 64), 4, 0, 0); }
    __device__ __forceinline__ void voff(const Unit&, int tid, unsigned (&va)[1][2], unsigned (&vb)[2]) const { if (FP8_MOE) mg::std_voff8<true, SWZ8>(tid, 512, 512, va, vb); else mg::std_voff<true>(tid, 512, 512, va, vb); }
};
struct EpiDn { static constexpr bool PERM = true; bf16_t* SLOT; const int* rowtok; MoeTab mt;
    struct Pre { int slot[8]; };
    __device__ __forceinline__ void prefetch(Pre& pre, const Unit& u, int wr, int wc, int fr, int fq) const {
        const int e = MOE_E(u.aux), lt = MOE_LT(u.aux), cn = mt.cnt[e]; const LAS int* sl_ = mt.lists + MOE_BUF(u.aux) * 512;
#pragma unroll
        for (int q = 0; q < 8; ++q) { const int r = (q >> 2) * 128 + wr * 64 + (q & 3) * 16 + fr; const int sv = sl_[r]; pre.slot[q] = (lt * 256 + r < cn) ? sv : -1; }
    }
    __device__ __forceinline__ void operator()(EPI_ARGS) const {
#pragma unroll
        for (int ai = 0; ai < 2; ++ai)
#pragma unroll
            for (int m = 0; m < 4; ++m) { const int sl = pre.slot[ai * 4 + m];
                if (FP8_SLOT && WIDE8) {
                    const f32x4 a0 = acc[ai][0][m][0] * 16.0f, a1 = acc[ai][0][m][1] * 16.0f, b0 = acc[ai][1][m][0] * 16.0f, b1 = acc[ai][1][m][1] * 16.0f;
                    const u32x4 w16 = widen8((u32x2){pk4_fp8(a0[0], a0[1], a0[2], a0[3]), pk4_fp8(a1[0], a1[1], a1[2], a1[3])}, (u32x2){pk4_fp8(b0[0], b0[1], b0[2], b0[3]), pk4_fp8(b1[0], b1[1], b1[2], b1[3])});
                    if (sl >= 0) st16((void*)((unsigned char*)SLOT + (size_t)sl * 1024 + u.pn * 256 + wc * 32 + ((fq & 1) ? 128 + 8 * (fq - 1) : 8 * fq)), w16);
                } else if (sl >= 0) { const size_t slot = (size_t)sl;
#pragma unroll
                    for (int bj = 0; bj < 2; ++bj) {
                        if (FP8_SLOT) { const f32x4 a0 = acc[ai][bj][m][0] * 16.0f, a1 = acc[ai][bj][m][1] * 16.0f;
                            st8((void*)((unsigned char*)SLOT + slot * 1024 + u.pn * 256 + bj * 128 + wc * 32 + 8 * fq), (u32x2){pk4_fp8(a0[0], a0[1], a0[2], a0[3]), pk4_fp8(a1[0], a1[1], a1[2], a1[3])}); }
                        else st16((void*)(SLOT + slot * 1024 + u.pn * 256 + bj * 128 + wc * 32 + 8 * fq), pack8(acc[ai][bj][m][0], acc[ai][bj][m][1])); } }
            }
    }
};
__device__ __forceinline__ MoeTab moe_table(const Params& p, const Ctx& c) {
    LAS int* cnt = (LAS int*)(c.lds + XT_OFF); LAS int* ts = (LAS int*)(c.lds + XT_OFF + 256);
    LAS int* sp = (LAS int*)(c.lds + XT_OFF + 512);
    if (c.tid < 32) { int a = 0;
#pragma unroll
        for (int sg = 0; sg < 4; ++sg) { sp[c.tid * 4 + sg] = a; a += (int)__hip_atomic_load((unsigned*)(p.ws + WS_CTL) + CW_CURSOR + 64 * (c.tid * 4 + sg), RLX_AGENT); }
        cnt[c.tid] = a; }
    __syncthreads();
    if (c.tid == 0) { int s = 0; for (int e = 0; e < 32; ++e) { ts[e] = s; s += (cnt[e] + 255) >> 8; } ts[32] = s; }
    __syncthreads();
    MoeTab mt; mt.cnt = cnt; mt.tstart = ts; mt.lists = (LAS int*)(c.lds + XT_OFF + 1024); mt.segp = (const LAS int*)(c.lds + XT_OFF + 512); return mt;
}

__device__ __forceinline__ MoeTab moe_table_keep(const Ctx& c) {
    MoeTab mt; mt.cnt = (LAS int*)(c.lds + XT_OFF); mt.tstart = (LAS int*)(c.lds + XT_OFF + 256); mt.lists = (LAS int*)(c.lds + XT_OFF + 1024); mt.segp = (const LAS int*)(c.lds + XT_OFF + 512); return mt; }
__device__ __forceinline__ void p4_scan(const Params& p, const Ctx& c) {
    typedef float f2 __attribute__((ext_vector_type(2)));
    const float* SST = (const float*)(p.ws + WS_SST); bf16_t* HP = (bf16_t*)(p.ws + WS_HP);
    for (int gid = (FUSE45 ? (c.vcu & 127) : c.vcu) * NTHREADS + c.tid; gid < 65536; gid += (FUSE45 ? 65536 : c.G * NTHREADS)) {
        const int g = gid >> 11, b = (gid >> 6) & 31, n = gid & 63;
        const f2 al = ((const f2*)(p.ws + WS_AL))[g * 64 + n];
        float hr = 0.f, hi = 0.f;
        for (int cc = 0; cc < 32; ++cc) { const size_t row = (size_t)g * 1024 + b * 32 + cc;
            HP[row * 128 + n] = (bf16_t)f2bf(hr); HP[row * 128 + 64 + n] = (bf16_t)f2bf(hi);
            const float sr = SST[row * 128 + n], si = SST[row * 128 + 64 + n];
            const float nr = al.x * hr - al.y * hi + sr, ni = al.x * hi + al.y * hr + si; hr = nr; hi = ni; }
    }
}

__device__ __forceinline__ void p7_sgu(const Params& p, const Ctx& c) {
    typedef float f32x16 __attribute__((ext_vector_type(16)));
    constexpr int VS = 136;
    LAS bf16_t* VT = (LAS bf16_t*)c.lds;
    const bf16_t* GV = (const bf16_t*)(p.ws + WS_GV); const bf16_t* U = (const bf16_t*)(p.ws + WS_U); bf16_t* YB = (bf16_t*)(p.ws + WS_YB);
    const bf16_t* SW = (const bf16_t*)(p.ws + WS_SGUW);
    const int lane = c.lane, w = c.wave;
    f32x4 lg0 = *(const f32x4*)(p.in[I_LNG] + 8 * lane), lg1 = *(const f32x4*)(p.in[I_LNG] + 8 * lane + 4), lb0 = *(const f32x4*)(p.in[I_LNB] + 8 * lane), lb1 = *(const f32x4*)(p.in[I_LNB] + 8 * lane + 4);
    for (int un = c.vcu; un < 512; un += c.G) {
        const size_t t0 = (size_t)un * 128;
        unsigned pk[8][8];
#pragma unroll
        for (int rr = 0; rr < 16; ++rr) {
            f32x4 a, b; unpack8(*(const u32x4*)(GV + (t0 + 16 * w + rr) * 512 + 8 * lane), a, b);
            const float mu = wave_sum((a[0] + a[1]) + (a[2] + a[3]) + (b[0] + b[1]) + (b[2] + b[3])) * (1.0f / 512.0f);
            a -= mu; b -= mu;
            const float var = wave_sum((a[0] * a[0] + a[1] * a[1]) + (a[2] * a[2] + a[3] * a[3]) + (b[0] * b[0] + b[1] * b[1]) + (b[2] * b[2] + b[3] * b[3])) * (1.0f / 512.0f);
            const float rs = 1.0f / sqrtf(var + 1e-5f);
            a = a * rs * lg0 + lb0; b = b * rs * lg1 + lb1;
#pragma unroll
            for (int j = 0; j < 4; ++j) {
                if (rr & 1) { pk[j][rr >> 1] |= f2bf(a[j]) << 16; pk[4 + j][rr >> 1] |= f2bf(b[j]) << 16; }
                else { pk[j][rr >> 1] = f2bf(a[j]); pk[4 + j][rr >> 1] = f2bf(b[j]); }
            }
        }
#pragma unroll
        for (int j = 0; j < 8; ++j) { LAS bf16_t* d = VT + (8 * lane + j) * VS + 16 * w;
            *(LAS u32x4*)d = (u32x4){pk[j][0], pk[j][1], pk[j][2], pk[j][3]}; *(LAS u32x4*)(d + 8) = (u32x4){pk[j][4], pk[j][5], pk[j][6], pk[j][7]}; }
        __syncthreads();
        const int tb = w & 3, db = w >> 2, l31 = lane & 31, hi = lane >> 5;
        LAS unsigned char* wu = c.lds + 139264 + w * 2560;
        const int lr = lane >> 2, lp = lane & 3;
        const size_t gbase = (t0 + tb * 32 + lr) * 512 + db * 32 + lp * 8;
        u32x4 un0 = *(const u32x4*)(U + gbase), un1 = *(const u32x4*)(U + gbase + 16 * 512);
        for (int h = 0; h < 8; ++h) {
            *(LAS u32x4*)(wu + lr * 80 + lp * 16) = un0; *(LAS u32x4*)(wu + (lr + 16) * 80 + lp * 16) = un1;
            if (h < 7) { un0 = *(const u32x4*)(U + gbase + (h + 1) * 64); un1 = *(const u32x4*)(U + gbase + 16 * 512 + (h + 1) * 64); }
            f32x16 acc;
#pragma unroll
            for (int q = 0; q < 16; ++q) acc[q] = 0.f;
            const LAS bf16_t* arow = VT + (h * 64 + db * 32 + l31) * VS + 8 * hi;
            const bf16_t* brow = SW + ((size_t)(h * 128 + tb * 32 + l31)) * 128 + 8 * hi;
            const int nks = 2 * tb + 2;
            bf16x8 bq[8];
            (void)nks;
#pragma unroll
            for (int ks = 0; ks < 8; ++ks) bq[ks] = *(const bf16x8*)(brow + 16 * ks);
#pragma unroll
            for (int ks = 0; ks < 8; ++ks) { const bf16x8 af = *(const LAS bf16x8*)(arow + 16 * ks); acc = __builtin_amdgcn_mfma_f32_32x32x16_bf16(af, bq[ks], acc, 0, 0, 0); }
            const int tt = tb * 32 + l31; const float bs = p.in[I_SGUB][h * 128 + tt];
#pragma unroll
            for (int q = 0; q < 4; ++q) {
                LAS u32x2* up = (LAS u32x2*)(wu + l31 * 80 + 16 * q + 8 * hi);
                const u32x2 uu = *up;
                float y0 = bf_lo(uu.x) * (acc[4 * q] + bs), y1 = bf_hi(uu.x) * (acc[4 * q + 1] + bs), y2 = bf_lo(uu.y) * (acc[4 * q + 2] + bs), y3 = bf_hi(uu.y) * (acc[4 * q + 3] + bs);
                if (Q8_P8) { y0 = q8(y0, 8.f, 0.125f); y1 = q8(y1, 8.f, 0.125f); y2 = q8(y2, 8.f, 0.125f); y3 = q8(y3, 8.f, 0.125f); }
                if (FP8_MERGE) *(LAS unsigned*)(wu + l31 * 80 + 8 * q + 4 * hi) = pk4_fp8(y0 * 8.0f, y1 * 8.0f, y2 * 8.0f, y3 * 8.0f);
                else *up = (u32x2){cvt_pk_bf16(y0, y1), cvt_pk_bf16(y2, y3)};
            }
            if (FP8_MERGE) { const u32x4 yo = *(const LAS u32x4*)(wu + (lane >> 1) * 80 + (lane & 1) * 16);
                *(u32x4*)((unsigned char*)YB + (t0 + tb * 32 + (lane >> 1)) * 512 + h * 64 + db * 32 + (lane & 1) * 16) = yo; }
            else { const u32x4 yo0 = *(const LAS u32x4*)(wu + lr * 80 + lp * 16), yo1 = *(const LAS u32x4*)(wu + (lr + 16) * 80 + lp * 16);
                *(u32x4*)(YB + gbase + h * 64) = yo0; *(u32x4*)(YB + gbase + 16 * 512 + h * 64) = yo1; }
            LDS_WAIT();
        }
        __syncthreads();
    }
}

__device__ __forceinline__ void p10_norm_router(const Params& p, const Ctx& c, const bool probe = false) {
    LAS f32x4* WR = (LAS f32x4*)c.lds;
    LAS int* RT = (LAS int*)(c.lds + 147456);
    LAS int* hist = (LAS int*)(c.lds + 147456 + 4096);
    const float* mod = (const float*)(p.ws + WS_MOD); const float* H1 = p.out; bf16_t* XN2 = (bf16_t*)(p.ws + (probe ? WS_GATES : WS_XN));
    int* rowtok = (int*)(p.ws + (probe ? WS_SLOT : WS_ROWTOK)); float* roww = (float*)(p.ws + (probe ? WS_SLOT + 32 * MiB : WS_ROWW)); unsigned* cursor = (unsigned*)(p.ws + WS_CTL) + CW_CURSOR + (probe ? 64 * 64 : 0);
    for (int idx = c.tid; idx < 16 * 9 * 64; idx += NTHREADS) { const int l = idx & 63, q = (idx >> 6) % 9, ji = idx / 576, k = 4 * l + (ji & 3) + 256 * (ji >> 2);
        WR[idx] = (q == 0) ? *(const f32x4*)(p.in[I_WRG] + k * 4) : *(const f32x4*)(p.in[I_WRE] + ((size_t)((q - 1) >> 1) * 1024 + k) * 8 + ((q - 1) & 1) * 4); }
    LAS float* BRE = (LAS float*)(c.lds + 147456 + 4096 + 512);
    if (c.tid < 64) hist[c.tid] = 0;
    if (c.tid < 32) BRE[c.tid] = p.in[I_BRE2][c.tid];
    const float brg[4] = {p.in[I_BRG][0], p.in[I_BRG][1], p.in[I_BRG][2], p.in[I_BRG][3]};
    __syncthreads();
    for (int rb = c.vcu; rb < 256; rb += c.G) {
        const int b = rb >> 3;
        f32x4 vn[2][4];
#pragma unroll
        for (int u2 = 0; u2 < 2; ++u2) { const GAS f32x4* xr0 = (const GAS f32x4*)(H1 + ((size_t)rb * 256 + c.wave * 32 + u2) * D) + c.lane;
#pragma unroll
          for (int j = 0; j < 4; ++j) vn[u2][j] = xr0[64 * j]; }
        for (int i = 0; i < 32; i += 2) {
            const LAS f32x4* WRl = WR + c.lane; asm volatile("" : "+v"(WRl));
            f32x4 v[2][4]; float rr[2];
#pragma unroll
            for (int u2 = 0; u2 < 2; ++u2) { float s = 0.f;
#pragma unroll
                for (int j = 0; j < 4; ++j) { v[u2][j] = vn[u2][j]; s += (v[u2][j].x * v[u2][j].x + v[u2][j].y * v[u2][j].y) + (v[u2][j].z * v[u2][j].z + v[u2][j].w * v[u2][j].w); }
                rr[u2] = s; }
            { const int inx = (i < 30) ? i + 2 : i;
#pragma unroll
              for (int u2 = 0; u2 < 2; ++u2) { const GAS f32x4* xrn = (const GAS f32x4*)(H1 + ((size_t)rb * 256 + c.wave * 32 + inx + u2) * D) + c.lane;
#pragma unroll
                for (int j = 0; j < 4; ++j) vn[u2][j] = xrn[64 * j]; } }
            f32x4 lg[2];
#pragma unroll
            for (int u2 = 0; u2 < 2; ++u2) { const size_t row = (size_t)rb * 256 + c.wave * 32 + i + u2;
                const float r = 1.0f / sqrtf(wave_sum(rr[u2]) * (1.0f / D) + 1e-6f);
                GAS unsigned long long* o8 = (GAS unsigned long long*)(XN2 + row * D) + c.lane;
                lg[u2] = (f32x4){0.f, 0.f, 0.f, 0.f};
#pragma unroll
                for (int j = 0; j < 4; ++j) { const int k = 4 * c.lane + 256 * j;
                    const f32x4 g_ = *(const f32x4*)(p.in[I_N2G] + k), sc_ = *(const f32x4*)(mod + b * 6144 + 4096 + k), sh_ = *(const f32x4*)(mod + b * 6144 + 3072 + k);
                    v[u2][j] = v[u2][j] * r * (g_ * (sc_ + 1.0f)) + sh_; { f32x4 y = v[u2][j]; if (Q8_MOE) { y.x = q8(y.x, 1.f, 1.f); y.y = q8(y.y, 1.f, 1.f); y.z = q8(y.z, 1.f, 1.f); y.w = q8(y.w, 1.f, 1.f); }
                      if (FP8_MOE) ((GAS unsigned*)((unsigned char*)XN2 + row * D) + c.lane)[64 * j] = pk4_fp8(y.x, y.y, y.z, y.w);
                      else o8[64 * j] = (unsigned long long)pk2(y.x, y.y) | ((unsigned long long)pk2(y.z, y.w) << 32); } } }
#pragma unroll
            for (int j = 0; j < 4; ++j) {
#pragma unroll
                for (int ii = 0; ii < 4; ++ii) { const f32x4 w = WRl[((j * 4 + ii) * 9 + 0) * 64]; lg[0] += w * v[0][j][ii]; lg[1] += w * v[1][j][ii]; }
                if (j & 1) __builtin_amdgcn_sched_barrier(0); }
            int grp[2]; float pg[2];
#pragma unroll
            for (int u2 = 0; u2 < 2; ++u2) { float l4[4];
#pragma unroll
                for (int q = 0; q < 4; ++q) l4[q] = wave_sum(lg[u2][q]) + brg[q];
                int g_ = 0; float mx = l4[0];
#pragma unroll
                for (int q = 1; q < 4; ++q) if (l4[q] > mx) { mx = l4[q]; g_ = q; }
                float se = 0.f;
#pragma unroll
                for (int q = 0; q < 4; ++q) se += __expf(l4[q] - mx);
                pg[u2] = 1.0f / se; grp[u2] = __builtin_amdgcn_readfirstlane(g_); }
            f32x4 ex0[2], ex1[2];
#pragma unroll
            for (int u2 = 0; u2 < 2; ++u2) { ex0[u2] = (f32x4){0.f, 0.f, 0.f, 0.f}; ex1[u2] = ex0[u2]; }
#pragma unroll
            for (int j = 0; j < 4; ++j) {
#pragma unroll
                for (int ii = 0; ii < 4; ++ii)
#pragma unroll
                    for (int u2 = 0; u2 < 2; ++u2) { const LAS f32x4* wp = WRl + ((j * 4 + ii) * 9 + 1 + 2 * grp[u2]) * 64; ex0[u2] += wp[0] * v[u2][j][ii]; ex1[u2] += wp[64] * v[u2][j][ii]; }
                __builtin_amdgcn_sched_barrier(0); }
#pragma unroll
            for (int u2 = 0; u2 < 2; ++u2) { const int rl = c.wave * 32 + i + u2; float le[8];
#pragma unroll
                for (int q = 0; q < 4; ++q) { le[q] = wave_sum(ex0[u2][q]) + BRE[grp[u2] * 8 + q]; le[4 + q] = wave_sum(ex1[u2][q]) + BRE[grp[u2] * 8 + 4 + q]; }
                int i0 = 0; float v0 = le[0];
#pragma unroll
                for (int q = 1; q < 8; ++q) if (le[q] > v0) { v0 = le[q]; i0 = q; }
                int i1 = -1; float v1 = -3.0e38f;
#pragma unroll
                for (int q = 0; q < 8; ++q) if (q != i0 && le[q] > v1) { v1 = le[q]; i1 = q; }
                const float ex = __expf(v1 - v0), p0 = 1.0f / (1.0f + ex), p1 = ex / (1.0f + ex);
                if (c.lane == 0) { RT[rl * 4 + 0] = grp[u2] * 8 + i0; RT[rl * 4 + 1] = grp[u2] * 8 + i1; RT[rl * 4 + 2] = (int)__float_as_uint(pg[u2] * p0); RT[rl * 4 + 3] = (int)__float_as_uint(pg[u2] * p1); } }
        }
        __syncthreads();
        int e0 = 0, e1 = 0, r0 = 0, r1 = 0;
        if (c.tid < 256) { e0 = RT[c.tid * 4]; e1 = RT[c.tid * 4 + 1]; r0 = __hip_atomic_fetch_add(&hist[e0], 1, __ATOMIC_RELAXED, __HIP_MEMORY_SCOPE_WORKGROUP); r1 = __hip_atomic_fetch_add(&hist[e1], 1, __ATOMIC_RELAXED, __HIP_MEMORY_SCOPE_WORKGROUP); }
        __syncthreads();
        if (c.tid < 32) hist[32 + c.tid] = (int)__hip_atomic_fetch_add(cursor + 64 * c.tid, (unsigned)hist[c.tid], RLX_AGENT);
        __syncthreads();
        if (c.tid < 256) { const int tok = rb * 256 + c.tid; const int p0 = hist[32 + e0] + r0, p1 = hist[32 + e1] + r1;
            rowtok[(size_t)e0 * ECAP + p0] = tok * 2; roww[(size_t)e0 * ECAP + p0] = __uint_as_float((unsigned)RT[c.tid * 4 + 2]);
            rowtok[(size_t)e1 * ECAP + p1] = tok * 2 + 1; roww[(size_t)e1 * ECAP + p1] = __uint_as_float((unsigned)RT[c.tid * 4 + 3]); }
        __syncthreads();
        if (c.tid < 32) hist[c.tid] = 0;
        __syncthreads();
    }
}

__device__ __forceinline__ void p11_router_mfma(const Params& p, const Ctx& c, const bool probe = false) {
    constexpr int TS = 1032;
    LAS bf16_t* TH = (LAS bf16_t*)c.lds; LAS bf16_t* TL = TH + 16 * TS;
    LAS float* PART = (LAS float*)(c.lds + 2 * 16 * TS * 2);
    LAS float* LGA = (LAS float*)(c.lds + 114688);
    LAS int* RT = (LAS int*)(c.lds + 147456); LAS int* hist = (LAS int*)(c.lds + 147456 + 4096);
    LAS unsigned char* wl8 = c.lds + 98304 + c.wave * 2048;
    const float* mod = (const float*)(p.ws + WS_MOD); const float* H1 = DELTA_H1 ? p.in[I_X] : p.out; const bf16_t* DLT = (const bf16_t*)(p.ws + WS_H1B); (void)DLT; const size_t dmul = (HOT11 && probe) ? (size_t)0 : (size_t)D; const bf16_t* H1B = (const bf16_t*)(p.ws + WS_H1B); unsigned char* XN2 = p.ws + (probe ? WS_GATES : WS_XN);
    int* rowtok = (int*)(p.ws + (probe ? WS_SLOT : WS_ROWTOK)); float* roww = (float*)(p.ws + (probe ? WS_SLOT + 32 * MiB : WS_ROWW)); unsigned* cursor = (unsigned*)(p.ws + WS_CTL) + CW_CURSOR + (probe ? 64 * 256 : 0);
    const int lane = c.lane, w = c.wave, l15 = lane & 15, lq = lane >> 4;
    bf16x8 bh[4][3], bl[4][3];
#pragma unroll
    for (int ks = 0; ks < 4; ++ks)
#pragma unroll
        for (int cb = 0; cb < 3; ++cb) { const size_t o = (size_t)(cb * 16 + l15) * 1024 + 128 * w + 32 * ks + 8 * lq; bh[ks][cb] = *(const bf16x8*)((const bf16_t*)(p.ws + WS_WRH) + o); bl[ks][cb] = *(const bf16x8*)((const bf16_t*)(p.ws + WS_WRL) + o); }
    LAS float* BIAS = (LAS float*)(c.lds + 147456 + 4096 + 512);
    if (c.tid < 64) hist[c.tid] = 0;
    if (c.tid < 4) BIAS[c.tid] = p.in[I_BRG][c.tid]; else if (c.tid < 36) BIAS[c.tid] = p.in[I_BRE2][c.tid - 4];
    __syncthreads();
    for (int rb = c.vcu; rb < 256; rb += c.G) {
        const int b = rb >> 3;
        f32x4 A[4], Bc[4];
#pragma unroll
        for (int j = 0; j < 4; ++j) { const int k = 4 * lane + 256 * j; const f32x4 g_ = *(const f32x4*)(p.in[I_N2G] + k), sc_ = *(const f32x4*)(mod + b * 6144 + 4096 + k); A[j] = g_ * (sc_ + 1.0f); Bc[j] = *(const f32x4*)(mod + b * 6144 + 3072 + k); }
        f32x4 vn[2][4], vm[2][4];
        u32x2 dn[2][4], dm[2][4];
#pragma unroll
        for (int u2 = 0; u2 < 2; ++u2) { const size_t r0_ = (size_t)rb * 256 + 2 * w + u2;
#pragma unroll
            for (int j = 0; j < 4; ++j) { vn[u2][j] = NTLD((const GAS f32x4*)(H1 + r0_ * dmul) + lane + 64 * j); if (!DELTA_H1) vm[u2][j] = NTLD((const GAS f32x4*)(H1 + (r0_ + 16) * dmul) + lane + 64 * j);
                if (DELTA_H1) dn[u2][j] = NTLD((const GAS u32x2*)(DLT + r0_ * dmul) + lane + 64 * j); } }
        auto chunk = [&](const int ch, f32x4 (&vq)[2][4], u32x2 (&dq)[2][4]) __attribute__((always_inline)) {
#pragma unroll
            for (int u2 = 0; u2 < 2; ++u2) { const int rl = 2 * w + u2; const size_t row = (size_t)rb * 256 + ch * 16 + rl;
                f32x4 v[4]; float s = 0.f;
#pragma unroll
                for (int j = 0; j < 4; ++j) { v[j] = vq[u2][j]; if (DELTA_H1) { const u32x2 dw = dq[u2][j]; v[j] += (f32x4){bf_lo(dw.x), bf_hi(dw.x), bf_lo(dw.y), bf_hi(dw.y)}; } s += (v[j].x * v[j].x + v[j].y * v[j].y) + (v[j].z * v[j].z + v[j].w * v[j].w); }
                constexpr int AH = DELTA_H1 ? 16 : 32;
                if (ch < 16 - AH / 16) {
#pragma unroll
                    for (int j = 0; j < 4; ++j) { vq[u2][j] = NTLD((const GAS f32x4*)(H1 + (row + AH) * dmul) + lane + 64 * j); if (DELTA_H1) dq[u2][j] = NTLD((const GAS u32x2*)(DLT + (row + AH) * dmul) + lane + 64 * j); } }
                const float r = 1.0f / sqrtf(wave_sum(s) * (1.0f / D) + 1e-6f);
#pragma unroll
                for (int j = 0; j < 4; ++j) { const int k = 4 * lane + 256 * j;
                    const f32x4 y = v[j] * r * A[j] + Bc[j];
                    *(LAS unsigned*)(wl8 + u2 * 1024 + 4 * lane + 256 * j) = pk4_fp8(y.x, y.y, y.z, y.w);
                    const unsigned h0 = cvt_pk_bf16(y.x, y.y), h1 = cvt_pk_bf16(y.z, y.w);
                    const unsigned l0 = cvt_pk_bf16(y.x - bf_lo(h0), y.y - bf_hi(h0)), l1 = cvt_pk_bf16(y.z - bf_lo(h1), y.w - bf_hi(h1));
                    *(LAS u32x2*)(TH + rl * TS + k) = (u32x2){h0, h1}; *(LAS u32x2*)(TL + rl * TS + k) = (u32x2){l0, l1}; }
            }
            LDS_WAIT();
#pragma unroll
            for (int u2 = 0; u2 < 2; ++u2) ((GAS u32x4*)(XN2 + ((size_t)rb * 256 + ch * 16 + 2 * w + u2) * D))[lane] = *(const LAS u32x4*)(wl8 + u2 * 1024 + 16 * lane);
            __syncthreads();
            f32x4 acc[3];
#pragma unroll
            for (int cb = 0; cb < 3; ++cb) acc[cb] = (f32x4){0.f, 0.f, 0.f, 0.f};
#pragma unroll
            for (int ks = 0; ks < 4; ++ks) { const int ko = l15 * TS + 128 * w + 32 * ks + 8 * lq;
                const bf16x8 ah = *(const LAS bf16x8*)(TH + ko), al = *(const LAS bf16x8*)(TL + ko);
#pragma unroll
                for (int cb = 0; cb < 3; ++cb) { acc[cb] = __builtin_amdgcn_mfma_f32_16x16x32_bf16(ah, bh[ks][cb], acc[cb], 0, 0, 0); acc[cb] = __builtin_amdgcn_mfma_f32_16x16x32_bf16(ah, bl[ks][cb], acc[cb], 0, 0, 0); acc[cb] = __builtin_amdgcn_mfma_f32_16x16x32_bf16(al, bh[ks][cb], acc[cb], 0, 0, 0); } }
#pragma unroll
            for (int cb = 0; cb < 3; ++cb)
#pragma unroll
                for (int q = 0; q < 4; ++q) PART[(w * 16 + lq * 4 + q) * 48 + cb * 16 + l15] = acc[cb][q];
            __syncthreads();
            for (int o = c.tid; o < 768; o += NTHREADS) { const int rr_ = o / 48, cc_ = o - rr_ * 48; float sacc = 0.f;
#pragma unroll
                for (int ww = 0; ww < 8; ++ww) sacc += PART[ww * 768 + o];
                if (cc_ < 36) LGA[(ch * 16 + rr_) * 36 + cc_] = sacc; }
        };
        if (DELTA_H1) { for (int ch = 0; ch < 16; ++ch) chunk(ch, vn, dn); } else { for (int ch = 0; ch < 16; ch += 2) { chunk(ch, vn, dn); chunk(ch + 1, vm, dm); } }
        __syncthreads();
        float rw0 = 0.f, rw1 = 0.f; int re0 = 0, re1 = 0;
        if (c.tid < 256) { const LAS float* lgp = LGA + c.tid * 36; float l4[4];
#pragma unroll
            for (int q = 0; q < 4; ++q) l4[q] = lgp[q] + BIAS[q];
            int grp = 0; float mx = l4[0];
#pragma unroll
            for (int q = 1; q < 4; ++q) if (l4[q] > mx) { mx = l4[q]; grp = q; }
            float se = 0.f;
#pragma unroll
            for (int q = 0; q < 4; ++q) se += __expf(l4[q] - mx);
            const float pg = 1.0f / se;
            float le[8];
#pragma unroll
            for (int q = 0; q < 8; ++q) le[q] = lgp[4 + grp * 8 + q] + BIAS[4 + grp * 8 + q];
            int i0 = 0; float v0 = le[0];
#pragma unroll
            for (int q = 1; q < 8; ++q) if (le[q] > v0) { v0 = le[q]; i0 = q; }
            int i1 = -1; float v1 = -3.0e38f;
#pragma unroll
            for (int q = 0; q < 8; ++q) if (q != i0 && le[q] > v1) { v1 = le[q]; i1 = q; }
            const float ex = __expf(v1 - v0), p0 = 1.0f / (1.0f + ex), p1 = ex / (1.0f + ex);
            re0 = grp * 8 + i0; re1 = grp * 8 + i1; rw0 = pg * p0; rw1 = pg * p1; }
        __syncthreads();
        if (c.tid < 256) { RT[c.tid * 4 + 0] = re0; RT[c.tid * 4 + 1] = re1; RT[c.tid * 4 + 2] = (int)__float_as_uint(rw0); RT[c.tid * 4 + 3] = (int)__float_as_uint(rw1); }
        __syncthreads();
        int e0 = 0, e1 = 0, r0 = 0, r1 = 0;
        if (c.tid < 256) { e0 = RT[c.tid * 4]; e1 = RT[c.tid * 4 + 1]; r0 = __hip_atomic_fetch_add(&hist[e0], 1, __ATOMIC_RELAXED, __HIP_MEMORY_SCOPE_WORKGROUP); r1 = __hip_atomic_fetch_add(&hist[e1], 1, __ATOMIC_RELAXED, __HIP_MEMORY_SCOPE_WORKGROUP); }
        __syncthreads();
        const int seg = rb & 3;
        if (c.tid < 32) hist[32 + c.tid] = seg * (ECAP / 4) + (int)__hip_atomic_fetch_add(cursor + 64 * (c.tid * 4 + seg), (unsigned)hist[c.tid], RLX_AGENT);
        __syncthreads();
        if (c.tid < 256) { const int tok = rb * 256 + c.tid; const int q0 = hist[32 + e0] + r0, q1 = hist[32 + e1] + r1;
            rowtok[(size_t)e0 * ECAP + q0] = tok * 2; roww[(size_t)e0 * ECAP + q0] = __uint_as_float((unsigned)RT[c.tid * 4 + 2]);
            rowtok[(size_t)e1 * ECAP + q1] = tok * 2 + 1; roww[(size_t)e1 * ECAP + q1] = __uint_as_float((unsigned)RT[c.tid * 4 + 3]); }
        __syncthreads();
        if (c.tid < 32) hist[c.tid] = 0;
        __syncthreads();
    }
}

__device__ __forceinline__ void p14_final(const Params& p, const Ctx& c, float* dst = nullptr) {
    const float* mod = (const float*)(p.ws + WS_MOD); const unsigned char* SLOT8 = (const unsigned char*)(p.ws + WS_SLOT); const float* out = DELTA_H1 ? p.in[I_X] : p.out; float* wout = dst ? dst : p.out; const bf16_t* DLT = (const bf16_t*)(p.ws + WS_H1B); (void)DLT;
    static_assert(FP8_SLOT == 1 && H1_BF16 == 0, "p14_final: fp8 slots, f32 h1");
    LAS unsigned char* wl = c.lds + c.wave * 8192;
    LAS unsigned char* wd = wl + 4096;
    for (int rb = c.vcu; rb < 256; rb += c.G) {
        const int b = rb >> 3;
        f32x4 gt[4], gf[4];
#pragma unroll
        for (int j = 0; j < 4; ++j) { const int k = 4 * c.lane + 256 * j; gt[j] = *(const f32x4*)(mod + b * 6144 + 5120 + k) * (1.0f / 16.0f); gf[j] = *(const f32x4*)(p.in[I_NFG] + k); }
        auto ld = [&](const size_t row, f32x4 (&hv)[2][4], u32x4 (&sl)[2][2], u32x4 (&dl)[2][2]) __attribute__((always_inline)) {
#pragma unroll
            for (int q = 0; q < 2; ++q) { const GAS f32x4* xr = (const GAS f32x4*)(out + (row + q) * D) + c.lane;
#pragma unroll
                for (int j = 0; j < 4; ++j) hv[q][j] = NTLD(xr + 64 * j);
                sl[q][0] = NTLD((const GAS u32x4*)(SLOT8 + ((row + q) * 2) * D) + c.lane); sl[q][1] = NTLD((const GAS u32x4*)(SLOT8 + ((row + q) * 2 + 1) * D) + c.lane);
                if (DELTA_H1) { dl[q][0] = NTLD((const GAS u32x4*)(DLT + (row + q) * D) + c.lane); dl[q][1] = NTLD((const GAS u32x4*)(DLT + (row + q) * D) + 64 + c.lane); } }
        };
        auto proc = [&](const size_t row, f32x4 (&hv)[2][4], u32x4 (&sl)[2][2], u32x4 (&dl)[2][2]) __attribute__((always_inline)) {
#pragma unroll
            for (int q = 0; q < 2; ++q) { *(LAS u32x4*)(wl + (q * 2) * 1024 + 16 * c.lane) = sl[q][0]; *(LAS u32x4*)(wl + (q * 2 + 1) * 1024 + 16 * c.lane) = sl[q][1];
                if (DELTA_H1) { *(LAS u32x4*)(wd + q * 2048 + 16 * c.lane) = dl[q][0]; *(LAS u32x4*)(wd + q * 2048 + 1024 + 16 * c.lane) = dl[q][1]; } }
            LDS_WAIT();
#pragma unroll
            for (int q = 0; q < 2; ++q) { float s = 0.f; f32x4 v[4];
#pragma unroll
                for (int j = 0; j < 4; ++j) { const int sa = *(const LAS int*)(wl + (q * 2) * 1024 + 4 * c.lane + 256 * j), sb = *(const LAS int*)(wl + (q * 2 + 1) * 1024 + 4 * c.lane + 256 * j);
                    const f32x2 a0 = __builtin_amdgcn_cvt_pk_f32_fp8(sa, false), a1 = __builtin_amdgcn_cvt_pk_f32_fp8(sa, true), b0 = __builtin_amdgcn_cvt_pk_f32_fp8(sb, false), b1 = __builtin_amdgcn_cvt_pk_f32_fp8(sb, true);
                    const f32x4 y = (f32x4){a0.x + b0.x, a0.y + b0.y, a1.x + b1.x, a1.y + b1.y};
                    v[j] = hv[q][j] + gt[j] * y; if (DELTA_H1) { const u32x2 dw = *(const LAS u32x2*)(wd + q * 2048 + 8 * c.lane + 512 * j); v[j] += (f32x4){bf_lo(dw.x), bf_hi(dw.x), bf_lo(dw.y), bf_hi(dw.y)}; } s += (v[j].x * v[j].x + v[j].y * v[j].y) + (v[j].z * v[j].z + v[j].w * v[j].w); }
                const float r = 1.0f / sqrtf(wave_sum(s) * (1.0f / D) + 1e-6f);
                GAS f32x4* xo = (GAS f32x4*)(wout + (row + q) * D) + c.lane;
#pragma unroll
                for (int j = 0; j < 4; ++j) xo[64 * j] = v[j] * r * gf[j]; }
            LDS_WAIT();
        };
        const size_t row0 = (size_t)rb * 256 + c.wave * 32;
        f32x4 hA[2][4], hB[2][4]; u32x4 sA[2][2], sB[2][2], dA[2][2], dB[2][2];
        ld(row0, hA, sA, dA);
        for (int i = 0; i < 32; i += 4) {
            ld(row0 + i + 2, hB, sB, dB);
            proc(row0 + i, hA, sA, dA);
            if (i + 4 < 32) ld(row0 + i + 4, hA, sA, dA);
            proc(row0 + i + 2, hB, sB, dB);
        }
    }
}
}
namespace fx {
constexpr int N_PHASES = 15;
struct KArgs { Params p; int region, pad; };
__global__ void __launch_bounds__(NTHREADS, 2) fwd(KArgs ka) {
    extern __shared__ __attribute__((aligned(16))) unsigned char lds_[];
    const Params& p = ka.p;
    Ctx c0; c0.lds = (LAS unsigned char*)lds_; c0.wave = __builtin_amdgcn_readfirstlane((int)threadIdx.x >> 6); c0.lane = 0; c0.tid = 0;
    c0.G = gridDim.x; { const int bx = blockIdx.x; c0.vcu = (c0.G % 8 == 0) ? (bx % 8) * (c0.G / 8) + bx / 8 : bx; }
#define CTX Ctx c = c0; c.lane = mg::lane_id(); c.tid = c.wave * 64 + c.lane;
    CTX
    volatile LAS unsigned* MISC = (volatile LAS unsigned*)(c.lds + MISC_OFF);
    if (c.tid < 64) MISC[c.tid] = 0u;
    __syncthreads();
    unsigned* ctl = (unsigned*)(p.ws + WS_CTL);
    const int lo = p.ph_lo, hi = p.ph_hi;
    XcdBarrier bar; bar.bar = ctl + CW_BAR + ka.region * XCD_BAR_WORDS; bar.x = 0; bar.st = nullptr; bar.wave = c0.wave;
    if (hi - lo > 1) bar = xcd_barrier_post(ctl + CW_BAR + ka.region * XCD_BAR_WORDS, MISC + 8, c0.wave);
#ifndef PHASE_MASK
#define PHASE_MASK 0x7fff
#endif
#define IN(k) ((((PHASE_MASK) >> (k)) & 1) && lo <= (k) && (k) < hi)
#ifndef REPEAT_MASK
#define REPEAT_MASK 0
#endif
#ifndef REPEAT_N
#define REPEAT_N 1
#endif

#ifdef TSTAMP
#define STAMP(k) do { if (blockIdx.x == 0 && c.tid == 0) ((unsigned long long*)(p.ws + (size_t)972 * MiB))[(k)] = __builtin_amdgcn_s_memrealtime(); } while (0)
#else
#define STAMP(k) do { } while (0)
#endif
#define SEAM(k) do { if (IN(k) && IN((k) + 1)) xcd_barrier(bar); STAMP((k) + 1); } while (0)
    LAS unsigned char* ring = c0.lds;
    const int G = c0.G, bx = (int)blockIdx.x;
    const char* ws = (const char*)p.ws;
#ifndef SPLIT_P0
#define SPLIT_P0 0
#endif
#if SPLIT_P0
#define PH0 { CTX p0_prologue<1>(p, c); }
#else
#define PH0 { CTX p0_prologue<3>(p, c); }
#endif
#define PH0B { CTX p0_prologue<P0_PARTS>(p, c); }
#if SPLIT_P0
#define PH1 { CTX p1_xn<4>(p, c); p0_prologue<2>(p, c); }
#else
#define PH1 { CTX p1_xn<8>(p, c); }
#endif
#if MERGE_ONE
#define E1G_EXTRA , (bf16_t*)(p.ws + WS_GATES) + TILED2_HALF
#else
#define E1G_EXTRA
#endif
#ifndef LATE_GATES
#define LATE_GATES 0
#endif
#if FP8_GATES
#define PH2A { CTX LAS float* bgl = (LAS float*)(c.lds + XT_OFF); (void)bgl; \
        { SchedStd<true> S{ws + WS_XN, ws + WS_W1T, 1024, 1024, 256, ZA_FP8GEMM ? 4 : 6, 16, G, bx, ZA_FP8GEMM ? 2 : 0}; \
          Epi1 E{(bf16_t*)(p.ws + WS_ZA), (bf16_t*)(p.ws + WS_U), (bf16_t*)(p.ws + WS_GV), (bf16_t*)(p.ws + WS_GATES), bgl}; \
          mg::gemm_phase<Epi1, SchedStd<true>, false, true>(c.wave, ring, S, E, 128, 128); } }
#define PH2B { CTX LAS float* bgl = (LAS float*)(c.lds + XT_OFF); for (int q_ = c.tid; q_ < 2048; q_ += NTHREADS) bgl[q_] = p.in[I_BGATE][q_]; __syncthreads(); \
        { if constexpr (ZA_FP8GEMM != 0) { SchedStd8<true> S{(const char*)p.out, ws + WS_WG8 - 512 * 1024, 1024, 1024, 256, 10, 8, G, bx}; \
            EpiZG E{Epi1{(bf16_t*)(p.ws + WS_ZA), (bf16_t*)(p.ws + WS_U), (bf16_t*)(p.ws + WS_GV), (bf16_t*)(p.ws + WS_GATES), bgl}, Epi1g{(bf16_t*)(p.ws + WS_GATES), bgl E1G_EXTRA}}; \
            mg::gemm_phase<EpiZG, SchedStd8<true>, false, true, true>(c.wave, ring, S, E, 128, 128, 127, 122); } \
          else { SchedStd8<true> S{(const char*)p.out, ws + WS_WG8, 1024, 1024, 256, 8, 8, G, bx}; Epi1g E{(bf16_t*)(p.ws + WS_GATES), bgl E1G_EXTRA}; \
            mg::gemm_phase<Epi1g, SchedStd8<true>, false, true, true>(c.wave, ring, S, E, 128, 128, 127, 122); } } }
#if LATE_GATES
#define PH2 PH2A
#define PH6X PH2B
#else
#define PH2 { PH2A PH2B }
#define PH6X { }
#endif
#else
#define PH2 { CTX LAS float* bgl = (LAS float*)(c.lds + XT_OFF); for (int q_ = c.tid; q_ < 2048; q_ += NTHREADS) bgl[q_] = p.in[I_BGATE][q_]; __syncthreads(); \
        SchedStd<true> S{ws + WS_XN, ws + WS_W1T, 1024, 1024, 256, 14, 16, G, bx}; \
        Epi1 E{(bf16_t*)(p.ws + WS_ZA), (bf16_t*)(p.ws + WS_U), (bf16_t*)(p.ws + WS_GV), (bf16_t*)(p.ws + WS_GATES), bgl}; \
        mg::gemm_phase<Epi1, SchedStd<true>, false, true>(c.wave, ring, S, E, 128, 128); }
#endif
#define PH2N { CTX { SchedStd<true> S{ws + WS_XN, ws + WS_W1T, 1024, 1024, 256, 6, 16, G, bx}; EpiNull E{}; mg::gemm_phase<EpiNull, SchedStd<true>, false, true>(c.wave, ring, S, E, 128, 128); } \
        { SchedStd8<true> S{(const char*)p.out, ws + WS_WG8, 1024, 1024, 256, 8, 8, G, bx}; EpiNull E{}; mg::gemm_phase<EpiNull, SchedStd8<true>, false, true, true>(c.wave, ring, S, E, 128, 128, 127, 122); } }
#define PH8N { CTX SchedStd<true> S{ws + WS_YA, ws + WS_WBAT, 512, 512, 256, 4, 8, G, bx}; EpiNull E{}; mg::gemm_phase<EpiNull, SchedStd<true>, false, true>(c.wave, ring, S, E, 128, 128); }
#define PH10N { CTX SchedStd8<true> S{ws + WS_MERGED, ws + WS_WOUTT, 1024, 1024, 256, 4, 8, G, bx}; EpiNull E{}; mg::gemm_phase<EpiNull, SchedStd8<true>, false, true, true>(c.wave, ring, S, E, 128, 128, 125, 122); }
#define PH12N { CTX const MoeTab mt = moe_table(p, c); SchedUp S{ws + WS_XN, ws + WS_WUPT, (const int*)(p.ws + WS_ROWTOK), mt, G, bx, (const float*)(p.ws + WS_ROWW)}; EpiNull E{}; mg::gemm_phase<EpiNull, SchedUp, true, true, FP8_MOE>(c.wave, ring, S, E, 128, 128, 127, 122); }
#define PH12M { CTX const MoeTab mt = moe_table(p, c); SchedUp S{ws + WS_XN, ws + WS_WUPT, (const int*)(p.ws + WS_ROWTOK), mt, G, bx, (const float*)(p.ws + WS_ROWW)}; EpiUpMath E{(const float*)(p.ws + WS_ROWW), mt}; mg::gemm_phase<EpiUpMath, SchedUp, true, true, FP8_MOE>(c.wave, ring, S, E, 128, 128, 127, 122); }
#ifndef NOEPI_MASK
#define NOEPI_MASK 0
#endif
#ifndef STAG10
#define STAG10 0
#endif
#ifndef STAG8
#define STAG8 0
#endif
#ifndef STAG2
#define STAG2 0
#endif
#define STAGGER(us) do { if ((us) > 0 && (c0.vcu & 1)) { const unsigned long long t0_ = __builtin_amdgcn_s_memrealtime(); while (__builtin_amdgcn_s_memrealtime() - t0_ < (unsigned long long)(us) * 100ull) __builtin_amdgcn_s_sleep(8); } } while (0)
#define PH3 { CTX SchedS5a S{ws + WS_ZA, ws + WS_TZ, ws + WS_WS, G, c.vcu}; EpiS5a E{(bf16_t*)(p.ws + WS_YI), (float*)(p.ws + WS_SST), p.in[I_LSTEP]}; \
        mg::gemm_phase<EpiS5a, SchedS5a, false, true, (FP8_S5A != 0)>(c.wave, ring, S, E, 128, 128, FP8_S5A ? 124 : 127, FP8_S5A ? 121 : 127); }
#define PH4 { CTX p4_scan(p, c); }
#define PH5 { CTX SchedS5b S{ws + WS_HP, ws + WS_WO, G, FUSE45 ? c.vcu : bx}; EpiS5b E{(const bf16_t*)(p.ws + WS_YI), (bf16_t*)(p.ws + WS_YG)}; \
        mg::gemm_phase<EpiS5b, SchedS5b, false, true>(c.wave, ring, S, E, 128, 128); }
#define PH6 { CTX SchedGlu S{ws + WS_YG, ws + WS_WGLUT, G, bx}; EpiGlu E{(const bf16_t*)(p.ws + WS_YG), (bf16_t*)(p.ws + WS_YA), p.in[I_BGLU]}; \
        mg::gemm_phase<EpiGlu, SchedGlu, false, true, false, false>(c.wave, ring, S, E, (size_t)8388608, 128); }
#define PH7 { CTX p7_sgu(p, c); }
#define PH8 { CTX SchedStd<true> S{ws + WS_YA, ws + WS_WBAT, 512, 512, 256, 4, 8, G, bx}; EpiMerge<0> E{(const bf16_t*)(p.ws + WS_GATES), (bf16_t*)(p.ws + WS_P1), (bf16_t*)(p.ws + WS_MERGED)}; \
        mg::gemm_phase<EpiMerge<0>, SchedStd<true>, false, true>(c.wave, ring, S, E, 128, 128); }
#define PH9 { CTX SchedStd<true> S{ws + WS_YB, ws + WS_WBBT, 512, 512, 256, 4, 8, G, bx}; EpiMerge<1> E{(const bf16_t*)(p.ws + WS_GATES), (bf16_t*)(p.ws + WS_P1), (bf16_t*)(p.ws + WS_MERGED)}; \
        mg::gemm_phase<EpiMerge<1>, SchedStd<true>, false, true>(c.wave, ring, S, E, 128, 128); }
#if FP8_OUT
#define PH89 { CTX SchedMerge S{ws + WS_YA, ws + WS_YB, ws + WS_WBAT, ws + WS_WBBT, G, bx}; EpiMergeOne E{(const bf16_t*)(p.ws + WS_GATES), (bf16_t*)(p.ws + WS_MERGED)}; \
        mg::gemm_phase<EpiMergeOne, SchedMerge, false, true, (FP8_MERGE != 0)>(c.wave, ring, S, E, 128, 128, FP8_MERGE ? 124 : 127, FP8_MERGE ? 123 : 127); }
#if H1_BF16
#define PH10 { CTX SchedStd8<true> S{ws + WS_MERGED, ws + WS_WOUTT, 1024, 1024, 256, 4, 8, G, bx}; EpiOutB E{p.in[I_X], (const float*)(p.ws + WS_MOD), (bf16_t*)(p.ws + WS_H1B)}; \
        mg::gemm_phase<EpiOutB, SchedStd8<true>, false, true, true>(c.wave, ring, S, E, 128, 128, 125, 122); }
#else
#define PH10 { CTX if constexpr (DELTA_H1 != 0) { SchedStd8<true> S{ws + WS_MERGED, ws + WS_WOUTT, 1024, 1024, 256, 4, 8, G, bx}; EpiDelta E{(const float*)(p.ws + WS_MOD), (bf16_t*)(p.ws + WS_H1B)}; \
        mg::gemm_phase<EpiDelta, SchedStd8<true>, false, true, true>(c.wave, ring, S, E, 128, 128, 125, 122); } \
      else { SchedStd8<false> S{ws + WS_MERGED, ws + WS_WOUTT, 1024, 1024, 256, 4, 8, G, bx}; EpiOut E{p.in[I_X], (const float*)(p.ws + WS_MOD), p.out}; \
        mg::gemm_phase<EpiOut, SchedStd8<false>, false, true, true>(c.wave, ring, S, E, 128, 128, 125, 122); } }
#endif
#else
#define PH10 { CTX SchedStd<false> S{ws + WS_MERGED, ws + WS_WOUTT, 1024, 1024, 256, 4, 16, G, bx}; EpiOut E{p.in[I_X], (const float*)(p.ws + WS_MOD), p.out}; \
        mg::gemm_phase<EpiOut, SchedStd<false>, false, true>(c.wave, ring, S, E, 128, 128); }
#endif
#ifndef ROUTER_MFMA
#define ROUTER_MFMA 1
#endif
#if ROUTER_MFMA
#define PH11 { CTX p11_router_mfma(p, c); }
#else
#define PH11 { CTX p10_norm_router(p, c); }
#endif
#define PH12 { CTX const MoeTab mt = moe_table(p, c); SchedUp S{ws + WS_XN, ws + WS_WUPT, (const int*)(p.ws + WS_ROWTOK), mt, G, bx, (const float*)(p.ws + WS_ROWW)}; EpiUp E{(bf16_t*)(p.ws + WS_HID), (const float*)(p.ws + WS_ROWW), mt}; \
        mg::gemm_phase<EpiUp, SchedUp, true, true, FP8_MOE>(c.wave, ring, S, E, 128, 128, 127, 122); }
#define PH13 { CTX const MoeTab mt = (one && IN(12)) ? moe_table_keep(c) : moe_table(p, c); SchedDn S{ws + WS_HID, ws + WS_WDNT, mt, G, bx, (const int*)(p.ws + WS_ROWTOK)}; EpiDn E{(bf16_t*)(p.ws + WS_SLOT), (const int*)(p.ws + WS_ROWTOK), mt}; \
        mg::gemm_phase<EpiDn, SchedDn, false, true, FP8_MOE>(c.wave, ring, S, E, 128, 128, 124, 123); }
#define PH14 { CTX p14_final(p, c); }
#define RUN(k, BODY) do { if (IN((k) & 15)) { BODY if constexpr (((REPEAT_MASK) >> (k)) & 1) { xcd_barrier(bar); BODY } } } while (0)
    const bool one = (hi - lo > 1);
#define GBAR do { if (one) xcd_barrier(bar); } while (0)
    do { if (IN(0)) { PH0 if constexpr ((REPEAT_MASK) & 1) { xcd_barrier(bar); PH0B } } } while (0);
    if (P0P1_HANDOFF && one && IN(0) && IN(1)) {
        __syncthreads();
        if (c0.wave == 0 && mg::lane_id() == 0) { XB_SPIN(xb_ld(ctl + CW_MODRDY) < 96u, bar.bar); __builtin_amdgcn_fence(__ATOMIC_ACQUIRE, "agent"); asm volatile("s_waitcnt vmcnt(0)" ::: "memory"); }
        __syncthreads(); }
    else GBAR;
    RUN(1, PH1); GBAR;
    if constexpr ((NOEPI_MASK >> 2) & 1) { PH2N xcd_barrier(bar); }
    STAGGER(STAG2); RUN(2, PH2); GBAR;
    RUN(3, PH3); GBAR;
    if (FUSE45 && one) { RUN(4, PH4); if (IN(5)) { asm volatile("s_waitcnt vmcnt(0)" ::: "memory"); __syncthreads(); } RUN(5, PH5); if (IN(7)) __syncthreads(); RUN(7, PH7); GBAR; }
    else { RUN(4, PH4); if (one) { RUN(7, PH7); } GBAR;
    RUN(5, PH5); GBAR; }
    RUN(6, PH6); if (IN(6)) { PH6X } GBAR;
    if (!one) { RUN(7, PH7); }
#if MERGE_ONE
    RUN(8, PH89); GBAR;
#else
    if constexpr ((NOEPI_MASK >> 8) & 1) { PH8N xcd_barrier(bar); }
    STAGGER(STAG8); RUN(8, PH8);
    if (one) { asm volatile("s_waitcnt vmcnt(0)" ::: "memory"); __syncthreads();
        if (c0.wave == 0 && mg::lane_id() == 0) { __builtin_amdgcn_fence(__ATOMIC_ACQUIRE, "agent"); asm volatile("s_waitcnt vmcnt(0)" ::: "memory"); }
        __syncthreads(); }
    RUN(9, PH9); GBAR;
#endif
    if constexpr ((NOEPI_MASK >> 10) & 1) { PH10N xcd_barrier(bar); }
    STAGGER(STAG10); RUN(10, PH10); GBAR;
    if constexpr (((REPEAT_MASK) >> 11) & 1) { if (IN(11)) { { CTX if (ROUTER_MFMA) p11_router_mfma(p, c, true); else p10_norm_router(p, c, true); } xcd_barrier(bar); } }
    RUN(11 + 16, PH11); GBAR;
    if constexpr ((NOEPI_MASK >> 12) & 1) { PH12N xcd_barrier(bar); }
    if constexpr ((NOEPI_MASK >> 20) & 1) { PH12M xcd_barrier(bar); }
    RUN(12, PH12); GBAR;
    RUN(13, PH13); GBAR;
    if constexpr (((REPEAT_MASK) >> 14) & 1) { if (IN(14)) { { CTX p14_final(p, c, (float*)(p.ws + WS_GATES)); } xcd_barrier(bar); } }
    RUN(14 + 16, PH14);
#undef IN
#undef SEAM
}
static int g_grid = 0;
static bool fast_setup() {
    if (g_grid != 0) return g_grid > 0;
    int dev = 0, cus = 0, per_cu = 0;
    if (hipGetDevice(&dev) != hipSuccess || hipDeviceGetAttribute(&cus, hipDeviceAttributeMultiprocessorCount, dev) != hipSuccess) { g_grid = -1; return false; }
    if (hipFuncSetAttribute((const void*)fwd, hipFuncAttributeMaxDynamicSharedMemorySize, LDS_BYTES) != hipSuccess) { fprintf(stderr, "hipFuncSetAttribute failed\n"); g_grid = -1; return false; }
    if (hipOccupancyMaxActiveBlocksPerMultiprocessor(&per_cu, (const void*)fwd, NTHREADS, LDS_BYTES) != hipSuccess || per_cu < 1) fprintf(stderr, "occupancy query: %d\n", per_cu);
    (void)hipGetLastError();
    g_grid = cus;
    return true;
}
static void fast_forward(void* const* d_in, float* out, unsigned char* ws, hipStream_t st, int lo, int hi, bool split, int region) {
    if (!fast_setup()) return;
    KArgs a{};
    for (int i = 0; i < 34; ++i) a.p.in[i] = (const float*)d_in[i];
    a.p.out = out; a.p.ws = ws; a.region = region; a.pad = 0;
    if (split) { for (int k = lo; k < hi; ++k) { a.p.ph_lo = k; a.p.ph_hi = k + 1; hipLaunchKernelGGL(fwd, dim3(g_grid), dim3(NTHREADS), LDS_BYTES, st, a); } }
    else { a.p.ph_lo = lo; a.p.ph_hi = hi; hipLaunchKernelGGL(fwd, dim3(g_grid), dim3(NTHREADS), LDS_BYTES, st, a); }
}
}
extern "C" void kernel_launch(void* const* d_in, const int* in_sizes, int n_in, void* d_out, int out_size, void* d_ws, size_t ws_size, hipStream_t stream) {
    (void)in_sizes; (void)n_in; (void)out_size; (void)ws_size;
    (void)hipMemsetAsync((char*)d_ws + fx::WS_CTL, 0, fx::CTL_ZERO_BYTES, stream);
    fx::fast_forward(d_in, (float*)d_out, (unsigned char*)d_ws, stream, 0, fx::N_PHASES, FAST_SPLIT, 0);
}
```
